# Optimizing an MI355X kernel written in HIP

```python
import math
import jax, jax.numpy as jnp
from jax import lax
import numpy as np

D_MODEL = 2048
BATCH = 4
SEQ = 4096
DEPTH = 2

N_MIXERS = 2
N_A_LAYERS = (DEPTH + 1) // 2
N_B_LAYERS = DEPTH // 2
EPS = 1e-6
D_RNN = D_MODEL
RG_HEADS = 16
RG_BLOCK = D_RNN // RG_HEADS
CONV_W = 4
RG_C = 8.0
MLA_HEADS = 16
Q_LORA = 512
KV_LORA = 512
QK_NOPE = 128
QK_ROPE = 64
V_DIM = 128
QK_DIM = QK_NOPE + QK_ROPE
ROPE_THETA = 10000.0
Q_BLOCK = 128
D_FF = 7 * D_MODEL // 2
N_EXPERTS = 8
TOP_K = 2
MOE_BLOCK = 256

kernel_name = "hybrid_rglru_mla_moe_trunk"


def rms_norm(x, g):
    xf = x.astype(jnp.float32)
    y = xf * lax.rsqrt(jnp.mean(xf * xf, axis=-1, keepdims=True) + EPS)
    return (y * g.astype(jnp.float32)).astype(x.dtype)


def swiglu(h, w_gate, w_up, w_down):
    return (jax.nn.silu(h @ w_gate) * (h @ w_up)) @ w_down


def causal_dwconv(x, w, b):
    S = x.shape[1]
    xp = jnp.pad(x, ((0, 0), (CONV_W - 1, 0), (0, 0)))
    out = b
    for k in range(CONV_W):
        out = out + xp[:, k:k + S] * w[k]
    return out


def rglru_mixer(h, w_in, conv_w, conv_b, w_a, b_a, w_x, b_x, lam, w_out):
    B, S, _ = h.shape
    u = h @ w_in
    gate_branch, rec = jnp.split(u, 2, axis=-1)
    xc = causal_dwconv(rec, conv_w, conv_b)
    xh = xc.reshape(B, S, RG_HEADS, RG_BLOCK)
    r = jax.nn.sigmoid((jnp.einsum('bshi,hij->bshj', xh, w_a).reshape(B, S, D_RNN) + b_a).astype(jnp.float32))
    i = jax.nn.sigmoid((jnp.einsum('bshi,hij->bshj', xh, w_x).reshape(B, S, D_RNN) + b_x).astype(jnp.float32))
    log_a = -RG_C * r * jax.nn.softplus(-lam.astype(jnp.float32))
    a = jnp.exp(log_a)
    mult = jnp.sqrt(-jnp.expm1(2.0 * log_a))
    b_in = mult * i * xc.astype(jnp.float32)

    def combine(left, right):
        a1, b1 = left
        a2, b2 = right
        return a1 * a2, a2 * b1 + b2

    _, hs = lax.associative_scan(combine, (a, b_in), axis=1)
    y = hs.astype(h.dtype) * jax.nn.gelu(gate_branch)
    return y @ w_out


def rope(x, positions):
    R = x.shape[-1]
    inv_freq = 1.0 / (ROPE_THETA ** (jnp.arange(0, R, 2, dtype=jnp.float32) / R))
    ang = positions.astype(jnp.float32)[..., None] * inv_freq
    cos = jnp.cos(ang)[:, :, None, :].astype(x.dtype)
    sin = jnp.sin(ang)[:, :, None, :].astype(x.dtype)
    x1, x2 = jnp.split(x, 2, axis=-1)
    return jnp.concatenate([x1 * cos - x2 * sin, x2 * cos + x1 * sin], axis=-1)


def mla_mixer(h, positions, w_in, q_norm, w_q_up, kv_norm, w_kv_up, w_out):
    B, S, _ = h.shape
    u = h @ w_in
    c_q = u[..., :Q_LORA]
    c_kv = u[..., Q_LORA:Q_LORA + KV_LORA]
    k_pe = u[..., Q_LORA + KV_LORA:]
    q = (rms_norm(c_q, q_norm) @ w_q_up).reshape(B, S, MLA_HEADS, QK_DIM)
    q = jnp.concatenate([q[..., :QK_NOPE], rope(q[..., QK_NOPE:], positions)], axis=-1)
    k_pe = rope(k_pe[:, :, None, :], positions)
    kv = (rms_norm(c_kv, kv_norm) @ w_kv_up).reshape(B, S, MLA_HEADS, QK_NOPE + V_DIM)
    k_nope, v = kv[..., :QK_NOPE], kv[..., QK_NOPE:]
    k = jnp.concatenate([k_nope, jnp.broadcast_to(k_pe, (B, S, MLA_HEADS, QK_ROPE))], axis=-1)
    scale = QK_DIM ** -0.5
    outs = []
    for s0 in range(0, S, Q_BLOCK):
        s1 = s0 + Q_BLOCK
        sc = jnp.einsum('bqhd,bkhd->bhqk', q[:, s0:s1], k[:, :s1],
                        preferred_element_type=jnp.float32) * scale
        q_idx = s0 + jnp.arange(Q_BLOCK)[:, None]
        k_idx = jnp.arange(s1)[None, :]
        sc = jnp.where(k_idx <= q_idx, sc, -jnp.inf)
        p = jax.nn.softmax(sc, axis=-1).astype(v.dtype)
        outs.append(jnp.einsum('bhqk,bkhv->bqhv', p, v[:, :s1]))
    o = jnp.concatenate(outs, axis=1).reshape(B, S, MLA_HEADS * V_DIM)
    return o @ w_out


def moe_swiglu(h, w_router, we_gate, we_up, we_down):
    B, S, D = h.shape
    N = B * S
    t = h.reshape(N, D)
    logits = jnp.dot(t, w_router, preferred_element_type=jnp.float32)
    top_v, top_e = lax.top_k(logits, TOP_K)
    gates = jax.nn.softmax(top_v, axis=-1)
    flat_e = top_e.reshape(-1)
    order = jnp.argsort(flat_e)
    e_sorted = flat_e[order]
    tok_sorted = order // TOP_K
    g_sorted = gates.reshape(-1)[order]
    counts = jnp.bincount(flat_e, length=N_EXPERTS)
    padded = ((counts + MOE_BLOCK - 1) // MOE_BLOCK) * MOE_BLOCK
    pad_end = jnp.cumsum(padded)
    pad_start = pad_end - padded
    start = jnp.cumsum(counts) - counts
    j = jnp.arange(N * TOP_K)
    dest = pad_start[e_sorted] + (j - start[e_sorted])
    P = ((N * TOP_K + MOE_BLOCK - 1) // MOE_BLOCK) * MOE_BLOCK + N_EXPERTS * MOE_BLOCK
    n_blocks = P // MOE_BLOCK
    buf = jnp.zeros((P, D), h.dtype).at[dest].set(t[tok_sorted])
    block_e = jnp.minimum(jnp.searchsorted(pad_end, jnp.arange(n_blocks) * MOE_BLOCK, side='right'),
                          N_EXPERTS - 1)

    def expert_block(args):
        xb, e = args
        return swiglu(xb, we_gate[e], we_up[e], we_down[e])

    y_buf = lax.map(expert_block, (buf.reshape(n_blocks, MOE_BLOCK, D), block_e)).reshape(P, D)
    y = y_buf[dest] * g_sorted[:, None].astype(h.dtype)
    out = jax.ops.segment_sum(y, tok_sorted, num_segments=N)
    return out.reshape(B, S, D)


def setup_inputs(seed: int = 0) -> dict:
    key = jax.random.key(seed)
    ks = iter(jax.random.split(key, 40))
    f32 = jnp.float32

    def w(shape, fan_in):
        return jax.random.normal(next(ks), shape, f32) * (fan_in ** -0.5)

    def gain(shape):
        return 1.0 + 0.02 * jax.random.normal(next(ks), shape, f32)

    def bias(shape):
        return 0.02 * jax.random.normal(next(ks), shape, f32)

    nA, nB = N_A_LAYERS, N_B_LAYERS
    x = jax.random.normal(next(ks), (BATCH, SEQ, D_MODEL), f32)
    positions = jnp.broadcast_to(jnp.arange(SEQ, dtype=jnp.int32), (BATCH, SEQ))
    a_base = jax.random.uniform(next(ks), (nA, D_RNN), f32, minval=0.9, maxval=0.999)
    rg_lambda = jnp.log(a_base) - jnp.log1p(-a_base)
    return {
        "x": x,
        "positions": positions,
        "a_norm_mix": gain((nA, D_MODEL)),
        "rg_w_in": w((nA, D_MODEL, 2 * D_RNN), D_MODEL),
        "rg_conv_w": w((nA, CONV_W, D_RNN), CONV_W),
        "rg_conv_b": bias((nA, D_RNN)),
        "rg_w_a": w((nA, RG_HEADS, RG_BLOCK, RG_BLOCK), RG_BLOCK),
        "rg_b_a": bias((nA, D_RNN)),
        "rg_w_x": w((nA, RG_HEADS, RG_BLOCK, RG_BLOCK), RG_BLOCK),
        "rg_b_x": bias((nA, D_RNN)),
        "rg_lambda": rg_lambda,
        "rg_w_out": w((nA, D_RNN, D_MODEL), D_RNN),
        "a_norm_ffn": gain((nA, D_MODEL)),
        "ff_w_gate": w((nA, D_MODEL, D_FF), D_MODEL),
        "ff_w_up": w((nA, D_MODEL, D_FF), D_MODEL),
        "ff_w_down": w((nA, D_FF, D_MODEL), D_FF),
        "b_norm_mix": gain((nB, D_MODEL)),
        "mla_w_in": w((nB, D_MODEL, Q_LORA + KV_LORA + QK_ROPE), D_MODEL),
        "mla_q_norm": gain((nB, Q_LORA)),
        "mla_w_q_up": w((nB, Q_LORA, MLA_HEADS * QK_DIM), Q_LORA),
        "mla_kv_norm": gain((nB, KV_LORA)),
        "mla_w_kv_up": w((nB, KV_LORA, MLA_HEADS * (QK_NOPE + V_DIM)), KV_LORA),
        "mla_w_out": w((nB, MLA_HEADS * V_DIM, D_MODEL), MLA_HEADS * V_DIM),
        "b_norm_ffn": gain((nB, D_MODEL)),
        "moe_w_router": w((nB, D_MODEL, N_EXPERTS), D_MODEL),
        "moe_w_gate": w((nB, N_EXPERTS, D_MODEL, D_FF), D_MODEL),
        "moe_w_up": w((nB, N_EXPERTS, D_MODEL, D_FF), D_MODEL),
        "moe_w_down": w((nB, N_EXPERTS, D_FF, D_MODEL), D_FF),
        "final_norm": gain((D_MODEL,)),
    }


def reference(x, positions, a_norm_mix, rg_w_in, rg_conv_w, rg_conv_b, rg_w_a, rg_b_a, rg_w_x, rg_b_x,
              rg_lambda, rg_w_out, a_norm_ffn, ff_w_gate, ff_w_up, ff_w_down, b_norm_mix, mla_w_in,
              mla_q_norm, mla_w_q_up, mla_kv_norm, mla_w_kv_up, mla_w_out, b_norm_ffn, moe_w_router,
              moe_w_gate, moe_w_up, moe_w_down, final_norm):
    for i in range(DEPTH):
        li = i // N_MIXERS
        if i % N_MIXERS == 0:
            x = x + rglru_mixer(rms_norm(x, a_norm_mix[li]), rg_w_in[li], rg_conv_w[li], rg_conv_b[li],
                                rg_w_a[li], rg_b_a[li], rg_w_x[li], rg_b_x[li], rg_lambda[li], rg_w_out[li])
            x = x + swiglu(rms_norm(x, a_norm_ffn[li]), ff_w_gate[li], ff_w_up[li], ff_w_down[li])
        else:
            x = x + mla_mixer(rms_norm(x, b_norm_mix[li]), positions, mla_w_in[li], mla_q_norm[li],
                              mla_w_q_up[li], mla_kv_norm[li], mla_w_kv_up[li], mla_w_out[li])
            x = x + moe_swiglu(rms_norm(x, b_norm_ffn[li]), moe_w_router[li], moe_w_gate[li],
                               moe_w_up[li], moe_w_down[li])
    return rms_norm(x, final_norm)
```

```cpp
#include <hip/hip_runtime.h>
#include <cstdio>
#include <cstdint>

#define GAS __attribute__((address_space(1)))
#define LAS __attribute__((address_space(3)))
typedef unsigned short bf16_t;
typedef short bf16x8 __attribute__((ext_vector_type(8)));
typedef short s16x4 __attribute__((ext_vector_type(4)));
typedef float f32x2 __attribute__((ext_vector_type(2)));
typedef float f32x4 __attribute__((ext_vector_type(4)));
typedef float f32x16 __attribute__((ext_vector_type(16)));
typedef unsigned u32x2 __attribute__((ext_vector_type(2)));
typedef unsigned u32x4 __attribute__((ext_vector_type(4)));

constexpr int D = 2048, SEQ = 4096, NBATCH = 4, M = NBATCH * SEQ;
constexpr int NH = 16, QLORA = 512, KVLORA = 512, NOPE = 128, ROPE = 64, VDIM = 128, QKD = 192;
constexpr int MLA_IN = 1088, MLA_IN_PAD = 1280;
constexpr int FF = 7168, NE = 8;
constexpr int PMAX = 2 * M + NE * 256;
constexpr int MAXT = PMAX / 256;
constexpr float EPS = 1e-6f;
constexpr float QSCALE = 0.10411754627697264f;
constexpr int GRID = 256, NWAVES = 8, NTHREADS = 512;
constexpr int RPB = M / GRID;
constexpr int SCH = 64, NCH = SEQ / SCH;

constexpr size_t MiB = 1u << 20;
constexpr size_t WS_CTL = 0, CTL_ZERO_BYTES = 64 * 1024;
constexpr size_t WS_TAB = 1 * MiB;
constexpr size_t TAB_CSP = WS_TAB, TAB_CNT = WS_TAB + 64 * 1024, TAB_TILE = WS_TAB + 128 * 1024, TAB_SLOT = WS_TAB + 256 * 1024,
                 TAB_GATE = WS_TAB + 512 * 1024, TAB_TOPE = WS_TAB + 768 * 1024;
constexpr size_t WS_AGGA = 2 * MiB, WS_AGGB = 4 * MiB;
constexpr size_t W_IN1 = 8 * MiB, W_GATE = 24 * MiB, W_OUT1 = 26 * MiB, W_FFGU = 34 * MiB, W_FFD = 90 * MiB, W_MLAIN = 118 * MiB,
                 W_QUP = 123 * MiB, W_KVUP = 126 * MiB, W_MLAO = 130 * MiB, W_MOEGU = 138 * MiB, W_MOED = 586 * MiB;
constexpr size_t WS_XB = 810 * MiB, WS_ACT = 874 * MiB;
constexpr size_t A_U = WS_ACT, A_XC = WS_ACT + 128 * MiB, A_AV = WS_ACT + 192 * MiB, A_BV = WS_ACT + 320 * MiB, A_Y = WS_ACT + 448 * MiB;
constexpr size_t A_H = WS_ACT;
constexpr size_t A_KPP = WS_ACT + 48 * MiB;
constexpr size_t A_CST = WS_ACT + 88 * MiB;
constexpr size_t A_CU = WS_ACT, A_CQ = WS_ACT + 80 * MiB, A_CKV = WS_ACT + 96 * MiB, A_KPE = WS_ACT + 112 * MiB, A_Q = WS_ACT + 114 * MiB,
                 A_KV = WS_ACT + 210 * MiB, A_O = WS_ACT + 338 * MiB;
constexpr size_t A_YP = WS_ACT + 400 * MiB;
constexpr int MAIN_TILES = 128, KSPLIT = 4;
constexpr size_t A_BUF = WS_ACT, A_HM = WS_ACT + 136 * MiB, A_YM = WS_ACT + 612 * MiB, WS_END = WS_ACT + 748 * MiB;
static_assert((size_t)PMAX * D * 2 <= 136 * MiB && (size_t)PMAX * FF * 2 <= 476 * MiB, "moe buffers");

constexpr int RING_BYTES = 135168;
constexpr int LDSCTL_OFF = RING_BYTES;
constexpr int LDS_BYTES = 147456;

__device__ const double INV_FREQ[32] = {1.0, 0.7498942093324559, 0.5623413251903491, 0.4216965034285822, 0.31622776601683794, 0.23713737056616552, 0.1778279410038923, 0.1333521432163324, 0.1,
    0.07498942093324558, 0.05623413251903491, 0.042169650342858224, 0.03162277660168379, 0.023713737056616554, 0.01778279410038923, 0.01333521432163324, 0.01, 0.007498942093324558,
    0.005623413251903491, 0.004216965034285823, 0.0031622776601683794, 0.0023713737056616554, 0.0017782794100389228, 0.001333521432163324, 0.001, 0.0007498942093324559, 0.0005623413251903491,
    0.00042169650342858224, 0.00031622776601683794, 0.00023713737056616554, 0.00017782794100389227, 0.0001333521432163324};

__device__ __forceinline__ int opaque_tid() { int t = threadIdx.x; asm volatile("" : "+v"(t)); return t; }
#define LDS_WAIT() asm volatile("s_waitcnt lgkmcnt(0)" ::: "memory")
#define VM_WAIT() asm volatile("s_waitcnt vmcnt(0)" ::: "memory")
__device__ __forceinline__ unsigned cvtpk(float lo, float hi) { unsigned r; asm volatile("v_cvt_pk_bf16_f32 %0, %1, %2" : "=v"(r) : "v"(lo), "v"(hi)); return r; }
typedef int v8i __attribute__((ext_vector_type(8)));
typedef short v2s __attribute__((ext_vector_type(2)));
typedef __bf16 v2bf __attribute__((ext_vector_type(2)));
typedef int v4i __attribute__((ext_vector_type(4)));
__device__ __forceinline__ unsigned pk4_fp8(float a, float b, float c, float d) {
    a = __builtin_amdgcn_fmed3f(a, -448.f, 448.f); b = __builtin_amdgcn_fmed3f(b, -448.f, 448.f); c = __builtin_amdgcn_fmed3f(c, -448.f, 448.f); d = __builtin_amdgcn_fmed3f(d, -448.f, 448.f);
    int w = __builtin_amdgcn_cvt_pk_fp8_f32(a, b, 0, false); w = __builtin_amdgcn_cvt_pk_fp8_f32(c, d, w, true); return (unsigned)w; }
__device__ __forceinline__ unsigned pk4_i8(float a, float b, float c, float d) {
    const unsigned ua = __float_as_uint(__builtin_amdgcn_fmed3f(a, -127.f, 127.f) + 12582912.f), ub = __float_as_uint(__builtin_amdgcn_fmed3f(b, -127.f, 127.f) + 12582912.f);
    const unsigned uc = __float_as_uint(__builtin_amdgcn_fmed3f(c, -127.f, 127.f) + 12582912.f), ud = __float_as_uint(__builtin_amdgcn_fmed3f(d, -127.f, 127.f) + 12582912.f);
    const unsigned t1 = __builtin_amdgcn_perm(ub, ua, 0x0c0c0400u), t2 = __builtin_amdgcn_perm(ud, uc, 0x0c0c0400u);
    return __builtin_amdgcn_perm(t2, t1, 0x05040100u); }
typedef float v16f __attribute__((ext_vector_type(16)));
typedef unsigned v6u __attribute__((ext_vector_type(6)));
typedef int v6i __attribute__((ext_vector_type(6)));
typedef int v2i __attribute__((ext_vector_type(2)));
__device__ __forceinline__ v6u pk32_fp6(const float (&x)[32]) {
    v16f a, b;
#pragma unroll
    for (int i = 0; i < 16; ++i) { a[i] = __builtin_amdgcn_fmed3f(x[i], -7.5f, 7.5f); b[i] = __builtin_amdgcn_fmed3f(x[16 + i], -7.5f, 7.5f); }
    return __builtin_amdgcn_cvt_scalef32_2xpk16_fp6_f32(a, b, 1.0f);
}
__device__ __forceinline__ float bf2f(unsigned short u) { return __uint_as_float((unsigned)u << 16); }
__device__ __forceinline__ float bflo(unsigned w) { return __uint_as_float(w << 16); }
__device__ __forceinline__ float bfhi(unsigned w) { return __uint_as_float(w & 0xffff0000u); }
__device__ __forceinline__ float wave_sum(float v) {
#pragma unroll
    for (int o = 1; o < 64; o <<= 1) v += __shfl_xor(v, o);
    return v;
}
__device__ __forceinline__ float dot4(f32x4 a) { return (a.x * a.x + a.y * a.y) + (a.z * a.z + a.w * a.w); }
__device__ __forceinline__ float sigmoidf_(float x) { return __builtin_amdgcn_rcpf(1.0f + __expf(-x)); }
__device__ __forceinline__ float gelu_tanh(float x) { const float u = 1.5957691216057308f * (x + 0.044715f * x * x * x); return x * sigmoidf_(u); }

namespace pg8 {
constexpr int BM = 256, BK = 64, HALF = 128, HTB = HALF * BK * 2, STAGE_BYTES = 8 * HTB, NXCD = 8, WGM = 8;
__host__ __device__ __forceinline__ int lds_byte(int r, int c) { const int st = (r >> 4) * 2 + (c >> 5), rr = r & 15, cc = c & 31, ob = rr * 64 + cc * 2; return st * 1024 + (ob ^ (((ob >> 9) & 1) << 5)); }
__host__ __device__ __forceinline__ void stage_rc(int b, int& R, int& C) { const int st = b / 1024, sb = b % 1024, swz = sb ^ (((sb >> 9) & 1) << 5); R = (st >> 1) * 16 + swz / 64; C = (st & 1) * 32 + (swz % 64) / 2; }
__host__ __device__ __forceinline__ int perm32(int rho) { const int n = rho >> 4, i = rho & 15; return 8 * (i >> 2) + 4 * n + (i & 3); }

struct Unit { int pm, pn; size_t aoff, boff; };
struct Gemm { const bf16_t* A; const bf16_t* Bt; int lda, ldb, K; };

struct TileOrder {
    int nM, nN, nwg, G, c;
    __host__ __device__ void init(int nM_, int nN_, int G_, int c_) { nM = nM_; nN = nN_; nwg = nM * nN; G = G_; c = c_; }
    __host__ __device__ bool tile(int i, int& pm, int& pn) const {
        const long L = (long)i * G + c; if (L >= nwg) return false;
        int wgid = (int)L; { const int q = nwg / NXCD, r = nwg % NXCD, xcd = wgid % NXCD, off = wgid / NXCD; wgid = (xcd < r ? xcd * (q + 1) : r * (q + 1) + (xcd - r) * q) + off; }
        const int nig = WGM * nN, gid = wgid / nig, fm = gid * WGM, gsz = (nM - fm) < WGM ? (nM - fm) : WGM;
        pm = fm + ((wgid % nig) % gsz); pn = (wgid % nig) / gsz; return true;
    }
};
struct SchedPlain {
    TileOrder T; size_t atile, btile;
    __device__ __forceinline__ bool next(int i, Unit& u) const { if (!T.tile(i, u.pm, u.pn)) return false; u.aoff = (size_t)u.pm * atile; u.boff = (size_t)u.pn * btile; return true; }
    __device__ __forceinline__ void a_ready(const Unit&) const {}
    __device__ __forceinline__ void done(const Unit&) const {}
};
struct SchedKSplit {
    int G, c, nM, KS, pn0; size_t atile, btile, kbytes;
    __device__ __forceinline__ bool next(int i, Unit& u) const { const int L = i * G + c; if (L >= nM * KS) return false; const int kc = L / nM; u.pm = L - kc * nM; u.pn = pn0 + kc;
        u.aoff = (size_t)u.pm * atile + (size_t)kc * kbytes; u.boff = (size_t)pn0 * btile + (size_t)kc * kbytes; return true; }
    __device__ __forceinline__ void a_ready(const Unit&) const {}
    __device__ __forceinline__ void done(const Unit&) const {}
};
struct SchedMoeSplit {
    int G, c, pm0, ntl, nN, KS; const LAS int* tile_e; size_t atile, btile, kbytes;
    __device__ __forceinline__ bool next(int i, Unit& u) const { const int L = i * G + c; if (L >= ntl * KS) return false; const int kc = L / ntl, t = L - kc * ntl, pn = t % nN; u.pm = pm0 + t / nN; u.pn = pn + nN * kc;
        const int e = tile_e[u.pm] & 7; u.aoff = (size_t)u.pm * atile + (size_t)kc * kbytes; u.boff = ((size_t)e * nN + pn) * btile + (size_t)kc * kbytes; return true; }
    __device__ __forceinline__ void a_ready(const Unit&) const {}
    __device__ __forceinline__ void done(const Unit&) const {}
};
struct SchedGate {
    TileOrder T;
    __device__ __forceinline__ bool next(int i, Unit& u) const { if (!T.tile(i, u.pm, u.pn)) return false; u.aoff = (size_t)u.pm * 256 * D * 2 + (size_t)(u.pn >> 1) * 512; u.boff = (size_t)u.pn * 256 * 256 * 2; return true; }
    __device__ __forceinline__ void a_ready(const Unit&) const {}
    __device__ __forceinline__ void done(const Unit&) const {}
};
struct SchedMoe {
    TileOrder T; const LAS int* tile_e; size_t atile, btile; int nN;
    __device__ __forceinline__ bool next(int i, Unit& u) const { if (!T.tile(i, u.pm, u.pn)) return false; const int e = tile_e[u.pm] & 7; u.aoff = (size_t)u.pm * atile; u.boff = ((size_t)e * nN + u.pn) * btile; return true; }
    __device__ __forceinline__ void a_ready(const Unit&) const {}
    __device__ __forceinline__ void done(const Unit&) const {}
};

typedef f32x4 Acc[2][2][4][2];
struct EpiBf16 {
    static constexpr bool PERM = true;
    bf16_t* O; int ldc; float scale;
    __device__ __forceinline__ void operator()(const Acc& acc, const Unit& u, int wr, int wc, int fr, int fq) const {
        const int row0 = u.pm * BM + wr * 64 + fr, col0 = u.pn * BM + wc * 32 + 8 * fq;
#pragma unroll
        for (int ai = 0; ai < 2; ++ai)
#pragma unroll
            for (int m = 0; m < 4; ++m) { bf16_t* rowp = O + (size_t)(row0 + ai * HALF + m * 16) * ldc + col0;
#pragma unroll
                for (int bj = 0; bj < 2; ++bj) { const f32x4 v0 = acc[ai][bj][m][0] * scale, v1 = acc[ai][bj][m][1] * scale;
                    u32x4 w; w.x = cvtpk(v0[0], v0[1]); w.y = cvtpk(v0[2], v0[3]); w.z = cvtpk(v1[0], v1[1]); w.w = cvtpk(v1[2], v1[3]);
                    *(u32x4*)(rowp + bj * HALF) = w; } }
    }
};
struct EpiFp8 {
    static constexpr bool PERM = true;
    unsigned char* O; int ldc; float scale;
    __device__ __forceinline__ void operator()(const Acc& acc, const Unit& u, int wr, int wc, int fr, int fq) const {
        const int row0 = u.pm * BM + wr * 64 + fr, col0 = u.pn * BM + wc * 32 + 8 * fq;
#pragma unroll
        for (int ai = 0; ai < 2; ++ai)
#pragma unroll
            for (int m = 0; m < 4; ++m) { unsigned char* rowp = O + (size_t)(row0 + ai * HALF + m * 16) * ldc + col0;
#pragma unroll
                for (int bj = 0; bj < 2; ++bj) { const f32x4 v0 = acc[ai][bj][m][0] * scale, v1 = acc[ai][bj][m][1] * scale;
                    u32x2 w; w.x = pk4_fp8(v0[0], v0[1], v0[2], v0[3]); w.y = pk4_fp8(v1[0], v1[1], v1[2], v1[3]);
                    *(u32x2*)(rowp + bj * HALF) = w; } }
    }
};
struct EpiBf16Split {
    static constexpr bool PERM = true;
    bf16_t* O; int ldc; float scale; size_t kstride;
    __device__ __forceinline__ void operator()(const Acc& acc, const Unit& u, int wr, int wc, int fr, int fq) const {
        const int row0 = u.pm * BM + wr * 64 + fr, col0 = (u.pn & 7) * BM + wc * 32 + 8 * fq;
        bf16_t* Ob = O + (size_t)(u.pn >> 3) * kstride;
#pragma unroll
        for (int ai = 0; ai < 2; ++ai)
#pragma unroll
            for (int m = 0; m < 4; ++m) { bf16_t* rowp = Ob + (size_t)(row0 + ai * HALF + m * 16) * ldc + col0;
#pragma unroll
                for (int bj = 0; bj < 2; ++bj) { const f32x4 v0 = acc[ai][bj][m][0] * scale, v1 = acc[ai][bj][m][1] * scale;
                    u32x4 w; w.x = cvtpk(v0[0], v0[1]); w.y = cvtpk(v0[2], v0[3]); w.z = cvtpk(v1[0], v1[1]); w.w = cvtpk(v1[2], v1[3]);
                    *(u32x4*)(rowp + bj * HALF) = w; } }
    }
};
struct EpiKpe {
    static constexpr bool PERM = false;
    float* O; int pn0; float scale;
    __device__ __forceinline__ void operator()(const Acc& acc, const Unit& u, int wr, int wc, int fr, int fq) const {
        if (wc >= 2) return;
        const int kc = u.pn - pn0, row0 = u.pm * BM + wr * 64 + fr, col0 = wc * 32 + 4 * fq;
#pragma unroll
        for (int ai = 0; ai < 2; ++ai)
#pragma unroll
            for (int m = 0; m < 4; ++m) { float* rowp = O + ((size_t)kc * M + row0 + ai * HALF + m * 16) * 64 + col0;
#pragma unroll
                for (int n = 0; n < 2; ++n) *(f32x4*)(rowp + n * 16) = acc[ai][0][m][n] * scale; }
    }
};
struct EpiF32 {
    static constexpr bool PERM = false;
    float* O; int ldc; float scale;
    __device__ __forceinline__ void operator()(const Acc& acc, const Unit& u, int wr, int wc, int fr, int fq) const {
        const int row0 = u.pm * BM + wr * 64 + fr, col0 = u.pn * BM + wc * 32 + 4 * fq;
#pragma unroll
        for (int ai = 0; ai < 2; ++ai)
#pragma unroll
            for (int m = 0; m < 4; ++m) { float* rowp = O + (size_t)(row0 + ai * HALF + m * 16) * ldc + col0;
#pragma unroll
                for (int bj = 0; bj < 2; ++bj)
#pragma unroll
                    for (int n = 0; n < 2; ++n) *(f32x4*)(rowp + bj * HALF + n * 16) = acc[ai][bj][m][n] * scale; }
    }
};
struct EpiResidual {
    static constexpr bool PERM = false;
    const float* res; float* out; int ldc; float scale;
    __device__ __forceinline__ void operator()(const Acc& acc, const Unit& u, int wr, int wc, int fr, int fq) const {
        const int row0 = u.pm * BM + wr * 64 + fr, col0 = u.pn * BM + wc * 32 + 4 * fq;
        f32x4 ra[2][2][2], rb[2][2][2];
#define ER_LOAD(R, ai, mp) do { _Pragma("unroll") for (int m2 = 0; m2 < 2; ++m2) { const size_t off = (size_t)(row0 + (ai) * HALF + ((mp) * 2 + m2) * 16) * ldc + col0; \
            _Pragma("unroll") for (int bj = 0; bj < 2; ++bj) _Pragma("unroll") for (int n = 0; n < 2; ++n) R[m2][bj][n] = *(const f32x4*)(res + off + bj * HALF + n * 16); } } while (0)
#define ER_STORE(R, ai, mp) do { _Pragma("unroll") for (int m2 = 0; m2 < 2; ++m2) { const size_t off = (size_t)(row0 + (ai) * HALF + ((mp) * 2 + m2) * 16) * ldc + col0; \
            _Pragma("unroll") for (int bj = 0; bj < 2; ++bj) _Pragma("unroll") for (int n = 0; n < 2; ++n) *(f32x4*)(out + off + bj * HALF + n * 16) = R[m2][bj][n] + acc[ai][bj][(mp) * 2 + m2][n] * scale; } } while (0)
        ER_LOAD(ra, 0, 0);
        ER_LOAD(rb, 0, 1); ER_STORE(ra, 0, 0);
        ER_LOAD(ra, 1, 0); ER_STORE(rb, 0, 1);
        ER_LOAD(rb, 1, 1); ER_STORE(ra, 1, 0);
        ER_STORE(rb, 1, 1);
#undef ER_LOAD
#undef ER_STORE
    }
};
template <int FP8OUT>
struct EpiSwiglu {
    static constexpr bool PERM = true;
    void* H; int ldc; float in_scale, out_scale;
    __device__ __forceinline__ void operator()(const Acc& acc, const Unit& u, int wr, int wc, int fr, int fq) const {
        const int row0 = u.pm * BM + wr * 64 + fr, col0 = u.pn * HALF + wc * 32 + 8 * fq;
        const float k_ = in_scale * in_scale * out_scale, c1 = -in_scale * 1.4426950408889634f, c0 = -__builtin_log2f(k_), c3 = 1.0f / k_;
#pragma unroll
        for (int ai = 0; ai < 2; ++ai)
#pragma unroll
            for (int m = 0; m < 4; ++m) { const size_t off = (size_t)(row0 + ai * HALF + m * 16) * ldc + col0;
                float h[8];
#pragma unroll
                for (int n = 0; n < 2; ++n)
#pragma unroll
                    for (int e = 0; e < 4; ++e) { const float a0 = acc[ai][0][m][n][e], a1 = acc[ai][1][m][n][e];
                        h[n * 4 + e] = (a0 * a1) * __builtin_amdgcn_rcpf(c3 + __builtin_amdgcn_exp2f(fmaf(a0, c1, c0))); }
                if constexpr (FP8OUT == 2) { u32x2 w; w.x = pk4_i8(h[0], h[1], h[2], h[3]); w.y = pk4_i8(h[4], h[5], h[6], h[7]); *(u32x2*)((unsigned char*)H + off) = w; }
                else if constexpr (FP8OUT == 1) { u32x2 w; w.x = pk4_fp8(h[0], h[1], h[2], h[3]); w.y = pk4_fp8(h[4], h[5], h[6], h[7]); *(u32x2*)((unsigned char*)H + off) = w; }
                else { u32x4 w; w.x = cvtpk(h[0], h[1]); w.y = cvtpk(h[2], h[3]); w.z = cvtpk(h[4], h[5]); w.w = cvtpk(h[6], h[7]); *(u32x4*)((bf16_t*)H + off) = w; } }
    }
};
struct EpiGate {
    static constexpr bool PERM = true;
    const bf16_t* XC; const float* b_a; const float* b_x; const float* csp; unsigned* AB;
    __device__ __forceinline__ void operator()(const Acc& acc, const Unit& u, int wr, int wc, int fr, int fq) const {
        const int row0 = u.pm * BM + wr * 64 + fr, c0 = u.pn * HALF + wc * 32 + 8 * fq;
#pragma unroll
        for (int n = 0; n < 2; ++n) {
            const f32x4 ba = *(const f32x4*)(b_a + c0 + 4 * n) * -1.4426950408889634f, bx = *(const f32x4*)(b_x + c0 + 4 * n) * -1.4426950408889634f, sp = *(const f32x4*)(csp + c0 + 4 * n);
            u32x2 xws[2][4];
#pragma unroll
            for (int ai = 0; ai < 2; ++ai)
#pragma unroll
                for (int m = 0; m < 4; ++m) xws[ai][m] = *(const u32x2*)(XC + (size_t)(row0 + ai * HALF + m * 16) * D + c0 + 4 * n);
#pragma unroll
            for (int ai = 0; ai < 2; ++ai)
#pragma unroll
                for (int m = 0; m < 4; ++m) { const size_t off = (size_t)(row0 + ai * HALF + m * 16) * D + c0 + 4 * n;
                    const u32x2 xw = xws[ai][m];
                    const float xc[4] = {bflo(xw.x), bfhi(xw.x), bflo(xw.y), bfhi(xw.y)};
                    u32x4 pk;
#pragma unroll
                    for (int e = 0; e < 4; ++e) {
                        const float r = __builtin_amdgcn_rcpf(1.0f + __builtin_amdgcn_exp2f(fmaf(acc[ai][0][m][n][e], -1.4426950408889634f, ba[e]))), ig = __builtin_amdgcn_rcpf(1.0f + __builtin_amdgcn_exp2f(fmaf(acc[ai][1][m][n][e], -1.4426950408889634f, bx[e])));
                        const float la2 = -sp[e] * r;
                        const float om = fmaxf(1.0f - __builtin_amdgcn_exp2f(la2 + la2), 0.0f);
                        pk[e] = cvtpk(la2, __builtin_amdgcn_sqrtf(om) * ig * xc[e]); }
                    *(u32x4*)(AB + off) = pk; }
        }
    }
};

template <class Epi, class Sched>
__device__ __forceinline__ void gemm_phase(LAS unsigned char* lds, const Gemm g, const Sched& S, const Epi& E) {
    const int tid = opaque_tid(), wid = __builtin_amdgcn_readfirstlane(tid >> 6), lane = tid & 63, wr = wid >> 2, wc = wid & 3, fr = lane & 15, fq = lane >> 4;
    const int K = g.K, nt = K / BK;
    unsigned voffA[2], voffB[2];
#pragma unroll
    for (int i = 0; i < 2; ++i) { int R, C; stage_rc(tid * 16 + i * 8192, R, C); const int Rb = Epi::PERM ? ((R & ~31) + perm32(R & 31)) : R;
        voffA[i] = (unsigned)(R * g.lda + C) * 2u; voffB[i] = (unsigned)(Rb * g.ldb + C) * 2u; }
    const size_t kstep = (size_t)(BK * 2);
    const size_t hstepA = (size_t)HALF * g.lda * 2, hstepB = (size_t)HALF * g.ldb * 2;
    const unsigned ldsw = (unsigned)wid * 1024u;
    const int aoff = lds_byte(wr * 64 + fr, fq * 8), boff = lds_byte(wc * 32 + fr, fq * 8);
#define PG8_SA(b, h) (((b) * 2 + (h)) * HTB)
#define PG8_SB(b, h) ((4 + (b) * 2 + (h)) * HTB)
#define PG8_STAGE(bufoff, gbase, voff) do { _Pragma("unroll") for (int _i = 0; _i < 2; ++_i) \
        __builtin_amdgcn_global_load_lds((const unsigned*)((const char*)(gbase) + (voff)[_i]), (LAS unsigned*)(lds + (bufoff) + ldsw + _i * 8192), 16, 0, 0); } while (0)
#define PG8_LDA(dst, b, h) do { _Pragma("unroll") for (int m = 0; m < 4; ++m) _Pragma("unroll") for (int k = 0; k < 2; ++k) dst[m][k] = *(const LAS bf16x8*)(lds + PG8_SA(b, h) + aoff + m * 2048 + k * 1024); } while (0)
#define PG8_LDB(dst, b, h) do { _Pragma("unroll") for (int n = 0; n < 2; ++n) _Pragma("unroll") for (int k = 0; k < 2; ++k) dst[n][k] = *(const LAS bf16x8*)(lds + PG8_SB(b, h) + boff + n * 2048 + k * 1024); } while (0)
#define PG8_MMA(ai, bj, At, Bt) do { __builtin_amdgcn_s_setprio(1); _Pragma("unroll") for (int m = 0; m < 4; ++m) _Pragma("unroll") for (int n = 0; n < 2; ++n) _Pragma("unroll") for (int k = 0; k < 2; ++k) \
        acc[ai][bj][m][n] = __builtin_amdgcn_mfma_f32_16x16x32_bf16(Bt[n][k], At[m][k], acc[ai][bj][m][n], 0, 0, 0); __builtin_amdgcn_s_setprio(0); } while (0)
#define PG8_WAIT_V(n) asm volatile("s_waitcnt vmcnt(" #n ")" ::: "memory")
#define PG8_WAIT_L(n) asm volatile("s_waitcnt lgkmcnt(" #n ")" ::: "memory")
#define PG8_BAR __builtin_amdgcn_s_barrier()
#define PG8_SCHED __builtin_amdgcn_sched_barrier(0)
    Unit cur, nxt; int ui = 0;
    if (!S.next(0, cur)) return;
    Acc acc;
#pragma unroll
    for (int a = 0; a < 2; ++a)
#pragma unroll
        for (int b = 0; b < 2; ++b)
#pragma unroll
            for (int m = 0; m < 4; ++m)
#pragma unroll
                for (int n = 0; n < 2; ++n) acc[a][b][m][n] = (f32x4){0.f, 0.f, 0.f, 0.f};
    bf16x8 At[4][2], B0[2][2], B1[2][2];
    const char* cA = (const char*)g.A + cur.aoff; const char* cB = (const char*)g.Bt + cur.boff;
    S.a_ready(cur);
    PG8_STAGE(PG8_SB(0, 0), cB, voffB); PG8_STAGE(PG8_SB(0, 1), cB + hstepB, voffB); PG8_STAGE(PG8_SA(0, 0), cA, voffA); PG8_STAGE(PG8_SA(0, 1), cA + hstepA, voffA);
    if (wr == 1) PG8_BAR;
    PG8_WAIT_V(2); PG8_BAR;
    PG8_STAGE(PG8_SB(1, 0), cB + kstep, voffB); PG8_STAGE(PG8_SA(1, 0), cA + kstep, voffA); PG8_STAGE(PG8_SB(1, 1), cB + hstepB + kstep, voffB);
    PG8_WAIT_V(6); PG8_BAR;
    for (;;) {
        const bool has_next = S.next(ui + 1, nxt);
        const char* nA = has_next ? (const char*)g.A + nxt.aoff : cA; const char* nB = has_next ? (const char*)g.Bt + nxt.boff : cB;
#pragma nounroll
        for (int t = 0; t < nt; t += 2) {
            const bool last = (t == nt - 2);
            const char* a1 = cA + (size_t)(t + 1) * kstep;
            const char* a2 = last ? nA : cA + (size_t)(t + 2) * kstep; const char* b2 = last ? nB : cB + (size_t)(t + 2) * kstep;
            const char* a3 = a2 + kstep; const char* b3 = b2 + kstep;
            if (last && has_next) S.a_ready(nxt);
            PG8_LDB(B0, 0, 0); PG8_LDB(B1, 0, 1); PG8_SCHED; PG8_LDA(At, 0, 0); PG8_STAGE(PG8_SA(1, 1), a1 + hstepA, voffA);
            PG8_WAIT_V(8); PG8_WAIT_L(0); PG8_BAR; PG8_MMA(0, 0, At, B0); PG8_MMA(0, 1, At, B1); PG8_BAR; PG8_SCHED;
            PG8_LDA(At, 0, 1); PG8_STAGE(PG8_SB(0, 0), b2, voffB); PG8_STAGE(PG8_SB(0, 1), b2 + hstepB, voffB); PG8_STAGE(PG8_SA(0, 0), a2, voffA);
            PG8_WAIT_V(8); PG8_WAIT_L(0); PG8_BAR; PG8_MMA(1, 0, At, B0); PG8_MMA(1, 1, At, B1); PG8_BAR; PG8_SCHED;
            PG8_LDB(B0, 1, 0); PG8_LDB(B1, 1, 1); PG8_SCHED; PG8_LDA(At, 1, 0); PG8_STAGE(PG8_SA(0, 1), a2 + hstepA, voffA);
            PG8_WAIT_V(8); PG8_WAIT_L(0); PG8_BAR; PG8_MMA(0, 0, At, B0); PG8_MMA(0, 1, At, B1); PG8_BAR; PG8_SCHED;
            PG8_LDA(At, 1, 1); PG8_STAGE(PG8_SB(1, 0), b3, voffB); PG8_STAGE(PG8_SB(1, 1), b3 + hstepB, voffB); PG8_STAGE(PG8_SA(1, 0), a3, voffA);
            PG8_WAIT_V(8); PG8_WAIT_L(0); PG8_BAR; PG8_MMA(1, 0, At, B0); PG8_MMA(1, 1, At, B1); PG8_BAR; PG8_SCHED;
        }
        if (wr == 0) PG8_BAR;
        E(acc, cur, wr, wc, fr, fq); S.done(cur);
        if (!has_next) break;
#pragma unroll
        for (int a = 0; a < 2; ++a)
#pragma unroll
            for (int b = 0; b < 2; ++b)
#pragma unroll
                for (int m = 0; m < 4; ++m)
#pragma unroll
                    for (int n = 0; n < 2; ++n) acc[a][b][m][n] = (f32x4){0.f, 0.f, 0.f, 0.f};
        cur = nxt; cA = nA; cB = nB; ++ui;
        if (wr == 1) PG8_BAR;
    }
    PG8_WAIT_V(0);
    PG8_BAR;
#undef PG8_SA
#undef PG8_SB
#undef PG8_STAGE
#undef PG8_LDA
#undef PG8_LDB
#undef PG8_MMA
#undef PG8_WAIT_V
#undef PG8_WAIT_L
#undef PG8_BAR
#undef PG8_SCHED
}

__host__ __device__ __forceinline__ int g8(int rr) { const int q = rr >> 1; return ((2 * q) & 7) | (q >> 2); }
__host__ __device__ __forceinline__ void stage_rc8(int b, int& R, int& Cb) { const int s = b >> 11, rr = (b >> 7) & 15, p = (b >> 4) & 7; R = s * 16 + rr; Cb = (p ^ g8(rr)) << 4; }
__host__ __device__ __forceinline__ int lds_byte8(int r, int c) { const int rr = r & 15; return (r >> 4) * 2048 + rr * 128 + ((c ^ g8(rr)) << 4); }
template <bool FP6> struct Frag8 { typedef v8i T; };
template <> struct Frag8<true> { typedef v6i T; };
template <class Epi, class Sched, int MODE = 0>
__device__ __forceinline__ void gemm_phase8(LAS unsigned char* lds, const Gemm g, const Sched& S, const Epi& E) {
    constexpr bool FP6 = (MODE == 1);
    const int tid = opaque_tid(), wid = __builtin_amdgcn_readfirstlane(tid >> 6), lane = tid & 63, wr = wid >> 2, wc = wid & 3, fr = lane & 15, fq = lane >> 4;
    const int K = g.K, nt = K / 128;
    unsigned voffA[2], voffB[2];
#pragma unroll
    for (int i = 0; i < 2; ++i) { int R, C; stage_rc8(tid * 16 + i * 8192, R, C); const int Rb = Epi::PERM ? ((R & ~31) + perm32(R & 31)) : R;
        voffA[i] = (unsigned)(R * g.lda + C); voffB[i] = (unsigned)(Rb * g.ldb + C); }
    const size_t kstep = 128;
    const size_t hstepA = (size_t)HALF * g.lda, hstepB = (size_t)HALF * g.ldb;
    const unsigned ldsw = (unsigned)wid * 1024u;
    const int aoff0 = lds_byte8(wr * 64 + fr, 2 * fq), aoff1 = lds_byte8(wr * 64 + fr, 2 * fq + 1), boff0 = lds_byte8(wc * 32 + fr, 2 * fq), boff1 = lds_byte8(wc * 32 + fr, 2 * fq + 1);
#define PG8_SA(b, h) (((b) * 2 + (h)) * HTB)
#define PG8_SB(b, h) ((4 + (b) * 2 + (h)) * HTB)
#define PG8_STAGE(bufoff, gbase, voff) do { _Pragma("unroll") for (int _i = 0; _i < 2; ++_i) \
        __builtin_amdgcn_global_load_lds((const unsigned*)((const char*)(gbase) + (voff)[_i]), (LAS unsigned*)(lds + (bufoff) + ldsw + _i * 8192), 16, 0, 0); } while (0)
#define PG8_LD1(dst, off0, off1) do { const v4i lo_ = *(const LAS v4i*)(lds + (off0)); \
        if constexpr (FP6) { const v2i hi_ = *(const LAS v2i*)(lds + (off1)); dst = (v6i){lo_[0], lo_[1], lo_[2], lo_[3], hi_[0], hi_[1]}; } \
        else { const v4i hi_ = *(const LAS v4i*)(lds + (off1)); dst = __builtin_shufflevector(lo_, hi_, 0, 1, 2, 3, 4, 5, 6, 7); } } while (0)
#define PG8_LDA(dst, b, h) do { _Pragma("unroll") for (int m = 0; m < 4; ++m) PG8_LD1(dst[m], PG8_SA(b, h) + aoff0 + m * 2048, PG8_SA(b, h) + aoff1 + m * 2048); } while (0)
#define PG8_LDB(dst, b, h) do { _Pragma("unroll") for (int n = 0; n < 2; ++n) PG8_LD1(dst[n], PG8_SB(b, h) + boff0 + n * 2048, PG8_SB(b, h) + boff1 + n * 2048); } while (0)
#define PG8_MMA(ai, bj, At, Bt) do { __builtin_amdgcn_s_setprio(1); \
        if constexpr (MODE == 2) { \
            _Pragma("unroll") for (int m = 0; m < 4; ++m) _Pragma("unroll") for (int n = 0; n < 2; ++n) { const v4i bl_ = __builtin_shufflevector(Bt[n], Bt[n], 0, 1, 2, 3), al_ = __builtin_shufflevector(At[m], At[m], 0, 1, 2, 3); \
                asm volatile("v_mfma_i32_16x16x64_i8 %0, %1, %2, %0" : "+v"(acc[ai][bj][m][n]) : "v"(bl_), "v"(al_)); } \
            _Pragma("unroll") for (int m = 0; m < 4; ++m) _Pragma("unroll") for (int n = 0; n < 2; ++n) { const v4i bh_ = __builtin_shufflevector(Bt[n], Bt[n], 4, 5, 6, 7), ah_ = __builtin_shufflevector(At[m], At[m], 4, 5, 6, 7); \
                asm volatile("v_mfma_i32_16x16x64_i8 %0, %1, %2, %0" : "+v"(acc[ai][bj][m][n]) : "v"(bh_), "v"(ah_)); } \
        } else { _Pragma("unroll") for (int m = 0; m < 4; ++m) _Pragma("unroll") for (int n = 0; n < 2; ++n) \
        { if constexpr (MODE == 1) asm volatile("v_mfma_f32_16x16x128_f8f6f4 %0, %1, %2, %0 cbsz:2 blgp:2" : "+v"(acc[ai][bj][m][n]) : "v"(Bt[n]), "v"(At[m])); \
          else asm volatile("v_mfma_f32_16x16x128_f8f6f4 %0, %1, %2, %0" : "+v"(acc[ai][bj][m][n]) : "v"(Bt[n]), "v"(At[m])); } } __builtin_amdgcn_s_setprio(0); } while (0)
#define PG8_WAIT_V(n) asm volatile("s_waitcnt vmcnt(" #n ")" ::: "memory")
#define PG8_WAIT_L(n) asm volatile("s_waitcnt lgkmcnt(" #n ")" ::: "memory")
#define PG8_BAR __builtin_amdgcn_s_barrier()
#define PG8_SCHED __builtin_amdgcn_sched_barrier(0)
    Unit cur, nxt; int ui = 0;
    if (!S.next(0, cur)) return;
    Acc acc;
#pragma unroll
    for (int a = 0; a < 2; ++a)
#pragma unroll
        for (int b = 0; b < 2; ++b)
#pragma unroll
            for (int m = 0; m < 4; ++m)
#pragma unroll
                for (int n = 0; n < 2; ++n) acc[a][b][m][n] = (f32x4){0.f, 0.f, 0.f, 0.f};
    typename Frag8<FP6>::T At[4], B0[2], B1[2];
    const char* cA = (const char*)g.A + cur.aoff; const char* cB = (const char*)g.Bt + cur.boff;
    S.a_ready(cur);
    PG8_STAGE(PG8_SB(0, 0), cB, voffB); PG8_STAGE(PG8_SB(0, 1), cB + hstepB, voffB); PG8_STAGE(PG8_SA(0, 0), cA, voffA); PG8_STAGE(PG8_SA(0, 1), cA + hstepA, voffA);
    if (wr == 1) PG8_BAR;
    PG8_WAIT_V(2); PG8_BAR;
    PG8_STAGE(PG8_SB(1, 0), cB + kstep, voffB); PG8_STAGE(PG8_SA(1, 0), cA + kstep, voffA); PG8_STAGE(PG8_SB(1, 1), cB + hstepB + kstep, voffB);
    PG8_WAIT_V(6); PG8_BAR;
    for (;;) {
        const bool has_next = S.next(ui + 1, nxt);
        const char* nA = has_next ? (const char*)g.A + nxt.aoff : cA; const char* nB = has_next ? (const char*)g.Bt + nxt.boff : cB;
#pragma nounroll
        for (int t = 0; t < nt; t += 2) {
            const bool last = (t == nt - 2);
            const char* a1 = cA + (size_t)(t + 1) * kstep;
            const char* a2 = last ? nA : cA + (size_t)(t + 2) * kstep; const char* b2 = last ? nB : cB + (size_t)(t + 2) * kstep;
            const char* a3 = a2 + kstep; const char* b3 = b2 + kstep;
            if (last && has_next) S.a_ready(nxt);
            PG8_LDB(B0, 0, 0); PG8_LDB(B1, 0, 1); PG8_SCHED; PG8_LDA(At, 0, 0); PG8_STAGE(PG8_SA(1, 1), a1 + hstepA, voffA);
            PG8_WAIT_V(8); PG8_WAIT_L(0); PG8_BAR; PG8_MMA(0, 0, At, B0); PG8_MMA(0, 1, At, B1); PG8_BAR; PG8_SCHED;
            PG8_LDA(At, 0, 1); PG8_STAGE(PG8_SB(0, 0), b2, voffB); PG8_STAGE(PG8_SB(0, 1), b2 + hstepB, voffB); PG8_STAGE(PG8_SA(0, 0), a2, voffA);
            PG8_WAIT_V(8); PG8_WAIT_L(0); PG8_BAR; PG8_MMA(1, 0, At, B0); PG8_MMA(1, 1, At, B1); PG8_BAR; PG8_SCHED;
            PG8_LDB(B0, 1, 0); PG8_LDB(B1, 1, 1); PG8_SCHED; PG8_LDA(At, 1, 0); PG8_STAGE(PG8_SA(0, 1), a2 + hstepA, voffA);
            PG8_WAIT_V(8); PG8_WAIT_L(0); PG8_BAR; PG8_MMA(0, 0, At, B0); PG8_MMA(0, 1, At, B1); PG8_BAR; PG8_SCHED;
            PG8_LDA(At, 1, 1); PG8_STAGE(PG8_SB(1, 0), b3, voffB); PG8_STAGE(PG8_SB(1, 1), b3 + hstepB, voffB); PG8_STAGE(PG8_SA(1, 0), a3, voffA);
            PG8_WAIT_V(8); PG8_WAIT_L(0); PG8_BAR; PG8_MMA(1, 0, At, B0); PG8_MMA(1, 1, At, B1); PG8_BAR; PG8_SCHED;
        }
        asm volatile("s_nop 15\n\ts_nop 15" ::: "memory");
        if (wr == 0) PG8_BAR;
        if constexpr (MODE == 2) {
#pragma unroll
            for (int a = 0; a < 2; ++a)
#pragma unroll
                for (int b = 0; b < 2; ++b)
#pragma unroll
                    for (int m = 0; m < 4; ++m)
#pragma unroll
                        for (int n = 0; n < 2; ++n)
                        { const f32x4 t_ = acc[a][b][m][n]; f32x4 r_;
                          r_.x = (float)__float_as_int(t_.x); r_.y = (float)__float_as_int(t_.y); r_.z = (float)__float_as_int(t_.z); r_.w = (float)__float_as_int(t_.w); acc[a][b][m][n] = r_; }
        }
        E(acc, cur, wr, wc, fr, fq); S.done(cur);
        if (!has_next) break;
#pragma unroll
        for (int a = 0; a < 2; ++a)
#pragma unroll
            for (int b = 0; b < 2; ++b)
#pragma unroll
                for (int m = 0; m < 4; ++m)
#pragma unroll
                    for (int n = 0; n < 2; ++n) acc[a][b][m][n] = (f32x4){0.f, 0.f, 0.f, 0.f};
        cur = nxt; cA = nA; cB = nB; ++ui;
        if (wr == 1) PG8_BAR;
    }
    PG8_WAIT_V(0);
    PG8_BAR;
#undef PG8_SA
#undef PG8_SB
#undef PG8_STAGE
#undef PG8_LDA
#undef PG8_LD1
#undef PG8_LDB
#undef PG8_MMA
#undef PG8_WAIT_V
#undef PG8_WAIT_L
#undef PG8_BAR
#undef PG8_SCHED
}
}

namespace att {
constexpr int KROW = 208, KBUF = 64 * KROW,     VROW = 80, VBUF = 128 * VROW,     VOFF = 2 * KBUF, LDS_TOTAL = VOFF + 3 * VBUF;
static_assert(LDS_TOTAL <= RING_BYTES, "attention LDS");
constexpr float THR = 4.5f, PSH = 4.f, QS8 = 16.f, OSC8 = 16.f;
__device__ __forceinline__ int crow(int r, int hi) { return (r & 3) + 8 * (r >> 2) + 4 * hi; }

constexpr int CV_KB = FF / 128, CV_NB = D / 16, CV_ITEMS = NE * CV_NB * CV_KB, CV_IPW = CV_ITEMS / (GRID * NWAVES);
constexpr int CU_KB = D / 128, CU_NB = FF / 16, CU_ITEMS = NE * CU_NB * CU_KB, CU_IPW = CU_ITEMS / (GRID * NWAVES);
static_assert(CV_ITEMS % (GRID * NWAVES) == 0 && CU_ITEMS % (GRID * NWAVES) == 0, "MoE conversion items per wave");
constexpr float CV_WS = 64.f, CV_W6 = 90.f;
typedef __bf16 v32bf __attribute__((ext_vector_type(32)));
struct CvtState { const float* WDn; unsigned char* TDn; const float* WUp; unsigned char* TUp; int gw, next; };
__device__ __forceinline__ void cvt_load(const CvtState& cs, int lane, f32x4 (&v)[8]) {
    const bool dn = cs.next < CV_IPW;
    const int id = dn ? cs.gw * CV_IPW + cs.next : cs.gw * CU_IPW + (cs.next - CV_IPW);
    const int kbn = dn ? CV_KB : CU_KB, nbn = dn ? CV_NB : CU_NB, ldn = dn ? D : FF;
    const int kb = id % kbn, tmp = id / kbn, nb = tmp % nbn, e = tmp / nbn;
    const float* src = (dn ? cs.WDn : cs.WUp) + ((size_t)e * (kbn * 128) + (size_t)(128 * kb + 32 * ((lane >> 2) & 3) + (lane >> 4))) * ldn + 16 * nb + 4 * (lane & 3);
#pragma unroll
    for (int i = 0; i < 8; ++i) v[i] = *(const f32x4*)(src + (size_t)(4 * i) * ldn);
}
__device__ __forceinline__ void cvt_store(CvtState& cs, int lane, f32x4 (&v)[8]) {
    const bool dn = cs.next < CV_IPW;
    const int id = dn ? cs.gw * CV_IPW + cs.next : cs.gw * CU_IPW + (cs.next - CV_IPW);
    const int kbn = dn ? CV_KB : CU_KB, nbn = dn ? CV_NB : CU_NB;
    const int kb = id % kbn, tmp = id / kbn, nb = tmp % nbn, e = tmp / nbn;
    const int n = 16 * nb + 4 * (lane & 3) + (lane >> 4), kof = 128 * kb + 32 * ((lane >> 2) & 3);
#pragma unroll
    for (int i = 0; i < 8; ++i) {
        unsigned r0 = __float_as_uint(v[i].x), r1 = __float_as_uint(v[i].y), r2 = __float_as_uint(v[i].z), r3 = __float_as_uint(v[i].w);
        { const auto s = __builtin_amdgcn_permlane16_swap(r0, r1, false, false); r0 = s[0]; r1 = s[1]; }
        { const auto s = __builtin_amdgcn_permlane16_swap(r2, r3, false, false); r2 = s[0]; r3 = s[1]; }
        { const auto s = __builtin_amdgcn_permlane32_swap(r0, r2, false, false); r0 = s[0]; r2 = s[1]; }
        { const auto s = __builtin_amdgcn_permlane32_swap(r1, r3, false, false); r1 = s[0]; r3 = s[1]; }
        v[i] = (f32x4){__uint_as_float(r0), __uint_as_float(r1), __uint_as_float(r2), __uint_as_float(r3)}; }
    if (dn) {
        unsigned char* dst = cs.TDn + ((size_t)e * D + (size_t)n) * FF + kof;
        u32x4 w0, w1;
        w0.x = pk4_fp8(v[0].x * CV_WS, v[0].y * CV_WS, v[0].z * CV_WS, v[0].w * CV_WS); w0.y = pk4_fp8(v[1].x * CV_WS, v[1].y * CV_WS, v[1].z * CV_WS, v[1].w * CV_WS);
        w0.z = pk4_fp8(v[2].x * CV_WS, v[2].y * CV_WS, v[2].z * CV_WS, v[2].w * CV_WS); w0.w = pk4_fp8(v[3].x * CV_WS, v[3].y * CV_WS, v[3].z * CV_WS, v[3].w * CV_WS);
        w1.x = pk4_fp8(v[4].x * CV_WS, v[4].y * CV_WS, v[4].z * CV_WS, v[4].w * CV_WS); w1.y = pk4_fp8(v[5].x * CV_WS, v[5].y * CV_WS, v[5].z * CV_WS, v[5].w * CV_WS);
        w1.z = pk4_fp8(v[6].x * CV_WS, v[6].y * CV_WS, v[6].z * CV_WS, v[6].w * CV_WS); w1.w = pk4_fp8(v[7].x * CV_WS, v[7].y * CV_WS, v[7].z * CV_WS, v[7].w * CV_WS);
        *(u32x4*)dst = w0; *(u32x4*)(dst + 16) = w1;
    } else {
        typedef unsigned v16u_ __attribute__((ext_vector_type(16)));
        v16u_ d;
#pragma unroll
        for (int i = 0; i < 4; ++i)
#pragma unroll
            for (int j = 0; j < 4; ++j) d[4 * i + j] = cvtpk(__builtin_amdgcn_fmed3f(v[i][j] * CV_W6, -7.5f, 7.5f), __builtin_amdgcn_fmed3f(v[4 + i][j] * CV_W6, -7.5f, 7.5f));
        const v6u w = __builtin_amdgcn_cvt_scalef32_pk32_fp6_bf16(__builtin_bit_cast(v32bf, d), 1.0f);
        const int drow = (n >> 7) * 256 + (n & 127) + 128;
        unsigned char* dst = cs.TUp + ((size_t)e * (2 * FF) + (size_t)drow) * D + kof;
        *(u32x4*)dst = (u32x4){w[0], w[1], w[2], w[3]}; *(u32x4*)(dst + 16) = (u32x4){w[4], w[5], 0u, 0u};
    }
    ++cs.next;
}

__device__ __forceinline__ void attn_unit(LAS unsigned char* lds, const unsigned char* Q, const unsigned char* KV, const bf16_t* KPE, const float* CST, bf16_t* O, int b, int h, int qb, CvtState& cs) {
    const int tid = opaque_tid(), wid = __builtin_amdgcn_readfirstlane(tid >> 6), lane = tid & 63, r32 = lane & 31, hi = lane >> 5;
    const bool lag = wid >= 4;
    if (lag) __builtin_amdgcn_s_setprio(1);
    const size_t rowb = (size_t)b * SEQ;
    const int qlo = qb * 256 + wid * 32;
    v8i qf[3];
    const unsigned qo = (unsigned)((rowb + qlo + r32) * (NH * QKD) + h * QKD + hi * 32);
    { const v4i a0 = *(const v4i*)((const char*)Q + qo), a1 = *(const v4i*)((const char*)Q + qo + 16), b0 = *(const v4i*)((const char*)Q + qo + 64), b1 = *(const v4i*)((const char*)Q + qo + 80);
      qf[0] = __builtin_shufflevector(a0, a1, 0, 1, 2, 3, 4, 5, 6, 7); qf[1] = __builtin_shufflevector(b0, b1, 0, 1, 2, 3, 4, 5, 6, 7); }
    { const float* cst = CST + (size_t)(rowb + qlo + r32) * 64;
      const v4i t0 = *(const v4i*)((const char*)Q + qo + 128), t1 = *(const v4i*)((const char*)Q + qo + 144);
#pragma unroll
      for (int d = 0; d < 8; ++d) {
          const int own = (d < 4) ? t0[d & 3] : t1[d & 3];
          const auto rr = __builtin_amdgcn_permlane32_swap((unsigned)own, (unsigned)own, false, false); const int par = (int)(rr[0] ^ rr[1]) ^ own;
          const f32x4 c = *(const f32x4*)(cst + 4 * d); f32x4 sn = *(const f32x4*)(cst + 32 + 4 * d);
          if (hi == 0) sn = -sn;
          const float o0 = __builtin_amdgcn_cvt_f32_fp8(own, 0) * c[0] + __builtin_amdgcn_cvt_f32_fp8(par, 0) * sn[0], o1 = __builtin_amdgcn_cvt_f32_fp8(own, 1) * c[1] + __builtin_amdgcn_cvt_f32_fp8(par, 1) * sn[1];
          const float o2 = __builtin_amdgcn_cvt_f32_fp8(own, 2) * c[2] + __builtin_amdgcn_cvt_f32_fp8(par, 2) * sn[2], o3 = __builtin_amdgcn_cvt_f32_fp8(own, 3) * c[3] + __builtin_amdgcn_cvt_f32_fp8(par, 3) * sn[3];
          qf[2][d] = (int)pk4_fp8(o0, o1, o2, o3); } }
    const int NT = 4 * (qb + 1);
    const int sr = tid >> 4, sc = (tid & 15) * 8, pr = tid >> 3, pc = (tid & 7) * 8;
    const unsigned kvo = (unsigned)((rowb + sr) * 4096 + h * 256 + sc);
    const unsigned kpo = (unsigned)(((rowb + pr) * 64 + pc) * 2);
    const int kw0 = sr * KROW + sc, kw1 = (sr + 32) * KROW + sc, kwp = pr * KROW + 128 + pc;
    const int vkg = (wid & 3) * 4 + (lane >> 4), vdg = (wid >> 2) * 16 + (lane & 15);
    const unsigned kvv = (unsigned)((rowb + 4 * vkg) * 4096 + h * 256 + 128 + 4 * vdg);
    const int vw = VOFF + 4 * vdg * VROW + (vkg & 1) * 32 + (((vkg >> 3) * 4 + ((vkg & 7) >> 1)) * 4);
    u32x2 sk0, sk1; bf16x8 skp; unsigned sv0, sv1, sv2, sv3;
#define ATT_LOAD(t) do { const unsigned k1_ = kvo + (unsigned)(t) * (64u * 4096u), k2_ = kpo + (unsigned)(t) * (64u * 128u); const char* kvb_ = (const char*)KV; \
        const unsigned k3_ = kvv + (unsigned)(t) * (64u * 4096u); \
        sk0 = *(const u32x2*)(kvb_ + k1_); sk1 = *(const u32x2*)(kvb_ + k1_ + 32u * 4096u); skp = *(const bf16x8*)((const char*)KPE + k2_); \
        sv0 = *(const unsigned*)(kvb_ + k3_); sv1 = *(const unsigned*)(kvb_ + k3_ + 4096u); sv2 = *(const unsigned*)(kvb_ + k3_ + 2u * 4096u); sv3 = *(const unsigned*)(kvb_ + k3_ + 3u * 4096u); } while (0)
#define B8_(x_, y_) ({ const unsigned bx_ = (x_), by_ = (y_); __builtin_bit_cast(unsigned, __builtin_amdgcn_cvt_scalef32_pk_fp8_bf16(__builtin_amdgcn_cvt_scalef32_pk_fp8_bf16((v2s){0, 0}, __builtin_bit_cast(v2bf, bx_), 1.0f, false), __builtin_bit_cast(v2bf, by_), 1.0f, true)); })
#define K8_(S) ({ const u32x4 t_ = __builtin_bit_cast(u32x4, S); u32x2 w_; w_.x = B8_(t_.x, t_.y); w_.y = B8_(t_.z, t_.w); w_; })
#define VL_(a_, b_) __builtin_amdgcn_perm(b_, a_, 0x05040100u)
#define VH_(a_, b_) __builtin_amdgcn_perm(b_, a_, 0x07060302u)
#define V8_(a_, b_, c_, d_) ((unsigned)__builtin_amdgcn_cvt_pk_fp8_f32(c_, d_, __builtin_amdgcn_cvt_pk_fp8_f32(a_, b_, 0, false), true))
#define ATT_WRITE(kb, vb) do { LAS unsigned char* kb_ = lds + (kb) * KBUF; LAS unsigned char* vb_ = lds + (vb) * VBUF; *(LAS u32x2*)(kb_ + kw0) = sk0; *(LAS u32x2*)(kb_ + kw1) = sk1; *(LAS u32x2*)(kb_ + kwp) = K8_(skp); \
        const unsigned a_ = __builtin_amdgcn_perm(sv1, sv0, 0x05010400u), b_ = __builtin_amdgcn_perm(sv3, sv2, 0x05010400u), c_ = __builtin_amdgcn_perm(sv1, sv0, 0x07030602u), d_ = __builtin_amdgcn_perm(sv3, sv2, 0x07030602u); \
        *(LAS unsigned*)(vb_ + vw) = VL_(a_, b_); *(LAS unsigned*)(vb_ + vw + VROW) = VH_(a_, b_); *(LAS unsigned*)(vb_ + vw + 2 * VROW) = VL_(c_, d_); *(LAS unsigned*)(vb_ + vw + 3 * VROW) = VH_(c_, d_); } while (0)
    ATT_LOAD(0); ATT_WRITE(0, 0);
    __syncthreads();
    float m_reg = -1e30f, l_reg = 0.f;
    f32x16 o[4];
#pragma unroll
    for (int d = 0; d < 4; ++d)
#pragma unroll
        for (int r = 0; r < 16; ++r) o[d][r] = 0.f;
    const unsigned vrd = (unsigned)(uintptr_t)lds + (unsigned)(VOFF + r32 * VROW + hi * 32);
#define DSR(dst, addr, off) asm volatile("ds_read_b128 %0, %1 offset:%2" : "=v"(dst) : "v"(addr), "i"(off))
#define DSW4(n, a, b, c, d) asm volatile("s_waitcnt lgkmcnt(" #n ")" : "+v"(a), "+v"(b), "+v"(c), "+v"(d))
#define CAT8(a, b) __builtin_shufflevector(a, b, 0, 1, 2, 3, 4, 5, 6, 7)
#define MMA8(A, B, C) __builtin_amdgcn_mfma_scale_f32_32x32x64_f8f6f4(A, B, C, 0, 0, 0, 0, 0, 0)
    v8i pf = {0, 0, 0, 0, 0, 0, 0, 0};
    bool pend = false; int vs = 0;
    v4i va0, va1, va2, va3, va4, va5, va6, va7;
#define PV_READ(slot) do { const unsigned vb0 = vrd + (unsigned)((slot) * VBUF); DSR(va0, vb0, 0); DSR(va1, vb0, 16); DSR(va2, vb0, 32 * VROW); DSR(va3, vb0, 32 * VROW + 16); \
        DSR(va4, vb0, 64 * VROW); DSR(va5, vb0, 64 * VROW + 16); DSR(va6, vb0, 96 * VROW); DSR(va7, vb0, 96 * VROW + 16); } while (0)
#define PV_MMA() do { DSW4(4, va0, va1, va2, va3); o[0] = MMA8(CAT8(va0, va1), pf, o[0]); o[1] = MMA8(CAT8(va2, va3), pf, o[1]); \
        DSW4(0, va4, va5, va6, va7); o[2] = MMA8(CAT8(va4, va5), pf, o[2]); o[3] = MMA8(CAT8(va6, va7), pf, o[3]); } while (0)
    f32x4 cv[8]; bool cvt_pend = false;
    for (int t = 0; t < NT; ++t) {
        if (t + 1 < NT) ATT_LOAD(t + 1);
        if (cvt_pend) { cvt_store(cs, lane, cv); cvt_pend = false; }
        if (lag && pend) { PV_MMA(); pend = false; }
        const int kb0 = t * 64;
        const bool cvt_now = ((t & 1) == 0) && cs.next < CV_IPW + CU_IPW;
        if (cvt_now && !(kb0 <= qlo + 31)) cvt_load(cs, lane, cv);
        if (kb0 <= qlo + 31) {
            const unsigned ka = (unsigned)(uintptr_t)lds + (unsigned)((t & 1) * KBUF + r32 * KROW + hi * 32);
            f32x16 p0, p1;
#pragma unroll
            for (int r = 0; r < 16; ++r) { p0[r] = 0.f; p1[r] = 0.f; }
            { v4i k0, k1, k2, k3, k4, k5, k6, k7, k8, k9, k10, k11;
              DSR(k0, ka, 0); DSR(k1, ka, 16); DSR(k2, ka, 32 * KROW); DSR(k3, ka, 32 * KROW + 16);
              DSR(k4, ka, 64); DSR(k5, ka, 80); DSR(k6, ka, 32 * KROW + 64); DSR(k7, ka, 32 * KROW + 80);
              DSR(k8, ka, 128); DSR(k9, ka, 144); DSR(k10, ka, 32 * KROW + 128); DSR(k11, ka, 32 * KROW + 144);
              DSW4(8, k0, k1, k2, k3);
              p0 = MMA8(CAT8(k0, k1), qf[0], p0); p1 = MMA8(CAT8(k2, k3), qf[0], p1);
              DSW4(4, k4, k5, k6, k7);
              p0 = MMA8(CAT8(k4, k5), qf[1], p0); p1 = MMA8(CAT8(k6, k7), qf[1], p1);
              DSW4(0, k8, k9, k10, k11);
              p0 = MMA8(CAT8(k8, k9), qf[2], p0); p1 = MMA8(CAT8(k10, k11), qf[2], p1); }
            PV_READ(vs);
            if (cvt_now) cvt_load(cs, lane, cv);
            if (kb0 + 63 > qlo) {
                const int dq = qlo + r32 - 4 * hi - kb0; const float NEG = -__builtin_inff();
#pragma unroll
                for (int r = 0; r < 16; ++r) { const int c = (r & 3) + 8 * (r >> 2); if (dq - c < 0) p0[r] = NEG; if (dq - c - 32 < 0) p1[r] = NEG; }
            }
            float pmax = p0[0];
#pragma unroll
            for (int r = 1; r < 16; ++r) pmax = fmaxf(pmax, p0[r]);
#pragma unroll
            for (int r = 0; r < 16; ++r) pmax = fmaxf(pmax, p1[r]);
            { auto rr = __builtin_amdgcn_permlane32_swap(__float_as_uint(pmax), __float_as_uint(pmax), false, false); pmax = fmaxf(__uint_as_float(rr[0]), __uint_as_float(rr[1])); }
            float mn, alpha;
            constexpr float QI8 = 1.0f / QS8;
            if (__all((pmax - m_reg) <= THR * QS8)) { mn = m_reg; alpha = 1.f; }
            else { mn = fmaxf(m_reg, pmax); alpha = __builtin_amdgcn_exp2f((m_reg - mn) * QI8); m_reg = mn; }
            const float mnq = PSH - mn * QI8;
            float ps = 0.f;
#pragma unroll
            for (int r = 0; r < 16; ++r) { p0[r] = __builtin_amdgcn_exp2f(fmaf(p0[r], QI8, mnq)); ps += p0[r]; }
#pragma unroll
            for (int r = 0; r < 16; ++r) { p1[r] = __builtin_amdgcn_exp2f(fmaf(p1[r], QI8, mnq)); ps += p1[r]; }
            { auto rr = __builtin_amdgcn_permlane32_swap(__float_as_uint(ps), __float_as_uint(ps), false, false); ps = __uint_as_float(rr[0]) + __uint_as_float(rr[1]); }
            l_reg = l_reg * alpha + ps;
            if (__any(alpha < 1.f)) {
#pragma unroll
                for (int d = 0; d < 4; ++d)
#pragma unroll
                    for (int r = 0; r < 16; ++r) o[d][r] *= alpha;
            }
#pragma unroll
            for (int i = 0; i < 4; ++i) { pf[i] = (int)V8_(p0[4 * i], p0[4 * i + 1], p0[4 * i + 2], p0[4 * i + 3]); pf[4 + i] = (int)V8_(p1[4 * i], p1[4 * i + 1], p1[4 * i + 2], p1[4 * i + 3]); }
            if (!lag) PV_MMA(); else pend = true;
        }
        if (cvt_now) cvt_pend = true;
        const int vn = (vs == 2) ? 0 : vs + 1;
        if (t + 1 < NT) ATT_WRITE((t + 1) & 1, vn);
        asm volatile("s_waitcnt lgkmcnt(0)" ::: "memory");
        __syncthreads();
        vs = vn;
    }
    if (lag && pend) PV_MMA();
    if (cvt_pend) cvt_store(cs, lane, cv);
    __builtin_amdgcn_s_setprio(0);
    __syncthreads();
#undef PV_READ
#undef PV_MMA
#undef DSR
#undef DSW4
#undef CAT8
#undef MMA8
#undef ATT_LOAD
#undef ATT_WRITE
#undef K8_
#undef V8_
#undef B8_
#undef VL_
#undef VH_
    { const float rl = __builtin_amdgcn_rcpf(l_reg) * OSC8;
      const unsigned oo = (unsigned)((rowb + qlo + r32) * D + h * VDIM + 4 * hi);
#pragma unroll
      for (int d0 = 0; d0 < 4; ++d0)
#pragma unroll
          for (int j = 0; j < 4; ++j)
              *(unsigned*)((char*)O + oo + (unsigned)(d0 * 32 + j * 8)) = pk4_fp8(o[d0][4 * j] * rl, o[d0][4 * j + 1] * rl, o[d0][4 * j + 2] * rl, o[d0][4 * j + 3] * rl); }
}
}

#define XB_TMO      128
#define XB_XCNT(j)  (256  + 64 * (j))
#define XB_XSUB(j)  (1280 + 64 * (j))
#define XB_XGEN(j)  (2304 + 64 * (j))
#define XB_TOP      3328
#define XB_TOPGEN   3392
#define XCD_BAR_WORDS 3456
#define XB_SPIN_CAP (1u << 18)
__device__ __forceinline__ unsigned xb_ld(unsigned* p)              { return __hip_atomic_load(p, __ATOMIC_RELAXED, __HIP_MEMORY_SCOPE_AGENT); }
__device__ __forceinline__ unsigned xb_add(unsigned* p, unsigned v) { return __hip_atomic_fetch_add(p, v, __ATOMIC_RELAXED, __HIP_MEMORY_SCOPE_AGENT); }
__device__ __forceinline__ unsigned xb_xcc_id() { return (unsigned)__builtin_amdgcn_s_getreg((3 << 11) | 20) & 0xFu; }
#define XB_SPIN(cond, bar) do { unsigned _sp = 0; while (cond) { __builtin_amdgcn_s_sleep(1); \
    if ((++_sp & 255u) == 0u) { if (xb_ld(&(bar)[XB_TMO])) break; if (_sp > XB_SPIN_CAP) { atomicAdd(&(bar)[XB_TMO], 1u); break; } } } } while (0)
struct XcdBarrier { unsigned* bar; unsigned x; volatile LAS unsigned* st; };
__device__ __forceinline__ XcdBarrier xcd_barrier_post(unsigned* bar, volatile LAS unsigned* st) {
    XcdBarrier b; b.bar = bar; b.x = xb_xcc_id(); b.st = st;
    if (threadIdx.x == 0) (void)xb_add(&bar[XB_XCNT(b.x)], 1u);
    return b;
}
__device__ __forceinline__ void xcd_barrier_complete(unsigned* bar, unsigned x, unsigned& nloc, unsigned& nx) {
    const unsigned G = gridDim.x * gridDim.y * gridDim.z;
    unsigned sum, cnt, mine, sp = 0u;
    for (;;) {
        sum = 0u; cnt = 0u; mine = 0u;
#pragma unroll
        for (unsigned j = 0; j < 16; ++j) { const unsigned c = xb_ld(&bar[XB_XCNT(j)]); sum += c; cnt += (c > 0u) ? 1u : 0u; mine = (j == x) ? c : mine; }
        if (sum == G) break;
        __builtin_amdgcn_s_sleep(1);
        if ((++sp & 255u) == 0u) { if (xb_ld(&bar[XB_TMO])) break; if (sp > XB_SPIN_CAP) { atomicAdd(&bar[XB_TMO], 1u); break; } }
    }
    nloc = mine > 0u ? mine : 1u; nx = cnt > 0u ? cnt : 1u;
}
__device__ __forceinline__ void xcd_barrier(const XcdBarrier& b) {
    asm volatile("s_waitcnt vmcnt(0)" ::: "memory");
    __syncthreads();
    if (threadIdx.x == 0) {
        unsigned* bar = b.bar;
        __builtin_amdgcn_s_waitcnt(0);
        unsigned nloc = b.st[0], nx = b.st[1];
        if (nloc == 0u) { xcd_barrier_complete(bar, b.x, nloc, nx); b.st[0] = nloc; b.st[1] = nx; }
        const unsigned old = xb_add(&bar[XB_XSUB(b.x)], 1u);
        const unsigned gen = old / nloc;
        if (old + 1u == (gen + 1u) * nloc) {
            __builtin_amdgcn_fence(__ATOMIC_RELEASE, "agent");
            asm volatile("s_waitcnt vmcnt(0)" ::: "memory");
            const unsigned og = xb_add(&bar[XB_TOP], 1u);
            const unsigned tg = og / nx;
            if (og + 1u == (tg + 1u) * nx) xb_add(&bar[XB_TOPGEN], 1u);
            else XB_SPIN(xb_ld(&bar[XB_TOPGEN]) == tg, bar);
            __builtin_amdgcn_fence(__ATOMIC_ACQUIRE, "agent");
            xb_add(&bar[XB_XGEN(b.x)], 1u);
            asm volatile("s_waitcnt vmcnt(0)" ::: "memory");
        } else {
            XB_SPIN(xb_ld(&bar[XB_XGEN(b.x)]) == gen, bar);
            __builtin_amdgcn_fence(__ATOMIC_ACQUIRE, "agent");
            asm volatile("s_waitcnt vmcnt(0)" ::: "memory");
        }
    }
    __syncthreads();
}

struct Args { const float* in[29]; const int* positions; float* out; unsigned char* ws; };
enum { I_X = 0, I_POS = 1, I_ANM = 2, I_RGWIN = 3, I_CONVW = 4, I_CONVB = 5, I_RGWA = 6, I_RGBA = 7, I_RGWX = 8, I_RGBX = 9, I_LAM = 10, I_RGWOUT = 11, I_ANF = 12, I_FFG = 13, I_FFU = 14, I_FFD = 15,
       I_BNM = 16, I_MLAWIN = 17, I_QNORM = 18, I_WQUP = 19, I_KVNORM = 20, I_WKVUP = 21, I_MLAWO = 22, I_BNF = 23, I_ROUTER = 24, I_MOEG = 25, I_MOEU = 26, I_MOED = 27, I_FNORM = 28 };

constexpr float WSC8 = 64.f, ASC8 = 8.f, HSC8 = 4.f; static_assert(WSC8 == att::CV_WS, "e4m3 weight scale");
__device__ __forceinline__ void tr_load(const float* W, int N, int k0, int n0, int lane, f32x4 (&v)[16]) {
    const float* src = W + (size_t)(k0 + 16 * (lane >> 4)) * N + n0 + 4 * (lane & 15);
#pragma unroll
    for (int i = 0; i < 16; ++i) v[i] = *(const f32x4*)(src + (size_t)i * N);
}
constexpr float WSI8 = 1400.f, ASI8 = 31.f, WSU8 = 700.f, WSD8 = 2600.f, HSI8 = 16.f;
template <int FP8>
__device__ __forceinline__ void tr_store(const f32x4 (&v)[16], void* WT, int K, int k0, int drow0, int lane, float wsc) {
    const int c = lane & 15, q = lane >> 4;
#pragma unroll
    for (int j = 0; j < 4; ++j) {
        const size_t eoff = (size_t)(drow0 + 4 * c + j) * K + k0 + 16 * q;
        if constexpr (FP8 == 2) { u32x4 o;
            o.x = pk4_i8(v[0][j] * wsc, v[1][j] * wsc, v[2][j] * wsc, v[3][j] * wsc); o.y = pk4_i8(v[4][j] * wsc, v[5][j] * wsc, v[6][j] * wsc, v[7][j] * wsc);
            o.z = pk4_i8(v[8][j] * wsc, v[9][j] * wsc, v[10][j] * wsc, v[11][j] * wsc); o.w = pk4_i8(v[12][j] * wsc, v[13][j] * wsc, v[14][j] * wsc, v[15][j] * wsc);
            *(u32x4*)((unsigned char*)WT + eoff) = o; }
        else if constexpr (FP8 == 1) { u32x4 o;
            o.x = pk4_fp8(v[0][j] * WSC8, v[1][j] * WSC8, v[2][j] * WSC8, v[3][j] * WSC8); o.y = pk4_fp8(v[4][j] * WSC8, v[5][j] * WSC8, v[6][j] * WSC8, v[7][j] * WSC8);
            o.z = pk4_fp8(v[8][j] * WSC8, v[9][j] * WSC8, v[10][j] * WSC8, v[11][j] * WSC8); o.w = pk4_fp8(v[12][j] * WSC8, v[13][j] * WSC8, v[14][j] * WSC8, v[15][j] * WSC8);
            *(u32x4*)((unsigned char*)WT + eoff) = o; }
        else { u32x4 o0, o1;
            o0.x = cvtpk(v[0][j], v[1][j]); o0.y = cvtpk(v[2][j], v[3][j]); o0.z = cvtpk(v[4][j], v[5][j]); o0.w = cvtpk(v[6][j], v[7][j]);
            o1.x = cvtpk(v[8][j], v[9][j]); o1.y = cvtpk(v[10][j], v[11][j]); o1.z = cvtpk(v[12][j], v[13][j]); o1.w = cvtpk(v[14][j], v[15][j]);
            *(u32x4*)((bf16_t*)WT + eoff) = o0; *(u32x4*)((bf16_t*)WT + eoff + 8) = o1; }
    }
}
template <int MODE, int FP8 = 0>
__device__ __forceinline__ void tr_matrix(const float* W, int nb, int K, int N, void* WT, int drows, int rot, int gw, int NGW, LAS float* scr, int lane, float wsc = 1.0f) {
    const int nbn = N / 64, per = (K / 128) * nbn, total = nb * per;
    int it = gw - rot; if (it < 0) it += NGW;
    if (it >= total) return;
    f32x4 va[16], vb[16];
    int e = it / per, r = it - e * per, kb = r / nbn, nbk = r - kb * nbn, n0 = nbk * 64, k0 = kb * 128;
    const float* Wp = W + (size_t)e * K * N; unsigned char* WTp = (unsigned char*)WT + (size_t)e * drows * K * (FP8 ? 1 : 2);
    tr_load(Wp, N, k0, n0, lane, va);
    for (;;) {
        tr_load(Wp, N, k0 + 64, n0, lane, vb);
        const int drow0 = (MODE == 0) ? n0 : ((n0 >> 7) * 256 + (n0 & 127) + (MODE == 2 ? 128 : 0));
        tr_store<FP8>(va, WTp, K, k0, drow0, lane, wsc);
        const int nit = it + NGW; const bool more = nit < total;
        int n0n = n0, k0n = k0; const float* Wpn = Wp; unsigned char* WTpn = WTp;
        if (more) { e = nit / per; r = nit - e * per; kb = r / nbn; nbk = r - kb * nbn; n0n = nbk * 64; k0n = kb * 128;
            Wpn = W + (size_t)e * K * N; WTpn = (unsigned char*)WT + (size_t)e * drows * K * (FP8 ? 1 : 2);
            tr_load(Wpn, N, k0n, n0n, lane, va); }
        tr_store<FP8>(vb, WTp, K, k0 + 64, drow0, lane, wsc);
        if (!more) break;
        it = nit; n0 = n0n; k0 = k0n; Wp = Wpn; WTp = WTpn;
    }
}
constexpr float WSC6 = 90.f, ASC6 = 2.f; static_assert(WSC6 == att::CV_W6, "e2m3 weight scale");
template <int MODE>
__device__ __forceinline__ void tr_matrix6(const float* W, int nb, int K, int N, unsigned char* WT, int drows, int rot, int gw, int NGW, int lane, float wscale) {
    const int nbn = N / 32, per = (K / 256) * nbn, total = nb * per;
    int it = gw - rot; if (it < 0) it += NGW;
    const int c = lane & 7, q = lane >> 3;
    for (; it < total; it += NGW) {
        const int e = it / per, r = it - e * per, kb = r / nbn, nbk = r - kb * nbn, n0 = nbk * 32, k0 = kb * 256;
        const float* src = W + (size_t)e * K * N + (size_t)(k0 + 32 * q) * N + n0 + 4 * c;
        f32x4 v[32];
#pragma unroll
        for (int i = 0; i < 32; ++i) v[i] = *(const f32x4*)(src + (size_t)i * N);
        const int drow0 = (MODE == 0) ? n0 : ((n0 >> 7) * 256 + (n0 & 127) + (MODE == 2 ? 128 : 0));
        unsigned char* dst = WT + (size_t)e * drows * K + (size_t)(drow0 + 4 * c) * K + k0 + 32 * q;
#pragma unroll
        for (int j = 0; j < 4; ++j) { float x[32];
#pragma unroll
            for (int i = 0; i < 32; ++i) x[i] = v[i][j] * wscale;
            const v6u w = pk32_fp6(x);
            *(u32x4*)(dst + (size_t)j * K) = (u32x4){w[0], w[1], w[2], w[3]}; *(u32x4*)(dst + (size_t)j * K + 16) = (u32x4){w[4], w[5], 0u, 0u}; }
    }
}
template <bool I8OUT = false>
__device__ __forceinline__ void norm_rows(const float* __restrict__ X, const float* __restrict__ gain, bf16_t* __restrict__ O, int gw, int NGW, int lane) {
    f32x4 g[8];
#pragma unroll
    for (int j = 0; j < 8; ++j) g[j] = *(const f32x4*)(gain + 4 * lane + 256 * j);
    for (int m = gw; m < M; m += 2 * NGW) {
        const f32x4* xa = (const f32x4*)(X + (size_t)m * D) + lane; const f32x4* xb = (const f32x4*)(X + (size_t)(m + NGW) * D) + lane;
        f32x4 va[8], vb[8]; float sa = 0.f, sb = 0.f;
#pragma unroll
        for (int j = 0; j < 8; ++j) { va[j] = xa[64 * j]; vb[j] = xb[64 * j]; }
#pragma unroll
        for (int j = 0; j < 8; ++j) { sa += dot4(va[j]); sb += dot4(vb[j]); }
        const float ra = 1.0f / sqrtf(wave_sum(sa) * (1.0f / D) + EPS), rb = 1.0f / sqrtf(wave_sum(sb) * (1.0f / D) + EPS);
        if constexpr (I8OUT) { unsigned* oa = (unsigned*)((unsigned char*)O + (size_t)m * D) + lane; unsigned* ob = (unsigned*)((unsigned char*)O + (size_t)(m + NGW) * D) + lane;
#pragma unroll
            for (int j = 0; j < 8; ++j) { const f32x4 ya = va[j] * (ra * ASI8) * g[j], yb = vb[j] * (rb * ASI8) * g[j]; oa[64 * j] = pk4_i8(ya.x, ya.y, ya.z, ya.w); ob[64 * j] = pk4_i8(yb.x, yb.y, yb.z, yb.w); } }
        else {
        u32x2* oa = (u32x2*)(O + (size_t)m * D) + lane; u32x2* ob = (u32x2*)(O + (size_t)(m + NGW) * D) + lane;
#pragma unroll
        for (int j = 0; j < 8; ++j) { const f32x4 ya = va[j] * ra * g[j], yb = vb[j] * rb * g[j]; u32x2 wa, wb; wa.x = cvtpk(ya.x, ya.y); wa.y = cvtpk(ya.z, ya.w); wb.x = cvtpk(yb.x, yb.y); wb.y = cvtpk(yb.z, yb.w);
            oa[64 * j] = wa; ob[64 * j] = wb; } }
    }
}
__device__ __forceinline__ void rope_cs(int pos, double invf, float& c, float& s) {
    const double rev = (double)pos * invf * 0.15915494309189535; const float fr = (float)(rev - __builtin_floor(rev));
    s = __builtin_amdgcn_sinf(fr); c = __builtin_amdgcn_cosf(fr);
}

#ifndef PHASES
#define PHASES 0xffffffffu
#endif
#define PH(n) (((PHASES) >> (n)) & 1u)
#ifndef REPEAT
#define REPEAT 0u
#endif
#define RP(n) _Pragma("nounroll") for (int rep_ = 0; rep_ < (int)(((REPEAT) >> (n)) & 1u) + 1; ++rep_)
__global__ void __launch_bounds__(NTHREADS, 2) fwd_kernel(Args args) {
    extern __shared__ __attribute__((aligned(16))) unsigned char lds_raw[];
    LAS unsigned char* lds = (LAS unsigned char*)lds_raw;
    volatile LAS unsigned* MISC = (volatile LAS unsigned*)(lds + LDSCTL_OFF);
    const int wave = __builtin_amdgcn_readfirstlane(opaque_tid() >> 6);
    const int G = gridDim.x, bx = blockIdx.x;
    const int gw = bx * NWAVES + wave, NGW = G * NWAVES, NGT = G * NTHREADS;
#define IDS() const int tid = opaque_tid(), lane = tid & 63, gtid = bx * NTHREADS + tid; (void)lane; (void)gtid
    unsigned char* ws = args.ws;
    float* out = args.out;
    { IDS(); for (int u = tid; u < (LDS_BYTES - LDSCTL_OFF) / 4; u += NTHREADS) ((LAS unsigned*)(lds + LDSCTL_OFF))[u] = 0u; }
    __syncthreads();
    XcdBarrier bar = xcd_barrier_post((unsigned*)(ws + WS_CTL) + 1024, MISC + 8);
#define GRID_BAR() xcd_barrier(bar)

    bf16_t* XB = (bf16_t*)(ws + WS_XB);
    float* csp = (float*)(ws + TAB_CSP);

    if (PH(0)) RP(0)
    {
        IDS();
        LAS float* scr = (LAS float*)(lds + wave * 16640);
        constexpr int T0 = (D / 128) * (2 * D / 64), T1 = (D / 128) * (D / 64), T2 = (D / 128) * (FF / 64), T5 = (D / 128) * (MLA_IN / 64), T6 = (QLORA / 128) * (NH * QKD / 64), T7 = (KVLORA / 128) * (NH * 256 / 64);
        constexpr int NGWC = GRID * NWAVES;
        constexpr int R1 = T0 % NGWC, R2 = (R1 + T1) % NGWC, R3 = (R2 + T2) % NGWC, R4 = (R3 + T2) % NGWC, R5 = (R4 + T2) % NGWC, R6 = (R5 + T5) % NGWC, R7 = (R6 + T6) % NGWC, R8 = (R7 + T7) % NGWC, R9 = (R8 + T1) % NGWC;
        static_assert((NE * (D / 256) * (FF / 32)) % NGWC == 0, "fp6 item count per matrix is a multiple of the wave count");
        tr_matrix<0, 2>(args.in[I_RGWIN], 1, D,      2 * D,    (bf16_t*)(ws + W_IN1),   2 * D,      0,   gw, NGW, scr, lane, WSI8);
        tr_matrix<0>(args.in[I_RGWOUT], 1,  D,      D,        (bf16_t*)(ws + W_OUT1),  D,          R1,  gw, NGW, scr, lane);
        tr_matrix<1, 2>(args.in[I_FFG], 1,  D,      FF,       (bf16_t*)(ws + W_FFGU),  2 * FF,     R2,  gw, NGW, scr, lane, WSI8);
        tr_matrix<2, 2>(args.in[I_FFU], 1,  D,      FF,       (bf16_t*)(ws + W_FFGU),  2 * FF,     R3,  gw, NGW, scr, lane, WSI8);
        tr_matrix<0, 2>(args.in[I_FFD],  1,  FF,     D,        (bf16_t*)(ws + W_FFD),   D,          R4,  gw, NGW, scr, lane, WSD8);
        tr_matrix<0, 2>(args.in[I_MLAWIN], 1, D,     MLA_IN,   (bf16_t*)(ws + W_MLAIN), MLA_IN_PAD, R5,  gw, NGW, scr, lane, WSI8);
        tr_matrix<0, 2>(args.in[I_WQUP],  1,  QLORA,  NH * QKD, (bf16_t*)(ws + W_QUP),   NH * QKD,   R6,  gw, NGW, scr, lane, WSU8);
        tr_matrix<0, 2>(args.in[I_WKVUP], 1,  KVLORA, NH * 256, (bf16_t*)(ws + W_KVUP),  NH * 256,   R7,  gw, NGW, scr, lane, WSU8);
        tr_matrix<0, 1>(args.in[I_MLAWO], 1,  D,      D,        (bf16_t*)(ws + W_MLAO),  D,          R8,  gw, NGW, scr, lane);
        tr_matrix6<1>(args.in[I_MOEG], NE, D, FF, ws + W_MOEGU, 2 * FF, R9, gw, NGW, lane, WSC6);
        { u32x4* z = (u32x4*)(ws + W_MLAIN + (size_t)MLA_IN * D); const int nz = (MLA_IN_PAD - MLA_IN) * D / 16;
          for (int i = gtid; i < nz; i += NGT) z[i] = (u32x4){0u, 0u, 0u, 0u}; }
        { bf16_t* Wg = (bf16_t*)(ws + W_GATE); const float* wa = args.in[I_RGWA]; const float* wx = args.in[I_RGWX];
          for (int idx = gtid; idx < 16 * 256 * 256; idx += NGT) { const int h = idx >> 16, n = (idx >> 8) & 255, k = idx & 255, kl = k - 128 * (h & 1);
              float v = 0.f; if (kl >= 0 && kl < 128) v = (n < 128) ? wa[((size_t)h * 128 + kl) * 128 + n] : wx[((size_t)h * 128 + kl) * 128 + (n - 128)];
              Wg[idx] = (bf16_t)(cvtpk(v, 0.f) & 0xffffu); } }
        for (int c = gtid; c < D; c += NGT) { const float lam = args.in[I_LAM][c]; csp[c] = 8.0f * 1.4426950408889634f * log1pf(expf(-lam)); }
        norm_rows<true>(args.in[I_X], args.in[I_ANM], XB, gw, NGW, lane);
    }
    GRID_BAR();

    if (PH(1)) RP(1)
    {
        pg8::Gemm g{XB, (const bf16_t*)(ws + W_IN1), D, D, D};
        pg8::SchedPlain S; S.T.init(M / 256, 2 * D / 256, G, bx); S.atile = (size_t)256 * D; S.btile = (size_t)256 * D;
        pg8::EpiBf16 E{(bf16_t*)(ws + A_U), 2 * D, 1.0f / (WSI8 * ASI8)};
        pg8::gemm_phase8<pg8::EpiBf16, pg8::SchedPlain, 2>(lds, g, S, E);
    }
    GRID_BAR();

    if (PH(2)) RP(2)
    {
        IDS();
        const bf16_t* __restrict__ U = (const bf16_t*)(ws + A_U); bf16_t* __restrict__ XC = (bf16_t*)(ws + A_XC);
        const float* __restrict__ cw = args.in[I_CONVW]; const float* __restrict__ cb = args.in[I_CONVB];
        const int cg = tid & 255, r0 = bx * RPB + (tid >> 8) * (RPB / 2);
        float wk[4][8], bias[8];
#pragma unroll
        for (int k = 0; k < 4; ++k) { const f32x4 w0 = *(const f32x4*)(cw + k * D + cg * 8), w1 = *(const f32x4*)(cw + k * D + cg * 8 + 4);
            wk[k][0] = w0.x; wk[k][1] = w0.y; wk[k][2] = w0.z; wk[k][3] = w0.w; wk[k][4] = w1.x; wk[k][5] = w1.y; wk[k][6] = w1.z; wk[k][7] = w1.w; }
        { const f32x4 b0 = *(const f32x4*)(cb + cg * 8), b1 = *(const f32x4*)(cb + cg * 8 + 4); bias[0] = b0.x; bias[1] = b0.y; bias[2] = b0.z; bias[3] = b0.w; bias[4] = b1.x; bias[5] = b1.y; bias[6] = b1.z; bias[7] = b1.w; }
        const bf16_t* rec = U + (size_t)r0 * (2 * D) + D + cg * 8;
        bf16_t* dst = XC + (size_t)r0 * D + cg * 8;
        u32x4 x3 = {0u, 0u, 0u, 0u}, x2 = x3, x1 = x3;
        if ((r0 & (SEQ - 1)) != 0) { x3 = *(const u32x4*)(rec - 3 * (2 * D)); x2 = *(const u32x4*)(rec - 2 * (2 * D)); x1 = *(const u32x4*)(rec - 1 * (2 * D)); }
#pragma unroll 1
        for (int tb = 0; tb < RPB / 2; tb += 8) {
            u32x4 xn[8];
#pragma unroll
            for (int u = 0; u < 8; ++u) xn[u] = *(const u32x4*)(rec + (size_t)(tb + u) * (2 * D));
#pragma unroll
            for (int u = 0; u < 8; ++u) {
                const u32x4 x0 = xn[u]; float acc[8];
#define CONV_TAP(K_, X_) do { acc[0] += wk[K_][0] * bflo(X_.x); acc[1] += wk[K_][1] * bfhi(X_.x); acc[2] += wk[K_][2] * bflo(X_.y); acc[3] += wk[K_][3] * bfhi(X_.y); \
                              acc[4] += wk[K_][4] * bflo(X_.z); acc[5] += wk[K_][5] * bfhi(X_.z); acc[6] += wk[K_][6] * bflo(X_.w); acc[7] += wk[K_][7] * bfhi(X_.w); } while (0)
#pragma unroll
                for (int e = 0; e < 8; ++e) acc[e] = bias[e];
                CONV_TAP(0, x3); CONV_TAP(1, x2); CONV_TAP(2, x1); CONV_TAP(3, x0);
#undef CONV_TAP
                u32x4 o; o.x = cvtpk(acc[0], acc[1]); o.y = cvtpk(acc[2], acc[3]); o.z = cvtpk(acc[4], acc[5]); o.w = cvtpk(acc[6], acc[7]);
                *(u32x4*)(dst + (size_t)(tb + u) * D) = o;
                x3 = x2; x2 = x1; x1 = x0;
            }
        }
    }
    GRID_BAR();

    if (PH(3)) RP(3)
    {
        pg8::Gemm g{(const bf16_t*)(ws + A_XC), (const bf16_t*)(ws + W_GATE), D, 256, 256};
        pg8::SchedGate S; S.T.init(M / 256, 16, G, bx);
        pg8::EpiGate E{(const bf16_t*)(ws + A_XC), args.in[I_RGBA], args.in[I_RGBX], csp, (unsigned*)(ws + A_AV)};
        pg8::gemm_phase(lds, g, S, E);
    }
    GRID_BAR();

    if (PH(4)) RP(4)
    {
        IDS();
        const unsigned* __restrict__ AB = (const unsigned*)(ws + A_AV);
        float* __restrict__ AGA = (float*)(ws + WS_AGGA); float* __restrict__ AGB = (float*)(ws + WS_AGGB);
        for (int item = bx; item < NBATCH * NCH; item += G) {
            const size_t r0 = (size_t)item * SCH;
            f32x4 A = {1.f, 1.f, 1.f, 1.f}, B = {0.f, 0.f, 0.f, 0.f};
#pragma unroll 8
            for (int t = 0; t < SCH; ++t) { const u32x4 w = *(const u32x4*)(AB + (r0 + t) * D + 4 * tid);
                const f32x4 a = {__builtin_amdgcn_exp2f(bflo(w.x)), __builtin_amdgcn_exp2f(bflo(w.y)), __builtin_amdgcn_exp2f(bflo(w.z)), __builtin_amdgcn_exp2f(bflo(w.w))};
                const f32x4 b = {bfhi(w.x), bfhi(w.y), bfhi(w.z), bfhi(w.w)}; A = A * a; B = a * B + b; }
            *(f32x4*)(AGA + (size_t)item * D + 4 * tid) = A; *(f32x4*)(AGB + (size_t)item * D + 4 * tid) = B;
        }
    }
    GRID_BAR();

    if (PH(5)) RP(5)
    {
        IDS();
        const unsigned* __restrict__ AB = (const unsigned*)(ws + A_AV);
        const float* __restrict__ AGA = (const float*)(ws + WS_AGGA); const float* __restrict__ AGB = (const float*)(ws + WS_AGGB);
        const bf16_t* __restrict__ U = (const bf16_t*)(ws + A_U); bf16_t* __restrict__ Y = (bf16_t*)(ws + A_Y);
        for (int item = bx; item < NBATCH * NCH; item += G) {
            const int b = item / NCH, ch = item - b * NCH; const size_t r0 = (size_t)item * SCH;
            f32x4 h = {0.f, 0.f, 0.f, 0.f};
#pragma unroll 8
            for (int c = 0; c < ch; ++c) { const f32x4 a = *(const f32x4*)(AGA + (size_t)(b * NCH + c) * D + 4 * tid), bb = *(const f32x4*)(AGB + (size_t)(b * NCH + c) * D + 4 * tid); h = a * h + bb; }
#pragma unroll 8
            for (int t = 0; t < SCH; ++t) {
                const u32x4 pw = *(const u32x4*)(AB + (r0 + t) * D + 4 * tid);
                const f32x4 a = {__builtin_amdgcn_exp2f(bflo(pw.x)), __builtin_amdgcn_exp2f(bflo(pw.y)), __builtin_amdgcn_exp2f(bflo(pw.z)), __builtin_amdgcn_exp2f(bflo(pw.w))};
                const f32x4 bb = {bfhi(pw.x), bfhi(pw.y), bfhi(pw.z), bfhi(pw.w)};
                const u32x2 gw2 = *(const u32x2*)(U + (r0 + t) * (2 * D) + 4 * tid);
                h = a * h + bb;
                const float y0 = h.x * gelu_tanh(bflo(gw2.x)), y1 = h.y * gelu_tanh(bfhi(gw2.x)), y2 = h.z * gelu_tanh(bflo(gw2.y)), y3 = h.w * gelu_tanh(bfhi(gw2.y));
                u32x2 w; w.x = cvtpk(y0, y1); w.y = cvtpk(y2, y3);
                *(u32x2*)(Y + (r0 + t) * D + 4 * tid) = w;
            }
        }
    }
    GRID_BAR();

    if (PH(6)) RP(6)
    {
        pg8::Gemm g{(const bf16_t*)(ws + A_Y), (const bf16_t*)(ws + W_OUT1), D, D, D};
        pg8::SchedPlain S; S.T.init(M / 256, D / 256, G, bx); S.atile = (size_t)256 * D * 2; S.btile = (size_t)256 * D * 2;
        pg8::EpiResidual E{args.in[I_X], out, D, 1.0f};
        pg8::gemm_phase(lds, g, S, E);
    }
    GRID_BAR();
    if (PH(7)) RP(7)
    { IDS(); norm_rows<true>(out, args.in[I_ANF], XB, gw, NGW, lane); }
    GRID_BAR();
    if (PH(8)) RP(8)
    {
        pg8::Gemm g{XB, (const bf16_t*)(ws + W_FFGU), D, D, D};
        pg8::SchedPlain S; S.T.init(M / 256, 2 * FF / 256, G, bx); S.atile = (size_t)256 * D; S.btile = (size_t)256 * D;
        pg8::EpiSwiglu<2> E{(void*)(ws + A_H), FF, 1.0f / (WSI8 * ASI8), HSI8};
        pg8::gemm_phase8<pg8::EpiSwiglu<2>, pg8::SchedPlain, 2>(lds, g, S, E);
    }
    GRID_BAR();
    if (PH(9)) RP(9)
    {
        pg8::Gemm g{(const bf16_t*)(ws + A_H), (const bf16_t*)(ws + W_FFD), FF, FF, FF};
        pg8::SchedPlain S; S.T.init(M / 256, D / 256, G, bx); S.atile = (size_t)256 * FF; S.btile = (size_t)256 * FF;
        pg8::EpiResidual E{out, out, D, 1.0f / (WSD8 * HSI8)};
        pg8::gemm_phase8<pg8::EpiResidual, pg8::SchedPlain, 2>(lds, g, S, E);
    }
    GRID_BAR();
    if (PH(10)) RP(10)
    { IDS(); norm_rows<true>(out, args.in[I_BNM], XB, gw, NGW, lane); }
    GRID_BAR();
    if (PH(11)) RP(11)
    {
        pg8::Gemm g{XB, (const bf16_t*)(ws + W_MLAIN), D, D, D};
        pg8::SchedPlain S; S.T.init(M / 256, 4, G, bx); S.atile = (size_t)256 * D; S.btile = (size_t)256 * D;
        pg8::EpiBf16 E{(bf16_t*)(ws + A_CU), MLA_IN_PAD, 1.0f / (WSI8 * ASI8)};
        pg8::gemm_phase8<pg8::EpiBf16, pg8::SchedPlain, 2>(lds, g, S, E);
    }
    if (PH(11)) RP(11)
    {
        pg8::Gemm g{XB, (const bf16_t*)(ws + W_MLAIN), D, D, D / 4};
        pg8::SchedKSplit S{G, bx, M / 256, 4, 4, (size_t)256 * D, (size_t)256 * D, (size_t)(D / 4)};
        pg8::EpiKpe E{(float*)(ws + A_KPP), 4, 1.0f / (WSI8 * ASI8)};
        pg8::gemm_phase8<pg8::EpiKpe, pg8::SchedKSplit, 2>(lds, g, S, E);
    }
    GRID_BAR();
    if (PH(12)) RP(12)
    {
        IDS();
        const bf16_t* __restrict__ CU = (const bf16_t*)(ws + A_CU); bf16_t* __restrict__ CQ = (bf16_t*)(ws + A_CQ); bf16_t* __restrict__ CKV = (bf16_t*)(ws + A_CKV); bf16_t* __restrict__ KPE = (bf16_t*)(ws + A_KPE);
        const int* __restrict__ posv = args.positions; float* __restrict__ CST = (float*)(ws + A_CST); const float* __restrict__ KPP = (const float*)(ws + A_KPP);
        const f32x4 gq0 = *(const f32x4*)(args.in[I_QNORM] + 4 * lane), gq1 = *(const f32x4*)(args.in[I_QNORM] + 256 + 4 * lane);
        const f32x4 gk0 = *(const f32x4*)(args.in[I_KVNORM] + 4 * lane), gk1 = *(const f32x4*)(args.in[I_KVNORM] + 256 + 4 * lane);
        const double invf = INV_FREQ[lane & 31];
#pragma unroll 2
        for (int m = gw; m < M; m += NGW) {
            const bf16_t* r = CU + (size_t)m * MLA_IN_PAD;
            const u32x2 wq0 = *(const u32x2*)(r + 4 * lane), wq1 = *(const u32x2*)(r + 256 + 4 * lane), wk0 = *(const u32x2*)(r + 512 + 4 * lane), wk1 = *(const u32x2*)(r + 768 + 4 * lane);
            const f32x4 q0 = {bflo(wq0.x), bfhi(wq0.x), bflo(wq0.y), bfhi(wq0.y)}, q1 = {bflo(wq1.x), bfhi(wq1.x), bflo(wq1.y), bfhi(wq1.y)};
            const f32x4 k0 = {bflo(wk0.x), bfhi(wk0.x), bflo(wk0.y), bfhi(wk0.y)}, k1 = {bflo(wk1.x), bfhi(wk1.x), bflo(wk1.y), bfhi(wk1.y)};
            const float* kp = KPP + (size_t)m * 64 + (lane & 31);
            const float x1 = (kp[0] + kp[(size_t)M * 64]) + (kp[(size_t)2 * M * 64] + kp[(size_t)3 * M * 64]), x2 = (kp[32] + kp[(size_t)M * 64 + 32]) + (kp[(size_t)2 * M * 64 + 32] + kp[(size_t)3 * M * 64 + 32]);
            const float rq = 1.0f / sqrtf(wave_sum(dot4(q0) + dot4(q1)) * (1.0f / QLORA) + EPS), rk = 1.0f / sqrtf(wave_sum(dot4(k0) + dot4(k1)) * (1.0f / KVLORA) + EPS);
            { const f32x4 y0 = q0 * (rq * ASI8) * gq0, y1 = q1 * (rq * ASI8) * gq1;
              *(unsigned*)((unsigned char*)CQ + (size_t)m * QLORA + 4 * lane) = pk4_i8(y0.x, y0.y, y0.z, y0.w); *(unsigned*)((unsigned char*)CQ + (size_t)m * QLORA + 256 + 4 * lane) = pk4_i8(y1.x, y1.y, y1.z, y1.w); }
            { const f32x4 y0 = k0 * (rk * ASI8) * gk0, y1 = k1 * (rk * ASI8) * gk1;
              *(unsigned*)((unsigned char*)CKV + (size_t)m * KVLORA + 4 * lane) = pk4_i8(y0.x, y0.y, y0.z, y0.w); *(unsigned*)((unsigned char*)CKV + (size_t)m * KVLORA + 256 + 4 * lane) = pk4_i8(y1.x, y1.y, y1.z, y1.w); }
            float cs, sn; rope_cs(posv[m], invf, cs, sn);
            const float o1 = x1 * cs - x2 * sn, o2 = x2 * cs + x1 * sn;
            CST[(size_t)m * 64 + lane] = (lane < 32) ? cs : sn;
            if (lane < 32) { KPE[(size_t)m * ROPE + lane] = (bf16_t)(cvtpk(o1, 0.f) & 0xffffu); KPE[(size_t)m * ROPE + 32 + lane] = (bf16_t)(cvtpk(o2, 0.f) & 0xffffu); }
        }
    }
    GRID_BAR();
    if (PH(13)) RP(13)
    {
        pg8::Gemm g{(const bf16_t*)(ws + A_CQ), (const bf16_t*)(ws + W_QUP), QLORA, QLORA, QLORA};
        pg8::SchedPlain S; S.T.init(M / 256, NH * QKD / 256, G, bx); S.atile = (size_t)256 * QLORA; S.btile = (size_t)256 * QLORA;
        pg8::EpiFp8 E{ws + A_Q, NH * QKD, QSCALE * att::QS8 / (WSU8 * ASI8)};
        pg8::gemm_phase8<pg8::EpiFp8, pg8::SchedPlain, 2>(lds, g, S, E);
    }
    if (PH(22)) RP(22)
    {
        pg8::Gemm g{(const bf16_t*)(ws + A_CKV), (const bf16_t*)(ws + W_KVUP), KVLORA, KVLORA, KVLORA};
        pg8::SchedPlain S; S.T.init(M / 256, NH * 256 / 256, G, bx); S.atile = (size_t)256 * KVLORA; S.btile = (size_t)256 * KVLORA;
        pg8::EpiFp8 E{ws + A_KV, NH * 256, 1.0f / (WSU8 * ASI8)};
        pg8::gemm_phase8<pg8::EpiFp8, pg8::SchedPlain, 2>(lds, g, S, E);
    }
    GRID_BAR();
    if (PH(15)) RP(15)
    {
        const int vcu = (G % 8 == 0) ? (bx % 8) * (G / 8) + bx / 8 : bx;
        att::CvtState cs{args.in[I_MOED], ws + W_MOED, args.in[I_MOEU], ws + W_MOEGU, gw, 0};
        for (int L = vcu; L < NBATCH * NH * 8; L += G) {
            const int bh = L >> 3, x = L & 7, b = bh / NH, h = bh - b * NH;
#pragma nounroll
            for (int pass = 0; pass < 2; ++pass)
                att::attn_unit(lds, ws + A_Q, ws + A_KV, (const bf16_t*)(ws + A_KPE), (const float*)(ws + A_CST), (bf16_t*)(ws + A_O), b, h, pass ? x : 15 - x, cs);
        }
        { const int lane_ = opaque_tid() & 63;
#pragma nounroll
          while (cs.next < att::CV_IPW + att::CU_IPW) { f32x4 cv[8]; att::cvt_load(cs, lane_, cv); att::cvt_store(cs, lane_, cv); } }
    }
    GRID_BAR();
    if (PH(16)) RP(16)
    {
        pg8::Gemm g{(const bf16_t*)(ws + A_O), (const bf16_t*)(ws + W_MLAO), D, D, D};
        pg8::SchedPlain S; S.T.init(M / 256, D / 256, G, bx); S.atile = (size_t)256 * D; S.btile = (size_t)256 * D;
        pg8::EpiResidual E{out, out, D, 1.0f / (WSC8 * att::OSC8)};
        pg8::gemm_phase8<pg8::EpiResidual, pg8::SchedPlain, 0>(lds, g, S, E);
    }
    GRID_BAR();
    int* CNT = (int*)(ws + TAB_CNT); int* TILE = (int*)(ws + TAB_TILE); int* SLOT = (int*)(ws + TAB_SLOT); float* GATE = (float*)(ws + TAB_GATE); int* TOPE = (int*)(ws + TAB_TOPE);
    if (PH(17)) RP(17)
    {
        IDS();
        LAS float* wr = (LAS float*)lds;
        LAS int* tl = (LAS int*)(lds + 65536);
        const float* gain = args.in[I_BNF]; const float* wrt = args.in[I_ROUTER];
        for (int d = tid; d < D; d += NTHREADS) { const float gd = gain[d]; const f32x4 a = *(const f32x4*)(wrt + (size_t)d * 8), c = *(const f32x4*)(wrt + (size_t)d * 8 + 4);
            wr[0 * D + d] = a.x * gd; wr[1 * D + d] = a.y * gd; wr[2 * D + d] = a.z * gd; wr[3 * D + d] = a.w * gd; wr[4 * D + d] = c.x * gd; wr[5 * D + d] = c.y * gd; wr[6 * D + d] = c.z * gd; wr[7 * D + d] = c.w * gd; }
        f32x4 g[8];
#pragma unroll
        for (int j = 0; j < 8; ++j) g[j] = *(const f32x4*)(gain + 4 * lane + 256 * j);
        __syncthreads();
        for (int i = 0; i < RPB / NWAVES; i += 2) {
            const int rl = wave * (RPB / NWAVES) + i, m = bx * RPB + rl;
            const f32x4* xr = (const f32x4*)(out + (size_t)m * D) + lane;
            f32x4 va[8], vb[8]; float sa = 0.f, sb = 0.f;
#pragma unroll
            for (int j = 0; j < 8; ++j) { va[j] = xr[64 * j]; vb[j] = xr[64 * j + D / 4]; }
#pragma unroll
            for (int j = 0; j < 8; ++j) { sa += dot4(va[j]); sb += dot4(vb[j]); }
            float la[8], lb[8];
#pragma unroll
            for (int e = 0; e < 8; ++e) { float a = 0.f, b = 0.f;
#pragma unroll
                for (int j = 0; j < 8; ++j) { const f32x4 w = *(const LAS f32x4*)(wr + e * D + 4 * lane + 256 * j);
                    a += (va[j].x * w.x + va[j].y * w.y) + (va[j].z * w.z + va[j].w * w.w); b += (vb[j].x * w.x + vb[j].y * w.y) + (vb[j].z * w.z + vb[j].w * w.w); }
                la[e] = a; lb[e] = b; }
            const float ra = 1.0f / sqrtf(wave_sum(sa) * (1.0f / D) + EPS), rb = 1.0f / sqrtf(wave_sum(sb) * (1.0f / D) + EPS);
#pragma unroll
            for (int e = 0; e < 8; ++e) { la[e] = wave_sum(la[e]) * ra; lb[e] = wave_sum(lb[e]) * rb; }
#pragma unroll
            for (int rr = 0; rr < 2; ++rr) {
                float lg[8];
#pragma unroll
                for (int e = 0; e < 8; ++e) lg[e] = rr ? lb[e] : la[e];
                int e1 = 0; float v1 = lg[0];
#pragma unroll
                for (int e = 1; e < 8; ++e) if (lg[e] > v1) { v1 = lg[e]; e1 = e; }
                int e2 = -1; float v2 = -__builtin_inff();
#pragma unroll
                for (int e = 0; e < 8; ++e) if (e != e1 && lg[e] > v2) { v2 = lg[e]; e2 = e; }
                const float g2 = 1.0f / (1.0f + expf(v1 - v2)), g1 = 1.0f - g2;
                if (lane == 0) { tl[2 * (rl + rr)] = e1; tl[2 * (rl + rr) + 1] = e2; TOPE[2 * (m + rr)] = e1; TOPE[2 * (m + rr) + 1] = e2; GATE[2 * (m + rr)] = g1; GATE[2 * (m + rr) + 1] = g2; }
            }
            u32x2* o = (u32x2*)(XB + (size_t)m * D) + lane;
#pragma unroll
            for (int j = 0; j < 8; ++j) { const f32x4 ya = va[j] * ra * g[j], yb = vb[j] * rb * g[j]; u32x2 wa, wb; wa.x = cvtpk(ya.x, ya.y); wa.y = cvtpk(ya.z, ya.w); wb.x = cvtpk(yb.x, yb.y); wb.y = cvtpk(yb.z, yb.w);
                o[64 * j] = wa; o[64 * j + D / 4] = wb; }
        }
        __syncthreads();
        if (tid < NE) { int c = 0; for (int i = 0; i < 2 * RPB; ++i) c += (tl[i] == tid) ? 1 : 0; CNT[bx * NE + tid] = c; }
        __syncthreads();
    }
    GRID_BAR();
    if (PH(18)) RP(18)
    {
        IDS();
        LAS int* sh = (LAS int*)lds;
        if (tid < NE) { int before = 0, total = 0; for (int bb = 0; bb < G; ++bb) { const int c = CNT[bb * NE + tid]; total += c; before += (bb < bx) ? c : 0; } sh[tid] = before; sh[16 + tid] = total; }
        if (tid >= 64 && tid < 64 + 2 * RPB) sh[32 + (tid - 64)] = TOPE[2 * bx * RPB + (tid - 64)];
        __syncthreads();
        if (tid == 0) { int ps = 0; for (int e = 0; e < NE; ++e) { sh[8 + e] = ps; ps += ((sh[16 + e] + 255) >> 8) << 8; }
            if (bx == 0) { int ti = 0; for (int e = 0; e < NE; ++e) { const int ntl = (sh[16 + e] + 255) >> 8; for (int q = 0; q < ntl; ++q) TILE[ti++] = e; } TILE[255] = ti; } }
        __syncthreads();
        if (tid < 2 * RPB) { const int e = sh[32 + tid]; int rank = 0; for (int j = 0; j < tid; ++j) rank += (sh[32 + j] == e) ? 1 : 0;
            const int slot = sh[8 + e] + sh[e] + rank; sh[160 + tid] = slot; SLOT[2 * bx * RPB + tid] = slot; }
        __syncthreads();
        unsigned char* BUF = ws + A_BUF;
        for (int en = wave; en < 2 * RPB; en += 2 * NWAVES) {
            u32x4 s[2][4]; int slot[2];
#pragma unroll
            for (int qq = 0; qq < 2; ++qq) { const int e_ = en + qq * NWAVES, m = bx * RPB + (e_ >> 1); slot[qq] = sh[160 + e_];
                const u32x4* src = (const u32x4*)(XB + (size_t)m * D + 32 * lane);
#pragma unroll
                for (int j = 0; j < 4; ++j) s[qq][j] = src[j]; }
#pragma unroll
            for (int qq = 0; qq < 2; ++qq) { float x[32];
#pragma unroll
                for (int j = 0; j < 4; ++j) { const u32x4 t = s[qq][j]; x[8 * j + 0] = bflo(t.x) * ASC6; x[8 * j + 1] = bfhi(t.x) * ASC6; x[8 * j + 2] = bflo(t.y) * ASC6; x[8 * j + 3] = bfhi(t.y) * ASC6;
                    x[8 * j + 4] = bflo(t.z) * ASC6; x[8 * j + 5] = bfhi(t.z) * ASC6; x[8 * j + 6] = bflo(t.w) * ASC6; x[8 * j + 7] = bfhi(t.w) * ASC6; }
                const v6u w = pk32_fp6(x); unsigned char* dst = BUF + (size_t)slot[qq] * D + 32 * lane;
                *(u32x4*)dst = (u32x4){w[0], w[1], w[2], w[3]}; *(u32x4*)(dst + 16) = (u32x4){w[4], w[5], 0u, 0u}; } }
        __syncthreads();
    }
    GRID_BAR();
    if (PH(19)) RP(19)
    {
        LAS int* tlds = (LAS int*)(lds + LDSCTL_OFF + 1024);
        { IDS(); if (tid < 256) tlds[tid] = TILE[tid]; __syncthreads(); }
        const int ntiles = tlds[255];
        pg8::Gemm g{(const bf16_t*)(ws + A_BUF), (const bf16_t*)(ws + W_MOEGU), D, D, D};
        pg8::SchedMoe S; S.T.init(ntiles, 2 * FF / 256, G, bx); S.tile_e = tlds; S.atile = (size_t)256 * D; S.btile = (size_t)256 * D; S.nN = 2 * FF / 256;
        pg8::EpiSwiglu<1> E{(void*)(ws + A_HM), FF, 1.0f / (WSC6 * ASC6), HSC8};
        pg8::gemm_phase8<pg8::EpiSwiglu<1>, pg8::SchedMoe, 1>(lds, g, S, E);
    }
    GRID_BAR();
    if (PH(20)) RP(20)
    {
        LAS int* tlds = (LAS int*)(lds + LDSCTL_OFF + 1024);
        { IDS(); if (tid < 256) tlds[tid] = TILE[tid]; __syncthreads(); }
        const int ntiles = tlds[255], nmain = ntiles < MAIN_TILES ? ntiles : MAIN_TILES;
        {
            pg8::Gemm g{(const bf16_t*)(ws + A_HM), (const bf16_t*)(ws + W_MOED), FF, FF, FF};
            pg8::SchedMoe S; S.T.init(nmain, D / 256, G, bx); S.tile_e = tlds; S.atile = (size_t)256 * FF; S.btile = (size_t)256 * FF; S.nN = D / 256;
            pg8::EpiBf16 E{(bf16_t*)(ws + A_YM), D, 1.0f / (WSC8 * HSC8)};
            pg8::gemm_phase8(lds, g, S, E);
        }
        if (ntiles > MAIN_TILES) {
            pg8::Gemm g{(const bf16_t*)(ws + A_HM), (const bf16_t*)(ws + W_MOED), FF, FF, FF / KSPLIT};
            pg8::SchedMoeSplit S; S.G = G; S.c = bx; S.pm0 = MAIN_TILES; S.nN = D / 256; S.ntl = (ntiles - MAIN_TILES) * (D / 256); S.KS = KSPLIT; S.tile_e = tlds;
            S.atile = (size_t)256 * FF; S.btile = (size_t)256 * FF; S.kbytes = FF / KSPLIT;
            pg8::EpiBf16Split E{(bf16_t*)(ws + A_YP) - (size_t)MAIN_TILES * 256 * D, D, 1.0f / (WSC8 * HSC8), (size_t)(MAXT - MAIN_TILES) * 256 * D};
            pg8::gemm_phase8(lds, g, S, E);
        }
    }
    GRID_BAR();
    if (PH(21)) RP(21)
    {
        IDS();
        const bf16_t* YM = (const bf16_t*)(ws + A_YM); const float* gain = args.in[I_FNORM];
        const bf16_t* YP = (const bf16_t*)(ws + A_YP); constexpr size_t YPS = (size_t)(MAXT - MAIN_TILES) * 256 * D;
        const bool poison = xb_ld((unsigned*)(ws + WS_CTL) + 1024 + XB_TMO) != 0u;
        f32x4 g[8];
#pragma unroll
        for (int j = 0; j < 8; ++j) g[j] = *(const f32x4*)(gain + 4 * lane + 256 * j);
        for (int m = gw; m < M; m += NGW) {
            const int s1 = SLOT[2 * m], s2 = SLOT[2 * m + 1]; const float g1 = GATE[2 * m], g2 = GATE[2 * m + 1];
            f32x4* xr = (f32x4*)(out + (size_t)m * D) + lane;
            const u32x2* y1 = (const u32x2*)(YM + (size_t)s1 * D) + lane; const u32x2* y2 = (const u32x2*)(YM + (size_t)s2 * D) + lane;
            f32x4 v[8]; float s = 0.f;
            if (s1 < MAIN_TILES * 256 && s2 < MAIN_TILES * 256) {
#pragma unroll
            for (int j = 0; j < 8; ++j) { const f32x4 x = xr[64 * j]; const u32x2 a = y1[64 * j], b = y2[64 * j];
                f32x4 t; t.x = x.x + g1 * bflo(a.x) + g2 * bflo(b.x); t.y = x.y + g1 * bfhi(a.x) + g2 * bfhi(b.x); t.z = x.z + g1 * bflo(a.y) + g2 * bflo(b.y); t.w = x.w + g1 * bfhi(a.y) + g2 * bfhi(b.y);
                v[j] = t; s += dot4(t); }
            } else {
#pragma unroll
                for (int j = 0; j < 8; ++j) v[j] = xr[64 * j];
#pragma unroll
                for (int k = 0; k < 2; ++k) { const int sl = k ? s2 : s1; const float gk = k ? g2 : g1;
                    const int np = (sl < MAIN_TILES * 256) ? 1 : KSPLIT;
                    const bf16_t* base = (sl < MAIN_TILES * 256) ? YM + (size_t)sl * D : YP + (size_t)(sl - MAIN_TILES * 256) * D;
                    for (int kc = 0; kc < np; ++kc) { const u32x2* y = (const u32x2*)(base + (size_t)kc * YPS) + lane;
#pragma unroll
                        for (int j = 0; j < 8; ++j) { const u32x2 a = y[64 * j]; v[j].x += gk * bflo(a.x); v[j].y += gk * bfhi(a.x); v[j].z += gk * bflo(a.y); v[j].w += gk * bfhi(a.y); } } }
#pragma unroll
                for (int j = 0; j < 8; ++j) s += dot4(v[j]);
            }
            float rstd = 1.0f / sqrtf(wave_sum(s) * (1.0f / D) + EPS);
            if (poison) rstd = __builtin_nanf("");
#pragma unroll
            for (int j = 0; j < 8; ++j) xr[64 * j] = v[j] * rstd * g[j];
        }
    }
}

extern "C" void kernel_launch(void* const* d_in, const int* in_sizes, int n_in, void* d_out, int out_size, void* d_ws, size_t ws_size, hipStream_t stream) {
    static int ready = 0;
    if (ready == 0) {
        if (n_in != 29 || in_sizes[0] != M * D || out_size != M * D || ws_size < WS_END) {
            fprintf(stderr, "kernel_launch: unexpected shapes (n_in %d, in0 %d, out %d, ws %zu, need %zu); nothing launched\n", n_in, n_in > 0 ? in_sizes[0] : -1, out_size, ws_size, (size_t)WS_END); ready = -1; return; }
        if (hipFuncSetAttribute((const void*)fwd_kernel, hipFuncAttributeMaxDynamicSharedMemorySize, LDS_BYTES) != hipSuccess) { fprintf(stderr, "kernel_launch: hipFuncSetAttribute failed\n"); ready = -1; return; }
        int per_cu = 0;
        if (hipOccupancyMaxActiveBlocksPerMultiprocessor(&per_cu, (const void*)fwd_kernel, NTHREADS, LDS_BYTES) != hipSuccess || per_cu < 1) fprintf(stderr, "kernel_launch: occupancy query reports %d workgroups per CU\n", per_cu);
        (void)hipGetLastError();
        ready = 1;
    }
    if (ready < 0) return;
    (void)hipMemsetAsync((char*)d_ws + WS_CTL, 0, CTL_ZERO_BYTES, stream);
    Args a{};
    for (int i = 0; i < 29; ++i) a.in[i] = (const float*)d_in[i];
    a.positions = (const int*)d_in[I_POS]; a.out = (float*)d_out; a.ws = (unsigned char*)d_ws;
    hipLaunchKernelGGL(fwd_kernel, dim3(GRID), dim3(NTHREADS), LDS_BYTES, stream, a);
}
```

```cpp
#include <hip/hip_runtime.h>
#include <cstdio>
#include <cstdint>

#define GAS __attribute__((address_space(1)))
#define LAS __attribute__((address_space(3)))
typedef unsigned short bf16_t;
typedef short bf16x8 __attribute__((ext_vector_type(8)));
typedef short s16x4 __attribute__((ext_vector_type(4)));
typedef float f32x2 __attribute__((ext_vector_type(2)));
typedef float f32x4 __attribute__((ext_vector_type(4)));
typedef float f32x16 __attribute__((ext_vector_type(16)));
typedef unsigned u32x2 __attribute__((ext_vector_type(2)));
typedef unsigned u32x4 __attribute__((ext_vector_type(4)));

constexpr int D = 2048, SEQ = 4096, NBATCH = 4, M = NBATCH * SEQ;
constexpr int NH = 16, QLORA = 512, KVLORA = 512, NOPE = 128, ROPE = 64, VDIM = 128, QKD = 192;
constexpr int MLA_IN = 1088, MLA_IN_PAD = 1280;
constexpr int FF = 7168, NE = 8;
constexpr int PMAX = 2 * M + NE * 256;
constexpr int MAXT = PMAX / 256;
constexpr float EPS = 1e-6f;
constexpr float QSCALE = 0.10411754627697264f;
constexpr int GRID = 256, NWAVES = 8, NTHREADS = 512;
constexpr int RPB = M / GRID;
constexpr int SCH = 64, NCH = SEQ / SCH;

constexpr size_t MiB = 1u << 20;
constexpr size_t WS_CTL = 0, CTL_ZERO_BYTES = 64 * 1024;
constexpr size_t WS_TAB = 1 * MiB;
constexpr size_t TAB_CSP = WS_TAB, TAB_CNT = WS_TAB + 64 * 1024, TAB_TILE = WS_TAB + 128 * 1024, TAB_SLOT = WS_TAB + 256 * 1024,
                 TAB_GATE = WS_TAB + 512 * 1024, TAB_TOPE = WS_TAB + 768 * 1024;
constexpr size_t WS_AGGA = 2 * MiB, WS_AGGB = 4 * MiB;
constexpr size_t W_IN1 = 8 * MiB, W_GATE = 24 * MiB, W_OUT1 = 26 * MiB, W_FFGU = 34 * MiB, W_FFD = 90 * MiB, W_MLAIN = 118 * MiB,
                 W_QUP = 123 * MiB, W_KVUP = 126 * MiB, W_MLAO = 130 * MiB, W_MOEGU = 138 * MiB, W_MOED = 586 * MiB;
constexpr size_t WS_XB = 810 * MiB, WS_ACT = 874 * MiB;
constexpr size_t A_U = WS_ACT, A_XC = WS_ACT + 128 * MiB, A_AV = WS_ACT + 192 * MiB, A_BV = WS_ACT + 320 * MiB, A_Y = WS_ACT + 448 * MiB;
constexpr size_t A_H = WS_ACT;
constexpr size_t A_KPP = WS_ACT + 48 * MiB;
constexpr size_t A_CST = WS_ACT + 88 * MiB;
constexpr size_t A_CU = WS_ACT, A_CQ = WS_ACT + 80 * MiB, A_CKV = WS_ACT + 96 * MiB, A_KPE = WS_ACT + 112 * MiB, A_Q = WS_ACT + 114 * MiB,
                 A_KV = WS_ACT + 210 * MiB, A_O = WS_ACT + 338 * MiB;
constexpr size_t A_YP = WS_ACT + 400 * MiB;
constexpr int MAIN_TILES = 128, KSPLIT = 4;
constexpr size_t A_BUF = WS_ACT, A_HM = WS_ACT + 136 * MiB, A_YM = WS_ACT + 612 * MiB, WS_END = WS_ACT + 748 * MiB;
static_assert((size_t)PMAX * D * 2 <= 136 * MiB && (size_t)PMAX * FF * 2 <= 476 * MiB, "moe buffers");

constexpr int RING_BYTES = 135168;
constexpr int LDSCTL_OFF = RING_BYTES;
constexpr int LDS_BYTES = 147456;

__device__ const double INV_FREQ[32] = {1.0, 0.7498942093324559, 0.5623413251903491, 0.4216965034285822, 0.31622776601683794, 0.23713737056616552, 0.1778279410038923, 0.1333521432163324, 0.1,
    0.07498942093324558, 0.05623413251903491, 0.042169650342858224, 0.03162277660168379, 0.023713737056616554, 0.01778279410038923, 0.01333521432163324, 0.01, 0.007498942093324558,
    0.005623413251903491, 0.004216965034285823, 0.0031622776601683794, 0.0023713737056616554, 0.0017782794100389228, 0.001333521432163324, 0.001, 0.0007498942093324559, 0.0005623413251903491,
    0.00042169650342858224, 0.00031622776601683794, 0.00023713737056616554, 0.00017782794100389227, 0.0001333521432163324};

__device__ __forceinline__ int opaque_tid() { int t = threadIdx.x; asm volatile("" : "+v"(t)); return t; }
#define LDS_WAIT() asm volatile("s_waitcnt lgkmcnt(0)" ::: "memory")
#define VM_WAIT() asm volatile("s_waitcnt vmcnt(0)" ::: "memory")
__device__ __forceinline__ unsigned cvtpk(float lo, float hi) { unsigned r; asm volatile("v_cvt_pk_bf16_f32 %0, %1, %2" : "=v"(r) : "v"(lo), "v"(hi)); return r; }
typedef int v8i __attribute__((ext_vector_type(8)));
typedef short v2s __attribute__((ext_vector_type(2)));
typedef __bf16 v2bf __attribute__((ext_vector_type(2)));
typedef int v4i __attribute__((ext_vector_type(4)));
__device__ __forceinline__ unsigned pk4_fp8(float a, float b, float c, float d) {
    a = __builtin_amdgcn_fmed3f(a, -448.f, 448.f); b = __builtin_amdgcn_fmed3f(b, -448.f, 448.f); c = __builtin_amdgcn_fmed3f(c, -448.f, 448.f); d = __builtin_amdgcn_fmed3f(d, -448.f, 448.f);
    int w = __builtin_amdgcn_cvt_pk_fp8_f32(a, b, 0, false); w = __builtin_amdgcn_cvt_pk_fp8_f32(c, d, w, true); return (unsigned)w; }
__device__ __forceinline__ unsigned pk4_i8(float a, float b, float c, float d) {
    const unsigned ua = __float_as_uint(__builtin_amdgcn_fmed3f(a, -127.f, 127.f) + 12582912.f), ub = __float_as_uint(__builtin_amdgcn_fmed3f(b, -127.f, 127.f) + 12582912.f);
    const unsigned uc = __float_as_uint(__builtin_amdgcn_fmed3f(c, -127.f, 127.f) + 12582912.f), ud = __float_as_uint(__builtin_amdgcn_fmed3f(d, -127.f, 127.f) + 12582912.f);
    const unsigned t1 = __builtin_amdgcn_perm(ub, ua, 0x0c0c0400u), t2 = __builtin_amdgcn_perm(ud, uc, 0x0c0c0400u);
    return __builtin_amdgcn_perm(t2, t1, 0x05040100u); }
typedef float v16f __attribute__((ext_vector_type(16)));
typedef unsigned v6u __attribute__((ext_vector_type(6)));
typedef int v6i __attribute__((ext_vector_type(6)));
typedef int v2i __attribute__((ext_vector_type(2)));
__device__ __forceinline__ v6u pk32_fp6(const float (&x)[32]) {
    v16f a, b;
#pragma unroll
    for (int i = 0; i < 16; ++i) { a[i] = __builtin_amdgcn_fmed3f(x[i], -7.5f, 7.5f); b[i] = __builtin_amdgcn_fmed3f(x[16 + i], -7.5f, 7.5f); }
    return __builtin_amdgcn_cvt_scalef32_2xpk16_fp6_f32(a, b, 1.0f);
}
__device__ __forceinline__ float bf2f(unsigned short u) { return __uint_as_float((unsigned)u << 16); }
__device__ __forceinline__ float bflo(unsigned w) { return __uint_as_float(w << 16); }
__device__ __forceinline__ float bfhi(unsigned w) { return __uint_as_float(w & 0xffff0000u); }
__device__ __forceinline__ float wave_sum(float v) {
#pragma unroll
    for (int o = 1; o < 64; o <<= 1) v += __shfl_xor(v, o);
    return v;
}
__device__ __forceinline__ float dot4(f32x4 a) { return (a.x * a.x + a.y * a.y) + (a.z * a.z + a.w * a.w); }
__device__ __forceinline__ float sigmoidf_(float x) { return __builtin_amdgcn_rcpf(1.0f + __expf(-x)); }
__device__ __forceinline__ float gelu_tanh(float x) { const float u = 1.5957691216057308f * (x + 0.044715f * x * x * x); return x * sigmoidf_(u); }

namespace pg8 {
constexpr int BM = 256, BK = 64, HALF = 128, HTB = HALF * BK * 2, STAGE_BYTES = 8 * HTB, NXCD = 8, WGM = 8;
__host__ __device__ __forceinline__ int lds_byte(int r, int c) { const int st = (r >> 4) * 2 + (c >> 5), rr = r & 15, cc = c & 31, ob = rr * 64 + cc * 2; return st * 1024 + (ob ^ (((ob >> 9) & 1) << 5)); }
__host__ __device__ __forceinline__ void stage_rc(int b, int& R, int& C) { const int st = b / 1024, sb = b % 1024, swz = sb ^ (((sb >> 9) & 1) << 5); R = (st >> 1) * 16 + swz / 64; C = (st & 1) * 32 + (swz % 64) / 2; }
__host__ __device__ __forceinline__ int perm32(int rho) { const int n = rho >> 4, i = rho & 15; return 8 * (i >> 2) + 4 * n + (i & 3); }

struct Unit { int pm, pn; size_t aoff, boff; };
struct Gemm { const bf16_t* A; const bf16_t* Bt; int lda, ldb, K; };

struct TileOrder {
    int nM, nN, nwg, G, c;
    __host__ __device__ void init(int nM_, int nN_, int G_, int c_) { nM = nM_; nN = nN_; nwg = nM * nN; G = G_; c = c_; }
    __host__ __device__ bool tile(int i, int& pm, int& pn) const {
        const long L = (long)i * G + c; if (L >= nwg) return false;
        int wgid = (int)L; { const int q = nwg / NXCD, r = nwg % NXCD, xcd = wgid % NXCD, off = wgid / NXCD; wgid = (xcd < r ? xcd * (q + 1) : r * (q + 1) + (xcd - r) * q) + off; }
        const int nig = WGM * nN, gid = wgid / nig, fm = gid * WGM, gsz = (nM - fm) < WGM ? (nM - fm) : WGM;
        pm = fm + ((wgid % nig) % gsz); pn = (wgid % nig) / gsz; return true;
    }
};
struct SchedPlain {
    TileOrder T; size_t atile, btile;
    __device__ __forceinline__ bool next(int i, Unit& u) const { if (!T.tile(i, u.pm, u.pn)) return false; u.aoff = (size_t)u.pm * atile; u.boff = (size_t)u.pn * btile; return true; }
    __device__ __forceinline__ void a_ready(const Unit&) const {}
    __device__ __forceinline__ void done(const Unit&) const {}
};
struct SchedKSplit {
    int G, c, nM, KS, pn0; size_t atile, btile, kbytes;
    __device__ __forceinline__ bool next(int i, Unit& u) const { const int L = i * G + c; if (L >= nM * KS) return false; const int kc = L / nM; u.pm = L - kc * nM; u.pn = pn0 + kc;
        u.aoff = (size_t)u.pm * atile + (size_t)kc * kbytes; u.boff = (size_t)pn0 * btile + (size_t)kc * kbytes; return true; }
    __device__ __forceinline__ void a_ready(const Unit&) const {}
    __device__ __forceinline__ void done(const Unit&) const {}
};
struct SchedMoeSplit {
    int G, c, pm0, ntl, nN, KS; const LAS int* tile_e; size_t atile, btile, kbytes;
    __device__ __forceinline__ bool next(int i, Unit& u) const { const int L = i * G + c; if (L >= ntl * KS) return false; const int kc = L / ntl, t = L - kc * ntl, pn = t % nN; u.pm = pm0 + t / nN; u.pn = pn + nN * kc;
        const int e = tile_e[u.pm] & 7; u.aoff = (size_t)u.pm * atile + (size_t)kc * kbytes; u.boff = ((size_t)e * nN + pn) * btile + (size_t)kc * kbytes; return true; }
    __device__ __forceinline__ void a_ready(const Unit&) const {}
    __device__ __forceinline__ void done(const Unit&) const {}
};
struct SchedGate {
    TileOrder T;
    __device__ __forceinline__ bool next(int i, Unit& u) const { if (!T.tile(i, u.pm, u.pn)) return false; u.aoff = (size_t)u.pm * 256 * D * 2 + (size_t)(u.pn >> 1) * 512; u.boff = (size_t)u.pn * 256 * 256 * 2; return true; }
    __device__ __forceinline__ void a_ready(const Unit&) const {}
    __device__ __forceinline__ void done(const Unit&) const {}
};
struct SchedMoe {
    TileOrder T; const LAS int* tile_e; size_t atile, btile; int nN;
    __device__ __forceinline__ bool next(int i, Unit& u) const { if (!T.tile(i, u.pm, u.pn)) return false; const int e = tile_e[u.pm] & 7; u.aoff = (size_t)u.pm * atile; u.boff = ((size_t)e * nN + u.pn) * btile; return true; }
    __device__ __forceinline__ void a_ready(const Unit&) const {}
    __device__ __forceinline__ void done(const Unit&) const {}
};

typedef f32x4 Acc[2][2][4][2];
struct EpiBf16 {
    static constexpr bool PERM = true;
    bf16_t* O; int ldc; float scale;
    __device__ __forceinline__ void operator()(const Acc& acc, const Unit& u, int wr, int wc, int fr, int fq) const {
        const int row0 = u.pm * BM + wr * 64 + fr, col0 = u.pn * BM + wc * 32 + 8 * fq;
#pragma unroll
        for (int ai = 0; ai < 2; ++ai)
#pragma unroll
            for (int m = 0; m < 4; ++m) { bf16_t* rowp = O + (size_t)(row0 + ai * HALF + m * 16) * ldc + col0;
#pragma unroll
                for (int bj = 0; bj < 2; ++bj) { const f32x4 v0 = acc[ai][bj][m][0] * scale, v1 = acc[ai][bj][m][1] * scale;
                    u32x4 w; w.x = cvtpk(v0[0], v0[1]); w.y = cvtpk(v0[2], v0[3]); w.z = cvtpk(v1[0], v1[1]); w.w = cvtpk(v1[2], v1[3]);
                    *(u32x4*)(rowp + bj * HALF) = w; } }
    }
};
struct EpiFp8 {
    static constexpr bool PERM = true;
    unsigned char* O; int ldc; float scale;
    __device__ __forceinline__ void operator()(const Acc& acc, const Unit& u, int wr, int wc, int fr, int fq) const {
        const int row0 = u.pm * BM + wr * 64 + fr, col0 = u.pn * BM + wc * 32 + 8 * fq;
#pragma unroll
        for (int ai = 0; ai < 2; ++ai)
#pragma unroll
            for (int m = 0; m < 4; ++m) { unsigned char* rowp = O + (size_t)(row0 + ai * HALF + m * 16) * ldc + col0;
#pragma unroll
                for (int bj = 0; bj < 2; ++bj) { const f32x4 v0 = acc[ai][bj][m][0] * scale, v1 = acc[ai][bj][m][1] * scale;
                    u32x2 w; w.x = pk4_fp8(v0[0], v0[1], v0[2], v0[3]); w.y = pk4_fp8(v1[0], v1[1], v1[2], v1[3]);
                    *(u32x2*)(rowp + bj * HALF) = w; } }
    }
};
struct EpiBf16Split {
    static constexpr bool PERM = true;
    bf16_t* O; int ldc; float scale; size_t kstride;
    __device__ __forceinline__ void operator()(const Acc& acc, const Unit& u, int wr, int wc, int fr, int fq) const {
        const int row0 = u.pm * BM + wr * 64 + fr, col0 = (u.pn & 7) * BM + wc * 32 + 8 * fq;
        bf16_t* Ob = O + (size_t)(u.pn >> 3) * kstride;
#pragma unroll
        for (int ai = 0; ai < 2; ++ai)
#pragma unroll
            for (int m = 0; m < 4; ++m) { bf16_t* rowp = Ob + (size_t)(row0 + ai * HALF + m * 16) * ldc + col0;
#pragma unroll
                for (int bj = 0; bj < 2; ++bj) { const f32x4 v0 = acc[ai][bj][m][0] * scale, v1 = acc[ai][bj][m][1] * scale;
                    u32x4 w; w.x = cvtpk(v0[0], v0[1]); w.y = cvtpk(v0[2], v0[3]); w.z = cvtpk(v1[0], v1[1]); w.w = cvtpk(v1[2], v1[3]);
                    *(u32x4*)(rowp + bj * HALF) = w; } }
    }
};
struct EpiKpe {
    static constexpr bool PERM = false;
    float* O; int pn0; float scale;
    __device__ __forceinline__ void operator()(const Acc& acc, const Unit& u, int wr, int wc, int fr, int fq) const {
        if (wc >= 2) return;
        const int kc = u.pn - pn0, row0 = u.pm * BM + wr * 64 + fr, col0 = wc * 32 + 4 * fq;
#pragma unroll
        for (int ai = 0; ai < 2; ++ai)
#pragma unroll
            for (int m = 0; m < 4; ++m) { float* rowp = O + ((size_t)kc * M + row0 + ai * HALF + m * 16) * 64 + col0;
#pragma unroll
                for (int n = 0; n < 2; ++n) *(f32x4*)(rowp + n * 16) = acc[ai][0][m][n] * scale; }
    }
};
struct EpiF32 {
    static constexpr bool PERM = false;
    float* O; int ldc; float scale;
    __device__ __forceinline__ void operator()(const Acc& acc, const Unit& u, int wr, int wc, int fr, int fq) const {
        const int row0 = u.pm * BM + wr * 64 + fr, col0 = u.pn * BM + wc * 32 + 4 * fq;
#pragma unroll
        for (int ai = 0; ai < 2; ++ai)
#pragma unroll
            for (int m = 0; m < 4; ++m) { float* rowp = O + (size_t)(row0 + ai * HALF + m * 16) * ldc + col0;
#pragma unroll
                for (int bj = 0; bj < 2; ++bj)
#pragma unroll
                    for (int n = 0; n < 2; ++n) *(f32x4*)(rowp + bj * HALF + n * 16) = acc[ai][bj][m][n] * scale; }
    }
};
struct EpiResidual {
    static constexpr bool PERM = false;
    const float* res; float* out; int ldc; float scale;
    __device__ __forceinline__ void operator()(const Acc& acc, const Unit& u, int wr, int wc, int fr, int fq) const {
        const int row0 = u.pm * BM + wr * 64 + fr, col0 = u.pn * BM + wc * 32 + 4 * fq;
        f32x4 ra[2][2][2], rb[2][2][2];
#define ER_LOAD(R, ai, mp) do { _Pragma("unroll") for (int m2 = 0; m2 < 2; ++m2) { const size_t off = (size_t)(row0 + (ai) * HALF + ((mp) * 2 + m2) * 16) * ldc + col0; \
            _Pragma("unroll") for (int bj = 0; bj < 2; ++bj) _Pragma("unroll") for (int n = 0; n < 2; ++n) R[m2][bj][n] = *(const f32x4*)(res + off + bj * HALF + n * 16); } } while (0)
#define ER_STORE(R, ai, mp) do { _Pragma("unroll") for (int m2 = 0; m2 < 2; ++m2) { const size_t off = (size_t)(row0 + (ai) * HALF + ((mp) * 2 + m2) * 16) * ldc + col0; \
            _Pragma("unroll") for (int bj = 0; bj < 2; ++bj) _Pragma("unroll") for (int n = 0; n < 2; ++n) *(f32x4*)(out + off + bj * HALF + n * 16) = R[m2][bj][n] + acc[ai][bj][(mp) * 2 + m2][n] * scale; } } while (0)
        ER_LOAD(ra, 0, 0);
        ER_LOAD(rb, 0, 1); ER_STORE(ra, 0, 0);
        ER_LOAD(ra, 1, 0); ER_STORE(rb, 0, 1);
        ER_LOAD(rb, 1, 1); ER_STORE(ra, 1, 0);
        ER_STORE(rb, 1, 1);
#undef ER_LOAD
#undef ER_STORE
    }
};
template <int FP8OUT>
struct EpiSwiglu {
    static constexpr bool PERM = true;
    void* H; int ldc; float in_scale, out_scale;
    __device__ __forceinline__ void operator()(const Acc& acc, const Unit& u, int wr, int wc, int fr, int fq) const {
        const int row0 = u.pm * BM + wr * 64 + fr, col0 = u.pn * HALF + wc * 32 + 8 * fq;
        const float k_ = in_scale * in_scale * out_scale, c1 = -in_scale * 1.4426950408889634f, c0 = -__builtin_log2f(k_), c3 = 1.0f / k_;
#pragma unroll
        for (int ai = 0; ai < 2; ++ai)
#pragma unroll
            for (int m = 0; m < 4; ++m) { const size_t off = (size_t)(row0 + ai * HALF + m * 16) * ldc + col0;
                float h[8];
#pragma unroll
                for (int n = 0; n < 2; ++n)
#pragma unroll
                    for (int e = 0; e < 4; ++e) { const float a0 = acc[ai][0][m][n][e], a1 = acc[ai][1][m][n][e];
                        h[n * 4 + e] = (a0 * a1) * __builtin_amdgcn_rcpf(c3 + __builtin_amdgcn_exp2f(fmaf(a0, c1, c0))); }
                if constexpr (FP8OUT == 2) { u32x2 w; w.x = pk4_i8(h[0], h[1], h[2], h[3]); w.y = pk4_i8(h[4], h[5], h[6], h[7]); *(u32x2*)((unsigned char*)H + off) = w; }
                else if constexpr (FP8OUT == 1) { u32x2 w; w.x = pk4_fp8(h[0], h[1], h[2], h[3]); w.y = pk4_fp8(h[4], h[5], h[6], h[7]); *(u32x2*)((unsigned char*)H + off) = w; }
                else { u32x4 w; w.x = cvtpk(h[0], h[1]); w.y = cvtpk(h[2], h[3]); w.z = cvtpk(h[4], h[5]); w.w = cvtpk(h[6], h[7]); *(u32x4*)((bf16_t*)H + off) = w; } }
    }
};
struct EpiGate {
    static constexpr bool PERM = true;
    const bf16_t* XC; const float* b_a; const float* b_x; const float* csp; unsigned* AB;
    __device__ __forceinline__ void operator()(const Acc& acc, const Unit& u, int wr, int wc, int fr, int fq) const {
        const int row0 = u.pm * BM + wr * 64 + fr, c0 = u.pn * HALF + wc * 32 + 8 * fq;
#pragma unroll
        for (int n = 0; n < 2; ++n) {
            const f32x4 ba = *(const f32x4*)(b_a + c0 + 4 * n) * -1.4426950408889634f, bx = *(const f32x4*)(b_x + c0 + 4 * n) * -1.4426950408889634f, sp = *(const f32x4*)(csp + c0 + 4 * n);
            u32x2 xws[2][4];
#pragma unroll
            for (int ai = 0; ai < 2; ++ai)
#pragma unroll
                for (int m = 0; m < 4; ++m) xws[ai][m] = *(const u32x2*)(XC + (size_t)(row0 + ai * HALF + m * 16) * D + c0 + 4 * n);
#pragma unroll
            for (int ai = 0; ai < 2; ++ai)
#pragma unroll
                for (int m = 0; m < 4; ++m) { const size_t off = (size_t)(row0 + ai * HALF + m * 16) * D + c0 + 4 * n;
                    const u32x2 xw = xws[ai][m];
                    const float xc[4] = {bflo(xw.x), bfhi(xw.x), bflo(xw.y), bfhi(xw.y)};
                    u32x4 pk;
#pragma unroll
                    for (int e = 0; e < 4; ++e) {
                        const float r = __builtin_amdgcn_rcpf(1.0f + __builtin_amdgcn_exp2f(fmaf(acc[ai][0][m][n][e], -1.4426950408889634f, ba[e]))), ig = __builtin_amdgcn_rcpf(1.0f + __builtin_amdgcn_exp2f(fmaf(acc[ai][1][m][n][e], -1.4426950408889634f, bx[e])));
                        const float la2 = -sp[e] * r;
                        const float om = fmaxf(1.0f - __builtin_amdgcn_exp2f(la2 + la2), 0.0f);
                        pk[e] = cvtpk(la2, __builtin_amdgcn_sqrtf(om) * ig * xc[e]); }
                    *(u32x4*)(AB + off) = pk; }
        }
    }
};

template <class Epi, class Sched>
__device__ __forceinline__ void gemm_phase(LAS unsigned char* lds, const Gemm g, const Sched& S, const Epi& E) {
    const int tid = opaque_tid(), wid = __builtin_amdgcn_readfirstlane(tid >> 6), lane = tid & 63, wr = wid >> 2, wc = wid & 3, fr = lane & 15, fq = lane >> 4;
    const int K = g.K, nt = K / BK;
    unsigned voffA[2], voffB[2];
#pragma unroll
    for (int i = 0; i < 2; ++i) { int R, C; stage_rc(tid * 16 + i * 8192, R, C); const int Rb = Epi::PERM ? ((R & ~31) + perm32(R & 31)) : R;
        voffA[i] = (unsigned)(R * g.lda + C) * 2u; voffB[i] = (unsigned)(Rb * g.ldb + C) * 2u; }
    const size_t kstep = (size_t)(BK * 2);
    const size_t hstepA = (size_t)HALF * g.lda * 2, hstepB = (size_t)HALF * g.ldb * 2;
    const unsigned ldsw = (unsigned)wid * 1024u;
    const int aoff = lds_byte(wr * 64 + fr, fq * 8), boff = lds_byte(wc * 32 + fr, fq * 8);
#define PG8_SA(b, h) (((b) * 2 + (h)) * HTB)
#define PG8_SB(b, h) ((4 + (b) * 2 + (h)) * HTB)
#define PG8_STAGE(bufoff, gbase, voff) do { _Pragma("unroll") for (int _i = 0; _i < 2; ++_i) \
        __builtin_amdgcn_global_load_lds((const unsigned*)((const char*)(gbase) + (voff)[_i]), (LAS unsigned*)(lds + (bufoff) + ldsw + _i * 8192), 16, 0, 0); } while (0)
#define PG8_LDA(dst, b, h) do { _Pragma("unroll") for (int m = 0; m < 4; ++m) _Pragma("unroll") for (int k = 0; k < 2; ++k) dst[m][k] = *(const LAS bf16x8*)(lds + PG8_SA(b, h) + aoff + m * 2048 + k * 1024); } while (0)
#define PG8_LDB(dst, b, h) do { _Pragma("unroll") for (int n = 0; n < 2; ++n) _Pragma("unroll") for (int k = 0; k < 2; ++k) dst[n][k] = *(const LAS bf16x8*)(lds + PG8_SB(b, h) + boff + n * 2048 + k * 1024); } while (0)
#define PG8_MMA(ai, bj, At, Bt) do { __builtin_amdgcn_s_setprio(1); _Pragma("unroll") for (int m = 0; m < 4; ++m) _Pragma("unroll") for (int n = 0; n < 2; ++n) _Pragma("unroll") for (int k = 0; k < 2; ++k) \
        acc[ai][bj][m][n] = __builtin_amdgcn_mfma_f32_16x16x32_bf16(Bt[n][k], At[m][k], acc[ai][bj][m][n], 0, 0, 0); __builtin_amdgcn_s_setprio(0); } while (0)
#define PG8_WAIT_V(n) asm volatile("s_waitcnt vmcnt(" #n ")" ::: "memory")
#define PG8_WAIT_L(n) asm volatile("s_waitcnt lgkmcnt(" #n ")" ::: "memory")
#define PG8_BAR __builtin_amdgcn_s_barrier()
#define PG8_SCHED __builtin_amdgcn_sched_barrier(0)
    Unit cur, nxt; int ui = 0;
    if (!S.next(0, cur)) return;
    Acc acc;
#pragma unroll
    for (int a = 0; a < 2; ++a)
#pragma unroll
        for (int b = 0; b < 2; ++b)
#pragma unroll
            for (int m = 0; m < 4; ++m)
#pragma unroll
                for (int n = 0; n < 2; ++n) acc[a][b][m][n] = (f32x4){0.f, 0.f, 0.f, 0.f};
    bf16x8 At[4][2], B0[2][2], B1[2][2];
    const char* cA = (const char*)g.A + cur.aoff; const char* cB = (const char*)g.Bt + cur.boff;
    S.a_ready(cur);
    PG8_STAGE(PG8_SB(0, 0), cB, voffB); PG8_STAGE(PG8_SB(0, 1), cB + hstepB, voffB); PG8_STAGE(PG8_SA(0, 0), cA, voffA); PG8_STAGE(PG8_SA(0, 1), cA + hstepA, voffA);
    if (wr == 1) PG8_BAR;
    PG8_WAIT_V(2); PG8_BAR;
    PG8_STAGE(PG8_SB(1, 0), cB + kstep, voffB); PG8_STAGE(PG8_SA(1, 0), cA + kstep, voffA); PG8_STAGE(PG8_SB(1, 1), cB + hstepB + kstep, voffB);
    PG8_WAIT_V(6); PG8_BAR;
    for (;;) {
        const bool has_next = S.next(ui + 1, nxt);
        const char* nA = has_next ? (const char*)g.A + nxt.aoff : cA; const char* nB = has_next ? (const char*)g.Bt + nxt.boff : cB;
#pragma nounroll
        for (int t = 0; t < nt; t += 2) {
            const bool last = (t == nt - 2);
            const char* a1 = cA + (size_t)(t + 1) * kstep;
            const char* a2 = last ? nA : cA + (size_t)(t + 2) * kstep; const char* b2 = last ? nB : cB + (size_t)(t + 2) * kstep;
            const char* a3 = a2 + kstep; const char* b3 = b2 + kstep;
            if (last && has_next) S.a_ready(nxt);
            PG8_LDB(B0, 0, 0); PG8_LDB(B1, 0, 1); PG8_SCHED; PG8_LDA(At, 0, 0); PG8_STAGE(PG8_SA(1, 1), a1 + hstepA, voffA);
            PG8_WAIT_V(8); PG8_WAIT_L(0); PG8_BAR; PG8_MMA(0, 0, At, B0); PG8_MMA(0, 1, At, B1); PG8_BAR; PG8_SCHED;
            PG8_LDA(At, 0, 1); PG8_STAGE(PG8_SB(0, 0), b2, voffB); PG8_STAGE(PG8_SB(0, 1), b2 + hstepB, voffB); PG8_STAGE(PG8_SA(0, 0), a2, voffA);
            PG8_WAIT_V(8); PG8_WAIT_L(0); PG8_BAR; PG8_MMA(1, 0, At, B0); PG8_MMA(1, 1, At, B1); PG8_BAR; PG8_SCHED;
            PG8_LDB(B0, 1, 0); PG8_LDB(B1, 1, 1); PG8_SCHED; PG8_LDA(At, 1, 0); PG8_STAGE(PG8_SA(0, 1), a2 + hstepA, voffA);
            PG8_WAIT_V(8); PG8_WAIT_L(0); PG8_BAR; PG8_MMA(0, 0, At, B0); PG8_MMA(0, 1, At, B1); PG8_BAR; PG8_SCHED;
            PG8_LDA(At, 1, 1); PG8_STAGE(PG8_SB(1, 0), b3, voffB); PG8_STAGE(PG8_SB(1, 1), b3 + hstepB, voffB); PG8_STAGE(PG8_SA(1, 0), a3, voffA);
            PG8_WAIT_V(8); PG8_WAIT_L(0); PG8_BAR; PG8_MMA(1, 0, At, B0); PG8_MMA(1, 1, At, B1); PG8_BAR; PG8_SCHED;
        }
        if (wr == 0) PG8_BAR;
        E(acc, cur, wr, wc, fr, fq); S.done(cur);
        if (!has_next) break;
#pragma unroll
        for (int a = 0; a < 2; ++a)
#pragma unroll
            for (int b = 0; b < 2; ++b)
#pragma unroll
                for (int m = 0; m < 4; ++m)
#pragma unroll
                    for (int n = 0; n < 2; ++n) acc[a][b][m][n] = (f32x4){0.f, 0.f, 0.f, 0.f};
        cur = nxt; cA = nA; cB = nB; ++ui;
        if (wr == 1) PG8_BAR;
    }
    PG8_WAIT_V(0);
    PG8_BAR;
#undef PG8_SA
#undef PG8_SB
#undef PG8_STAGE
#undef PG8_LDA
#undef PG8_LDB
#undef PG8_MMA
#undef PG8_WAIT_V
#undef PG8_WAIT_L
#undef PG8_BAR
#undef PG8_SCHED
}

__host__ __device__ __forceinline__ int g8(int rr) { const int q = rr >> 1; return ((2 * q) & 7) | (q >> 2); }
__host__ __device__ __forceinline__ void stage_rc8(int b, int& R, int& Cb) { const int s = b >> 11, rr = (b >> 7) & 15, p = (b >> 4) & 7; R = s * 16 + rr; Cb = (p ^ g8(rr)) << 4; }
__host__ __device__ __forceinline__ int lds_byte8(int r, int c) { const int rr = r & 15; return (r >> 4) * 2048 + rr * 128 + ((c ^ g8(rr)) << 4); }
template <bool FP6> struct Frag8 { typedef v8i T; };
template <> struct Frag8<true> { typedef v6i T; };
template <class Epi, class Sched, int MODE = 0>
__device__ __forceinline__ void gemm_phase8(LAS unsigned char* lds, const Gemm g, const Sched& S, const Epi& E) {
    constexpr bool FP6 = (MODE == 1);
    const int tid = opaque_tid(), wid = __builtin_amdgcn_readfirstlane(tid >> 6), lane = tid & 63, wr = wid >> 2, wc = wid & 3, fr = lane & 15, fq = lane >> 4;
    const int K = g.K, nt = K / 128;
    unsigned voffA[2], voffB[2];
#pragma unroll
    for (int i = 0; i < 2; ++i) { int R, C; stage_rc8(tid * 16 + i * 8192, R, C); const int Rb = Epi::PERM ? ((R & ~31) + perm32(R & 31)) : R;
        voffA[i] = (unsigned)(R * g.lda + C); voffB[i] = (unsigned)(Rb * g.ldb + C); }
    const size_t kstep = 128;
    const size_t hstepA = (size_t)HALF * g.lda, hstepB = (size_t)HALF * g.ldb;
    const unsigned ldsw = (unsigned)wid * 1024u;
    const int aoff0 = lds_byte8(wr * 64 + fr, 2 * fq), aoff1 = lds_byte8(wr * 64 + fr, 2 * fq + 1), boff0 = lds_byte8(wc * 32 + fr, 2 * fq), boff1 = lds_byte8(wc * 32 + fr, 2 * fq + 1);
#define PG8_SA(b, h) (((b) * 2 + (h)) * HTB)
#define PG8_SB(b, h) ((4 + (b) * 2 + (h)) * HTB)
#define PG8_STAGE(bufoff, gbase, voff) do { _Pragma("unroll") for (int _i = 0; _i < 2; ++_i) \
        __builtin_amdgcn_global_load_lds((const unsigned*)((const char*)(gbase) + (voff)[_i]), (LAS unsigned*)(lds + (bufoff) + ldsw + _i * 8192), 16, 0, 0); } while (0)
#define PG8_LD1(dst, off0, off1) do { const v4i lo_ = *(const LAS v4i*)(lds + (off0)); \
        if constexpr (FP6) { const v2i hi_ = *(const LAS v2i*)(lds + (off1)); dst = (v6i){lo_[0], lo_[1], lo_[2], lo_[3], hi_[0], hi_[1]}; } \
        else { const v4i hi_ = *(const LAS v4i*)(lds + (off1)); dst = __builtin_shufflevector(lo_, hi_, 0, 1, 2, 3, 4, 5, 6, 7); } } while (0)
#define PG8_LDA(dst, b, h) do { _Pragma("unroll") for (int m = 0; m < 4; ++m) PG8_LD1(dst[m], PG8_SA(b, h) + aoff0 + m * 2048, PG8_SA(b, h) + aoff1 + m * 2048); } while (0)
#define PG8_LDB(dst, b, h) do { _Pragma("unroll") for (int n = 0; n < 2; ++n) PG8_LD1(dst[n], PG8_SB(b, h) + boff0 + n * 2048, PG8_SB(b, h) + boff1 + n * 2048); } while (0)
#define PG8_MMA(ai, bj, At, Bt) do { __builtin_amdgcn_s_setprio(1); \
        if constexpr (MODE == 2) { \
            _Pragma("unroll") for (int m = 0; m < 4; ++m) _Pragma("unroll") for (int n = 0; n < 2; ++n) { const v4i bl_ = __builtin_shufflevector(Bt[n], Bt[n], 0, 1, 2, 3), al_ = __builtin_shufflevector(At[m], At[m], 0, 1, 2, 3); \
                asm volatile("v_mfma_i32_16x16x64_i8 %0, %1, %2, %0" : "+v"(acc[ai][bj][m][n]) : "v"(bl_), "v"(al_)); } \
            _Pragma("unroll") for (int m = 0; m < 4; ++m) _Pragma("unroll") for (int n = 0; n < 2; ++n) { const v4i bh_ = __builtin_shufflevector(Bt[n], Bt[n], 4, 5, 6, 7), ah_ = __builtin_shufflevector(At[m], At[m], 4, 5, 6, 7); \
                asm volatile("v_mfma_i32_16x16x64_i8 %0, %1, %2, %0" : "+v"(acc[ai][bj][m][n]) : "v"(bh_), "v"(ah_)); } \
        } else { _Pragma("unroll") for (int m = 0; m < 4; ++m) _Pragma("unroll") for (int n = 0; n < 2; ++n) \
        { if constexpr (MODE == 1) asm volatile("v_mfma_f32_16x16x128_f8f6f4 %0, %1, %2, %0 cbsz:2 blgp:2" : "+v"(acc[ai][bj][m][n]) : "v"(Bt[n]), "v"(At[m])); \
          else asm volatile("v_mfma_f32_16x16x128_f8f6f4 %0, %1, %2, %0" : "+v"(acc[ai][bj][m][n]) : "v"(Bt[n]), "v"(At[m])); } } __builtin_amdgcn_s_setprio(0); } while (0)
#define PG8_WAIT_V(n) asm volatile("s_waitcnt vmcnt(" #n ")" ::: "memory")
#define PG8_WAIT_L(n) asm volatile("s_waitcnt lgkmcnt(" #n ")" ::: "memory")
#define PG8_BAR __builtin_amdgcn_s_barrier()
#define PG8_SCHED __builtin_amdgcn_sched_barrier(0)
    Unit cur, nxt; int ui = 0;
    if (!S.next(0, cur)) return;
    Acc acc;
#pragma unroll
    for (int a = 0; a < 2; ++a)
#pragma unroll
        for (int b = 0; b < 2; ++b)
#pragma unroll
            for (int m = 0; m < 4; ++m)
#pragma unroll
                for (int n = 0; n < 2; ++n) acc[a][b][m][n] = (f32x4){0.f, 0.f, 0.f, 0.f};
    typename Frag8<FP6>::T At[4], B0[2], B1[2];
    const char* cA = (const char*)g.A + cur.aoff; const char* cB = (const char*)g.Bt + cur.boff;
    S.a_ready(cur);
    PG8_STAGE(PG8_SB(0, 0), cB, voffB); PG8_STAGE(PG8_SB(0, 1), cB + hstepB, voffB); PG8_STAGE(PG8_SA(0, 0), cA, voffA); PG8_STAGE(PG8_SA(0, 1), cA + hstepA, voffA);
    if (wr == 1) PG8_BAR;
    PG8_WAIT_V(2); PG8_BAR;
    PG8_STAGE(PG8_SB(1, 0), cB + kstep, voffB); PG8_STAGE(PG8_SA(1, 0), cA + kstep, voffA); PG8_STAGE(PG8_SB(1, 1), cB + hstepB + kstep, voffB);
    PG8_WAIT_V(6); PG8_BAR;
    for (;;) {
        const bool has_next = S.next(ui + 1, nxt);
        const char* nA = has_next ? (const char*)g.A + nxt.aoff : cA; const char* nB = has_next ? (const char*)g.Bt + nxt.boff : cB;
#pragma nounroll
        for (int t = 0; t < nt; t += 2) {
            const bool last = (t == nt - 2);
            const char* a1 = cA + (size_t)(t + 1) * kstep;
            const char* a2 = last ? nA : cA + (size_t)(t + 2) * kstep; const char* b2 = last ? nB : cB + (size_t)(t + 2) * kstep;
            const char* a3 = a2 + kstep; const char* b3 = b2 + kstep;
            if (last && has_next) S.a_ready(nxt);
            PG8_LDB(B0, 0, 0); PG8_LDB(B1, 0, 1); PG8_SCHED; PG8_LDA(At, 0, 0); PG8_STAGE(PG8_SA(1, 1), a1 + hstepA, voffA);
            PG8_WAIT_V(8); PG8_WAIT_L(0); PG8_BAR; PG8_MMA(0, 0, At, B0); PG8_MMA(0, 1, At, B1); PG8_BAR; PG8_SCHED;
            PG8_LDA(At, 0, 1); PG8_STAGE(PG8_SB(0, 0), b2, voffB); PG8_STAGE(PG8_SB(0, 1), b2 + hstepB, voffB); PG8_STAGE(PG8_SA(0, 0), a2, voffA);
            PG8_WAIT_V(8); PG8_WAIT_L(0); PG8_BAR; PG8_MMA(1, 0, At, B0); PG8_MMA(1, 1, At, B1); PG8_BAR; PG8_SCHED;
            PG8_LDB(B0, 1, 0); PG8_LDB(B1, 1, 1); PG8_SCHED; PG8_LDA(At, 1, 0); PG8_STAGE(PG8_SA(0, 1), a2 + hstepA, voffA);
            PG8_WAIT_V(8); PG8_WAIT_L(0); PG8_BAR; PG8_MMA(0, 0, At, B0); PG8_MMA(0, 1, At, B1); PG8_BAR; PG8_SCHED;
            PG8_LDA(At, 1, 1); PG8_STAGE(PG8_SB(1, 0), b3, voffB); PG8_STAGE(PG8_SB(1, 1), b3 + hstepB, voffB); PG8_STAGE(PG8_SA(1, 0), a3, voffA);
            PG8_WAIT_V(8); PG8_WAIT_L(0); PG8_BAR; PG8_MMA(1, 0, At, B0); PG8_MMA(1, 1, At, B1); PG8_BAR; PG8_SCHED;
        }
        asm volatile("s_nop 15\n\ts_nop 15" ::: "memory");
        if (wr == 0) PG8_BAR;
        if constexpr (MODE == 2) {
#pragma unroll
            for (int a = 0; a < 2; ++a)
#pragma unroll
                for (int b = 0; b < 2; ++b)
#pragma unroll
                    for (int m = 0; m < 4; ++m)
#pragma unroll
                        for (int n = 0; n < 2; ++n)
                        { const f32x4 t_ = acc[a][b][m][n]; f32x4 r_;
                          r_.x = (float)__float_as_int(t_.x); r_.y = (float)__float_as_int(t_.y); r_.z = (float)__float_as_int(t_.z); r_.w = (float)__float_as_int(t_.w); acc[a][b][m][n] = r_; }
        }
        E(acc, cur, wr, wc, fr, fq); S.done(cur);
        if (!has_next) break;
#pragma unroll
        for (int a = 0; a < 2; ++a)
#pragma unroll
            for (int b = 0; b < 2; ++b)
#pragma unroll
                for (int m = 0; m < 4; ++m)
#pragma unroll
                    for (int n = 0; n < 2; ++n) acc[a][b][m][n] = (f32x4){0.f, 0.f, 0.f, 0.f};
        cur = nxt; cA = nA; cB = nB; ++ui;
        if (wr == 1) PG8_BAR;
    }
    PG8_WAIT_V(0);
    PG8_BAR;
#undef PG8_SA
#undef PG8_SB
#undef PG8_STAGE
#undef PG8_LDA
#undef PG8_LD1
#undef PG8_LDB
#undef PG8_MMA
#undef PG8_WAIT_V
#undef PG8_WAIT_L
#undef PG8_BAR
#undef PG8_SCHED
}
}

namespace att {
constexpr int KROW = 208, KBUF = 64 * KROW,     VROW = 80, VBUF = 128 * VROW,     VOFF = 2 * KBUF, LDS_TOTAL = VOFF + 3 * VBUF;
static_assert(LDS_TOTAL <= RING_BYTES, "attention LDS");
constexpr float THR = 4.5f, PSH = 4.f, QS8 = 16.f, OSC8 = 16.f;
__device__ __forceinline__ int crow(int r, int hi) { return (r & 3) + 8 * (r >> 2) + 4 * hi; }

constexpr int CV_KB = FF / 128, CV_NB = D / 16, CV_ITEMS = NE * CV_NB * CV_KB, CV_IPW = CV_ITEMS / (GRID * NWAVES);
static_assert(CV_ITEMS % (GRID * NWAVES) == 0 && CV_KB % CV_IPW == 0, "MoE-down conversion items per wave");
constexpr float CV_WS = 64.f;
struct CvtState { const float* W; unsigned char* WT; int next, end; };
__device__ __forceinline__ void cvt_load(const CvtState& cs, int lane, f32x4 (&v)[8]) {
    const int kb = cs.next % CV_KB, tmp = cs.next / CV_KB, nb = tmp % CV_NB, e = tmp / CV_NB;
    const float* src = cs.W + ((size_t)e * FF + (size_t)(128 * kb + 8 * (lane >> 2))) * D + 16 * nb + 4 * (lane & 3);
#pragma unroll
    for (int i = 0; i < 8; ++i) v[i] = __builtin_nontemporal_load((const f32x4*)(src + (size_t)i * D));
}
__device__ __forceinline__ void cvt_store(CvtState& cs, int lane, const f32x4 (&v)[8]) {
    const int kb = cs.next % CV_KB, tmp = cs.next / CV_KB, nb = tmp % CV_NB, e = tmp / CV_NB;
    unsigned char* dst = cs.WT + ((size_t)e * D + (size_t)(16 * nb + 4 * (lane & 3))) * FF + 128 * kb + 8 * (lane >> 2);
#pragma unroll
    for (int j = 0; j < 4; ++j) { u32x2 w; w.x = pk4_fp8(v[0][j] * CV_WS, v[1][j] * CV_WS, v[2][j] * CV_WS, v[3][j] * CV_WS); w.y = pk4_fp8(v[4][j] * CV_WS, v[5][j] * CV_WS, v[6][j] * CV_WS, v[7][j] * CV_WS);
        __builtin_nontemporal_store(w, (u32x2*)(dst + (size_t)j * FF)); }
    ++cs.next;
}

__device__ __forceinline__ void attn_unit(LAS unsigned char* lds, const unsigned char* Q, const unsigned char* KV, const bf16_t* KPE, const float* CST, bf16_t* O, int b, int h, int qb, CvtState& cs) {
    const int tid = opaque_tid(), wid = __builtin_amdgcn_readfirstlane(tid >> 6), lane = tid & 63, r32 = lane & 31, hi = lane >> 5;
    const bool lag = wid >= 4;
    if (lag) __builtin_amdgcn_s_setprio(1);
    const size_t rowb = (size_t)b * SEQ;
    const int qlo = qb * 256 + wid * 32;
    v8i qf[3];
    const unsigned qo = (unsigned)((rowb + qlo + r32) * (NH * QKD) + h * QKD + hi * 32);
    { const v4i a0 = *(const v4i*)((const char*)Q + qo), a1 = *(const v4i*)((const char*)Q + qo + 16), b0 = *(const v4i*)((const char*)Q + qo + 64), b1 = *(const v4i*)((const char*)Q + qo + 80);
      qf[0] = __builtin_shufflevector(a0, a1, 0, 1, 2, 3, 4, 5, 6, 7); qf[1] = __builtin_shufflevector(b0, b1, 0, 1, 2, 3, 4, 5, 6, 7); }
    { const float* cst = CST + (size_t)(rowb + qlo + r32) * 64;
      const v4i t0 = *(const v4i*)((const char*)Q + qo + 128), t1 = *(const v4i*)((const char*)Q + qo + 144);
#pragma unroll
      for (int d = 0; d < 8; ++d) {
          const int own = (d < 4) ? t0[d & 3] : t1[d & 3];
          const auto rr = __builtin_amdgcn_permlane32_swap((unsigned)own, (unsigned)own, false, false); const int par = (int)(rr[0] ^ rr[1]) ^ own;
          const f32x4 c = *(const f32x4*)(cst + 4 * d); f32x4 sn = *(const f32x4*)(cst + 32 + 4 * d);
          if (hi == 0) sn = -sn;
          const float o0 = __builtin_amdgcn_cvt_f32_fp8(own, 0) * c[0] + __builtin_amdgcn_cvt_f32_fp8(par, 0) * sn[0], o1 = __builtin_amdgcn_cvt_f32_fp8(own, 1) * c[1] + __builtin_amdgcn_cvt_f32_fp8(par, 1) * sn[1];
          const float o2 = __builtin_amdgcn_cvt_f32_fp8(own, 2) * c[2] + __builtin_amdgcn_cvt_f32_fp8(par, 2) * sn[2], o3 = __builtin_amdgcn_cvt_f32_fp8(own, 3) * c[3] + __builtin_amdgcn_cvt_f32_fp8(par, 3) * sn[3];
          qf[2][d] = (int)pk4_fp8(o0, o1, o2, o3); } }
    const int NT = 4 * (qb + 1);
    const int sr = tid >> 4, sc = (tid & 15) * 8, pr = tid >> 3, pc = (tid & 7) * 8;
    const unsigned kvo = (unsigned)((rowb + sr) * 4096 + h * 256 + sc);
    const unsigned kpo = (unsigned)(((rowb + pr) * 64 + pc) * 2);
    const int kw0 = sr * KROW + sc, kw1 = (sr + 32) * KROW + sc, kwp = pr * KROW + 128 + pc;
    const int vkg = (wid & 3) * 4 + (lane >> 4), vdg = (wid >> 2) * 16 + (lane & 15);
    const unsigned kvv = (unsigned)((rowb + 4 * vkg) * 4096 + h * 256 + 128 + 4 * vdg);
    const int vw = VOFF + 4 * vdg * VROW + (vkg & 1) * 32 + (((vkg >> 3) * 4 + ((vkg & 7) >> 1)) * 4);
    u32x2 sk0, sk1; bf16x8 skp; unsigned sv0, sv1, sv2, sv3;
#define ATT_LOAD(t) do { const unsigned k1_ = kvo + (unsigned)(t) * (64u * 4096u), k2_ = kpo + (unsigned)(t) * (64u * 128u); const char* kvb_ = (const char*)KV; \
        const unsigned k3_ = kvv + (unsigned)(t) * (64u * 4096u); \
        sk0 = *(const u32x2*)(kvb_ + k1_); sk1 = *(const u32x2*)(kvb_ + k1_ + 32u * 4096u); skp = *(const bf16x8*)((const char*)KPE + k2_); \
        sv0 = *(const unsigned*)(kvb_ + k3_); sv1 = *(const unsigned*)(kvb_ + k3_ + 4096u); sv2 = *(const unsigned*)(kvb_ + k3_ + 2u * 4096u); sv3 = *(const unsigned*)(kvb_ + k3_ + 3u * 4096u); } while (0)
#define B8_(x_, y_) ({ const unsigned bx_ = (x_), by_ = (y_); __builtin_bit_cast(unsigned, __builtin_amdgcn_cvt_scalef32_pk_fp8_bf16(__builtin_amdgcn_cvt_scalef32_pk_fp8_bf16((v2s){0, 0}, __builtin_bit_cast(v2bf, bx_), 1.0f, false), __builtin_bit_cast(v2bf, by_), 1.0f, true)); })
#define K8_(S) ({ const u32x4 t_ = __builtin_bit_cast(u32x4, S); u32x2 w_; w_.x = B8_(t_.x, t_.y); w_.y = B8_(t_.z, t_.w); w_; })
#define VL_(a_, b_) __builtin_amdgcn_perm(b_, a_, 0x05040100u)
#define VH_(a_, b_) __builtin_amdgcn_perm(b_, a_, 0x07060302u)
#define V8_(a_, b_, c_, d_) ((unsigned)__builtin_amdgcn_cvt_pk_fp8_f32(c_, d_, __builtin_amdgcn_cvt_pk_fp8_f32(a_, b_, 0, false), true))
#define ATT_WRITE(kb, vb) do { LAS unsigned char* kb_ = lds + (kb) * KBUF; LAS unsigned char* vb_ = lds + (vb) * VBUF; *(LAS u32x2*)(kb_ + kw0) = sk0; *(LAS u32x2*)(kb_ + kw1) = sk1; *(LAS u32x2*)(kb_ + kwp) = K8_(skp); \
        const unsigned a_ = __builtin_amdgcn_perm(sv1, sv0, 0x05010400u), b_ = __builtin_amdgcn_perm(sv3, sv2, 0x05010400u), c_ = __builtin_amdgcn_perm(sv1, sv0, 0x07030602u), d_ = __builtin_amdgcn_perm(sv3, sv2, 0x07030602u); \
        *(LAS unsigned*)(vb_ + vw) = VL_(a_, b_); *(LAS unsigned*)(vb_ + vw + VROW) = VH_(a_, b_); *(LAS unsigned*)(vb_ + vw + 2 * VROW) = VL_(c_, d_); *(LAS unsigned*)(vb_ + vw + 3 * VROW) = VH_(c_, d_); } while (0)
    ATT_LOAD(0); ATT_WRITE(0, 0);
    __syncthreads();
    float m_reg = -1e30f, l_reg = 0.f;
    f32x16 o[4];
#pragma unroll
    for (int d = 0; d < 4; ++d)
#pragma unroll
        for (int r = 0; r < 16; ++r) o[d][r] = 0.f;
    const unsigned vrd = (unsigned)(uintptr_t)lds + (unsigned)(VOFF + r32 * VROW + hi * 32);
#define DSR(dst, addr, off) asm volatile("ds_read_b128 %0, %1 offset:%2" : "=v"(dst) : "v"(addr), "i"(off))
#define DSW4(n, a, b, c, d) asm volatile("s_waitcnt lgkmcnt(" #n ")" : "+v"(a), "+v"(b), "+v"(c), "+v"(d))
#define CAT8(a, b) __builtin_shufflevector(a, b, 0, 1, 2, 3, 4, 5, 6, 7)
#define MMA8(A, B, C) __builtin_amdgcn_mfma_scale_f32_32x32x64_f8f6f4(A, B, C, 0, 0, 0, 0, 0, 0)
    v8i pf = {0, 0, 0, 0, 0, 0, 0, 0};
    bool pend = false; int vs = 0;
    v4i va0, va1, va2, va3, va4, va5, va6, va7;
#define PV_READ(slot) do { const unsigned vb0 = vrd + (unsigned)((slot) * VBUF); DSR(va0, vb0, 0); DSR(va1, vb0, 16); DSR(va2, vb0, 32 * VROW); DSR(va3, vb0, 32 * VROW + 16); \
        DSR(va4, vb0, 64 * VROW); DSR(va5, vb0, 64 * VROW + 16); DSR(va6, vb0, 96 * VROW); DSR(va7, vb0, 96 * VROW + 16); } while (0)
#define PV_MMA() do { DSW4(4, va0, va1, va2, va3); o[0] = MMA8(CAT8(va0, va1), pf, o[0]); o[1] = MMA8(CAT8(va2, va3), pf, o[1]); \
        DSW4(0, va4, va5, va6, va7); o[2] = MMA8(CAT8(va4, va5), pf, o[2]); o[3] = MMA8(CAT8(va6, va7), pf, o[3]); } while (0)
    f32x4 cv[8]; bool cvt_pend = false;
    for (int t = 0; t < NT; ++t) {
        if (t + 1 < NT) ATT_LOAD(t + 1);
        if (cvt_pend) { cvt_store(cs, lane, cv); cvt_pend = false; }
        if (lag && pend) { PV_MMA(); pend = false; }
        const int kb0 = t * 64;
        const bool cvt_now = ((t & 3) == 0) && cs.next < cs.end;
        if (cvt_now && !(kb0 <= qlo + 31)) cvt_load(cs, lane, cv);
        if (kb0 <= qlo + 31) {
            const unsigned ka = (unsigned)(uintptr_t)lds + (unsigned)((t & 1) * KBUF + r32 * KROW + hi * 32);
            f32x16 p0, p1;
#pragma unroll
            for (int r = 0; r < 16; ++r) { p0[r] = 0.f; p1[r] = 0.f; }
            { v4i k0, k1, k2, k3, k4, k5, k6, k7, k8, k9, k10, k11;
              DSR(k0, ka, 0); DSR(k1, ka, 16); DSR(k2, ka, 32 * KROW); DSR(k3, ka, 32 * KROW + 16);
              DSR(k4, ka, 64); DSR(k5, ka, 80); DSR(k6, ka, 32 * KROW + 64); DSR(k7, ka, 32 * KROW + 80);
              DSR(k8, ka, 128); DSR(k9, ka, 144); DSR(k10, ka, 32 * KROW + 128); DSR(k11, ka, 32 * KROW + 144);
              DSW4(8, k0, k1, k2, k3);
              p0 = MMA8(CAT8(k0, k1), qf[0], p0); p1 = MMA8(CAT8(k2, k3), qf[0], p1);
              PV_READ(vs);
              DSW4(12, k4, k5, k6, k7);
              p0 = MMA8(CAT8(k4, k5), qf[1], p0); p1 = MMA8(CAT8(k6, k7), qf[1], p1);
              DSW4(8, k8, k9, k10, k11);
              p0 = MMA8(CAT8(k8, k9), qf[2], p0); p1 = MMA8(CAT8(k10, k11), qf[2], p1); }
            if (cvt_now) cvt_load(cs, lane, cv);
            if (kb0 + 63 > qlo) {
                const int dq = qlo + r32 - 4 * hi - kb0; const float NEG = -__builtin_inff();
#pragma unroll
                for (int r = 0; r < 16; ++r) { const int c = (r & 3) + 8 * (r >> 2); if (dq - c < 0) p0[r] = NEG; if (dq - c - 32 < 0) p1[r] = NEG; }
            }
            float pmax = p0[0];
#pragma unroll
            for (int r = 1; r < 16; ++r) pmax = fmaxf(pmax, p0[r]);
#pragma unroll
            for (int r = 0; r < 16; ++r) pmax = fmaxf(pmax, p1[r]);
            { auto rr = __builtin_amdgcn_permlane32_swap(__float_as_uint(pmax), __float_as_uint(pmax), false, false); pmax = fmaxf(__uint_as_float(rr[0]), __uint_as_float(rr[1])); }
            float mn, alpha;
            constexpr float QI8 = 1.0f / QS8;
            if (__all((pmax - m_reg) <= THR * QS8)) { mn = m_reg; alpha = 1.f; }
            else { mn = fmaxf(m_reg, pmax); alpha = __builtin_amdgcn_exp2f((m_reg - mn) * QI8); m_reg = mn; }
            const float mnq = PSH - mn * QI8;
            float ps = 0.f;
#pragma unroll
            for (int r = 0; r < 16; ++r) { p0[r] = __builtin_amdgcn_exp2f(fmaf(p0[r], QI8, mnq)); ps += p0[r]; }
#pragma unroll
            for (int r = 0; r < 16; ++r) { p1[r] = __builtin_amdgcn_exp2f(fmaf(p1[r], QI8, mnq)); ps += p1[r]; }
            { auto rr = __builtin_amdgcn_permlane32_swap(__float_as_uint(ps), __float_as_uint(ps), false, false); ps = __uint_as_float(rr[0]) + __uint_as_float(rr[1]); }
            l_reg = l_reg * alpha + ps;
            if (__any(alpha < 1.f)) {
#pragma unroll
                for (int d = 0; d < 4; ++d)
#pragma unroll
                    for (int r = 0; r < 16; ++r) o[d][r] *= alpha;
            }
#pragma unroll
            for (int i = 0; i < 4; ++i) { pf[i] = (int)V8_(p0[4 * i], p0[4 * i + 1], p0[4 * i + 2], p0[4 * i + 3]); pf[4 + i] = (int)V8_(p1[4 * i], p1[4 * i + 1], p1[4 * i + 2], p1[4 * i + 3]); }
            if (!lag) PV_MMA(); else pend = true;
        }
        if (cvt_now) cvt_pend = true;
        const int vn = (vs == 2) ? 0 : vs + 1;
        if (t + 1 < NT) ATT_WRITE((t + 1) & 1, vn);
        asm volatile("s_waitcnt lgkmcnt(0)" ::: "memory");
        __syncthreads();
        vs = vn;
    }
    if (lag && pend) PV_MMA();
    if (cvt_pend) cvt_store(cs, lane, cv);
    __builtin_amdgcn_s_setprio(0);
    __syncthreads();
#undef PV_READ
#undef PV_MMA
#undef DSR
#undef DSW4
#undef CAT8
#undef MMA8
#undef ATT_LOAD
#undef ATT_WRITE
#undef K8_
#undef V8_
#undef B8_
#undef VL_
#undef VH_
    { const float rl = __builtin_amdgcn_rcpf(l_reg) * OSC8;
      const unsigned oo = (unsigned)((rowb + qlo + r32) * D + h * VDIM + 4 * hi);
#pragma unroll
      for (int d0 = 0; d0 < 4; ++d0)
#pragma unroll
          for (int j = 0; j < 4; ++j)
              *(unsigned*)((char*)O + oo + (unsigned)(d0 * 32 + j * 8)) = pk4_fp8(o[d0][4 * j] * rl, o[d0][4 * j + 1] * rl, o[d0][4 * j + 2] * rl, o[d0][4 * j + 3] * rl); }
}
}

#define XB_TMO      128
#define XB_XCNT(j)  (256  + 64 * (j))
#define XB_XSUB(j)  (1280 + 64 * (j))
#define XB_XGEN(j)  (2304 + 64 * (j))
#define XB_TOP      3328
#define XB_TOPGEN   3392
#define XCD_BAR_WORDS 3456
#define XB_SPIN_CAP (1u << 18)
__device__ __forceinline__ unsigned xb_ld(unsigned* p)              { return __hip_atomic_load(p, __ATOMIC_RELAXED, __HIP_MEMORY_SCOPE_AGENT); }
__device__ __forceinline__ unsigned xb_add(unsigned* p, unsigned v) { return __hip_atomic_fetch_add(p, v, __ATOMIC_RELAXED, __HIP_MEMORY_SCOPE_AGENT); }
__device__ __forceinline__ unsigned xb_xcc_id() { return (unsigned)__builtin_amdgcn_s_getreg((3 << 11) | 20) & 0xFu; }
#define XB_SPIN(cond, bar) do { unsigned _sp = 0; while (cond) { __builtin_amdgcn_s_sleep(1); \
    if ((++_sp & 255u) == 0u) { if (xb_ld(&(bar)[XB_TMO])) break; if (_sp > XB_SPIN_CAP) { atomicAdd(&(bar)[XB_TMO], 1u); break; } } } } while (0)
struct XcdBarrier { unsigned* bar; unsigned x; volatile LAS unsigned* st; };
__device__ __forceinline__ XcdBarrier xcd_barrier_post(unsigned* bar, volatile LAS unsigned* st) {
    XcdBarrier b; b.bar = bar; b.x = xb_xcc_id(); b.st = st;
    if (threadIdx.x == 0) (void)xb_add(&bar[XB_XCNT(b.x)], 1u);
    return b;
}
__device__ __forceinline__ void xcd_barrier_complete(unsigned* bar, unsigned x, unsigned& nloc, unsigned& nx) {
    const unsigned G = gridDim.x * gridDim.y * gridDim.z;
    unsigned sum, cnt, mine, sp = 0u;
    for (;;) {
        sum = 0u; cnt = 0u; mine = 0u;
#pragma unroll
        for (unsigned j = 0; j < 16; ++j) { const unsigned c = xb_ld(&bar[XB_XCNT(j)]); sum += c; cnt += (c > 0u) ? 1u : 0u; mine = (j == x) ? c : mine; }
        if (sum == G) break;
        __builtin_amdgcn_s_sleep(1);
        if ((++sp & 255u) == 0u) { if (xb_ld(&bar[XB_TMO])) break; if (sp > XB_SPIN_CAP) { atomicAdd(&bar[XB_TMO], 1u); break; } }
    }
    nloc = mine > 0u ? mine : 1u; nx = cnt > 0u ? cnt : 1u;
}
__device__ __forceinline__ void xcd_barrier(const XcdBarrier& b) {
    asm volatile("s_waitcnt vmcnt(0)" ::: "memory");
    __syncthreads();
    if (threadIdx.x == 0) {
        unsigned* bar = b.bar;
        __builtin_amdgcn_s_waitcnt(0);
        unsigned nloc = b.st[0], nx = b.st[1];
        if (nloc == 0u) { xcd_barrier_complete(bar, b.x, nloc, nx); b.st[0] = nloc; b.st[1] = nx; }
        const unsigned old = xb_add(&bar[XB_XSUB(b.x)], 1u);
        const unsigned gen = old / nloc;
        if (old + 1u == (gen + 1u) * nloc) {
            __builtin_amdgcn_fence(__ATOMIC_RELEASE, "agent");
            asm volatile("s_waitcnt vmcnt(0)" ::: "memory");
            const unsigned og = xb_add(&bar[XB_TOP], 1u);
            const unsigned tg = og / nx;
            if (og + 1u == (tg + 1u) * nx) xb_add(&bar[XB_TOPGEN], 1u);
            else XB_SPIN(xb_ld(&bar[XB_TOPGEN]) == tg, bar);
            __builtin_amdgcn_fence(__ATOMIC_ACQUIRE, "agent");
            xb_add(&bar[XB_XGEN(b.x)], 1u);
            asm volatile("s_waitcnt vmcnt(0)" ::: "memory");
        } else {
            XB_SPIN(xb_ld(&bar[XB_XGEN(b.x)]) == gen, bar);
            __builtin_amdgcn_fence(__ATOMIC_ACQUIRE, "agent");
            asm volatile("s_waitcnt vmcnt(0)" ::: "memory");
        }
    }
    __syncthreads();
}

struct Args { const float* in[29]; const int* positions; float* out; unsigned char* ws; };
enum { I_X = 0, I_POS = 1, I_ANM = 2, I_RGWIN = 3, I_CONVW = 4, I_CONVB = 5, I_RGWA = 6, I_RGBA = 7, I_RGWX = 8, I_RGBX = 9, I_LAM = 10, I_RGWOUT = 11, I_ANF = 12, I_FFG = 13, I_FFU = 14, I_FFD = 15,
       I_BNM = 16, I_MLAWIN = 17, I_QNORM = 18, I_WQUP = 19, I_KVNORM = 20, I_WKVUP = 21, I_MLAWO = 22, I_BNF = 23, I_ROUTER = 24, I_MOEG = 25, I_MOEU = 26, I_MOED = 27, I_FNORM = 28 };

constexpr float WSC8 = 64.f, ASC8 = 8.f, HSC8 = 4.f; static_assert(WSC8 == att::CV_WS, "e4m3 weight scale");
__device__ __forceinline__ void tr_load(const float* W, int N, int k0, int n0, int lane, f32x4 (&v)[16]) {
    const float* src = W + (size_t)(k0 + 16 * (lane >> 4)) * N + n0 + 4 * (lane & 15);
#pragma unroll
    for (int i = 0; i < 16; ++i) v[i] = *(const f32x4*)(src + (size_t)i * N);
}
constexpr float WSI8 = 1400.f, ASI8 = 31.f, WSU8 = 700.f, WSD8 = 2600.f, HSI8 = 16.f;
template <int FP8>
__device__ __forceinline__ void tr_store(const f32x4 (&v)[16], void* WT, int K, int k0, int drow0, int lane, float wsc) {
    const int c = lane & 15, q = lane >> 4;
#pragma unroll
    for (int j = 0; j < 4; ++j) {
        const size_t eoff = (size_t)(drow0 + 4 * c + j) * K + k0 + 16 * q;
        if constexpr (FP8 == 2) { u32x4 o;
            o.x = pk4_i8(v[0][j] * wsc, v[1][j] * wsc, v[2][j] * wsc, v[3][j] * wsc); o.y = pk4_i8(v[4][j] * wsc, v[5][j] * wsc, v[6][j] * wsc, v[7][j] * wsc);
            o.z = pk4_i8(v[8][j] * wsc, v[9][j] * wsc, v[10][j] * wsc, v[11][j] * wsc); o.w = pk4_i8(v[12][j] * wsc, v[13][j] * wsc, v[14][j] * wsc, v[15][j] * wsc);
            *(u32x4*)((unsigned char*)WT + eoff) = o; }
        else if constexpr (FP8 == 1) { u32x4 o;
            o.x = pk4_fp8(v[0][j] * WSC8, v[1][j] * WSC8, v[2][j] * WSC8, v[3][j] * WSC8); o.y = pk4_fp8(v[4][j] * WSC8, v[5][j] * WSC8, v[6][j] * WSC8, v[7][j] * WSC8);
            o.z = pk4_fp8(v[8][j] * WSC8, v[9][j] * WSC8, v[10][j] * WSC8, v[11][j] * WSC8); o.w = pk4_fp8(v[12][j] * WSC8, v[13][j] * WSC8, v[14][j] * WSC8, v[15][j] * WSC8);
            *(u32x4*)((unsigned char*)WT + eoff) = o; }
        else { u32x4 o0, o1;
            o0.x = cvtpk(v[0][j], v[1][j]); o0.y = cvtpk(v[2][j], v[3][j]); o0.z = cvtpk(v[4][j], v[5][j]); o0.w = cvtpk(v[6][j], v[7][j]);
            o1.x = cvtpk(v[8][j], v[9][j]); o1.y = cvtpk(v[10][j], v[11][j]); o1.z = cvtpk(v[12][j], v[13][j]); o1.w = cvtpk(v[14][j], v[15][j]);
            *(u32x4*)((bf16_t*)WT + eoff) = o0; *(u32x4*)((bf16_t*)WT + eoff + 8) = o1; }
    }
}
template <int MODE, int FP8 = 0>
__device__ __forceinline__ void tr_matrix(const float* W, int nb, int K, int N, void* WT, int drows, int rot, int gw, int NGW, LAS float* scr, int lane, float wsc = 1.0f) {
    const int nbn = N / 64, per = (K / 128) * nbn, total = nb * per;
    int it = gw - rot; if (it < 0) it += NGW;
    if (it >= total) return;
    f32x4 va[16], vb[16];
    int e = it / per, r = it - e * per, kb = r / nbn, nbk = r - kb * nbn, n0 = nbk * 64, k0 = kb * 128;
    const float* Wp = W + (size_t)e * K * N; unsigned char* WTp = (unsigned char*)WT + (size_t)e * drows * K * (FP8 ? 1 : 2);
    tr_load(Wp, N, k0, n0, lane, va);
    for (;;) {
        tr_load(Wp, N, k0 + 64, n0, lane, vb);
        const int drow0 = (MODE == 0) ? n0 : ((n0 >> 7) * 256 + (n0 & 127) + (MODE == 2 ? 128 : 0));
        tr_store<FP8>(va, WTp, K, k0, drow0, lane, wsc);
        const int nit = it + NGW; const bool more = nit < total;
        int n0n = n0, k0n = k0; const float* Wpn = Wp; unsigned char* WTpn = WTp;
        if (more) { e = nit / per; r = nit - e * per; kb = r / nbn; nbk = r - kb * nbn; n0n = nbk * 64; k0n = kb * 128;
            Wpn = W + (size_t)e * K * N; WTpn = (unsigned char*)WT + (size_t)e * drows * K * (FP8 ? 1 : 2);
            tr_load(Wpn, N, k0n, n0n, lane, va); }
        tr_store<FP8>(vb, WTp, K, k0 + 64, drow0, lane, wsc);
        if (!more) break;
        it = nit; n0 = n0n; k0 = k0n; Wp = Wpn; WTp = WTpn;
    }
}
constexpr float WSC6 = 90.f, ASC6 = 2.f;
template <int MODE>
__device__ __forceinline__ void tr_matrix6(const float* W, int nb, int K, int N, unsigned char* WT, int drows, int rot, int gw, int NGW, int lane, float wscale) {
    const int nbn = N / 32, per = (K / 256) * nbn, total = nb * per;
    int it = gw - rot; if (it < 0) it += NGW;
    const int c = lane & 7, q = lane >> 3;
    for (; it < total; it += NGW) {
        const int e = it / per, r = it - e * per, kb = r / nbn, nbk = r - kb * nbn, n0 = nbk * 32, k0 = kb * 256;
        const float* src = W + (size_t)e * K * N + (size_t)(k0 + 32 * q) * N + n0 + 4 * c;
        f32x4 v[32];
#pragma unroll
        for (int i = 0; i < 32; ++i) v[i] = *(const f32x4*)(src + (size_t)i * N);
        const int drow0 = (MODE == 0) ? n0 : ((n0 >> 7) * 256 + (n0 & 127) + (MODE == 2 ? 128 : 0));
        unsigned char* dst = WT + (size_t)e * drows * K + (size_t)(drow0 + 4 * c) * K + k0 + 32 * q;
#pragma unroll
        for (int j = 0; j < 4; ++j) { float x[32];
#pragma unroll
            for (int i = 0; i < 32; ++i) x[i] = v[i][j] * wscale;
            const v6u w = pk32_fp6(x);
            *(u32x4*)(dst + (size_t)j * K) = (u32x4){w[0], w[1], w[2], w[3]}; *(u32x4*)(dst + (size_t)j * K + 16) = (u32x4){w[4], w[5], 0u, 0u}; }
    }
}
template <bool I8OUT = false>
__device__ __forceinline__ void norm_rows(const float* __restrict__ X, const float* __restrict__ gain, bf16_t* __restrict__ O, int gw, int NGW, int lane) {
    f32x4 g[8];
#pragma unroll
    for (int j = 0; j < 8; ++j) g[j] = *(const f32x4*)(gain + 4 * lane + 256 * j);
    for (int m = gw; m < M; m += 2 * NGW) {
        const f32x4* xa = (const f32x4*)(X + (size_t)m * D) + lane; const f32x4* xb = (const f32x4*)(X + (size_t)(m + NGW) * D) + lane;
        f32x4 va[8], vb[8]; float sa = 0.f, sb = 0.f;
#pragma unroll
        for (int j = 0; j < 8; ++j) { va[j] = xa[64 * j]; vb[j] = xb[64 * j]; }
#pragma unroll
        for (int j = 0; j < 8; ++j) { sa += dot4(va[j]); sb += dot4(vb[j]); }
        const float ra = 1.0f / sqrtf(wave_sum(sa) * (1.0f / D) + EPS), rb = 1.0f / sqrtf(wave_sum(sb) * (1.0f / D) + EPS);
        if constexpr (I8OUT) { unsigned* oa = (unsigned*)((unsigned char*)O + (size_t)m * D) + lane; unsigned* ob = (unsigned*)((unsigned char*)O + (size_t)(m + NGW) * D) + lane;
#pragma unroll
            for (int j = 0; j < 8; ++j) { const f32x4 ya = va[j] * (ra * ASI8) * g[j], yb = vb[j] * (rb * ASI8) * g[j]; oa[64 * j] = pk4_i8(ya.x, ya.y, ya.z, ya.w); ob[64 * j] = pk4_i8(yb.x, yb.y, yb.z, yb.w); } }
        else {
        u32x2* oa = (u32x2*)(O + (size_t)m * D) + lane; u32x2* ob = (u32x2*)(O + (size_t)(m + NGW) * D) + lane;
#pragma unroll
        for (int j = 0; j < 8; ++j) { const f32x4 ya = va[j] * ra * g[j], yb = vb[j] * rb * g[j]; u32x2 wa, wb; wa.x = cvtpk(ya.x, ya.y); wa.y = cvtpk(ya.z, ya.w); wb.x = cvtpk(yb.x, yb.y); wb.y = cvtpk(yb.z, yb.w);
            oa[64 * j] = wa; ob[64 * j] = wb; } }
    }
}
__device__ __forceinline__ void rope_cs(int pos, double invf, float& c, float& s) {
    const double rev = (double)pos * invf * 0.15915494309189535; const float fr = (float)(rev - __builtin_floor(rev));
    s = __builtin_amdgcn_sinf(fr); c = __builtin_amdgcn_cosf(fr);
}

#ifndef PHASES
#define PHASES 0xffffffffu
#endif
#define PH(n) (((PHASES) >> (n)) & 1u)
#ifndef REPEAT
#define REPEAT 0u
#endif
#define RP(n) _Pragma("nounroll") for (int rep_ = 0; rep_ < (int)(((REPEAT) >> (n)) & 1u) + 1; ++rep_)
__global__ void __launch_bounds__(NTHREADS, 2) fwd_kernel(Args args) {
    extern __shared__ __attribute__((aligned(16))) unsigned char lds_raw[];
    LAS unsigned char* lds = (LAS unsigned char*)lds_raw;
    volatile LAS unsigned* MISC = (volatile LAS unsigned*)(lds + LDSCTL_OFF);
    const int wave = __builtin_amdgcn_readfirstlane(opaque_tid() >> 6);
    const int G = gridDim.x, bx = blockIdx.x;
    const int gw = bx * NWAVES + wave, NGW = G * NWAVES, NGT = G * NTHREADS;
#define IDS() const int tid = opaque_tid(), lane = tid & 63, gtid = bx * NTHREADS + tid; (void)lane; (void)gtid
    unsigned char* ws = args.ws;
    float* out = args.out;
    { IDS(); for (int u = tid; u < (LDS_BYTES - LDSCTL_OFF) / 4; u += NTHREADS) ((LAS unsigned*)(lds + LDSCTL_OFF))[u] = 0u; }
    __syncthreads();
    XcdBarrier bar = xcd_barrier_post((unsigned*)(ws + WS_CTL) + 1024, MISC + 8);
#define GRID_BAR() xcd_barrier(bar)

    bf16_t* XB = (bf16_t*)(ws + WS_XB);
    float* csp = (float*)(ws + TAB_CSP);

    if (PH(0)) RP(0)
    {
        IDS();
        LAS float* scr = (LAS float*)(lds + wave * 16640);
        constexpr int T0 = (D / 128) * (2 * D / 64), T1 = (D / 128) * (D / 64), T2 = (D / 128) * (FF / 64), T5 = (D / 128) * (MLA_IN / 64), T6 = (QLORA / 128) * (NH * QKD / 64), T7 = (KVLORA / 128) * (NH * 256 / 64);
        constexpr int NGWC = GRID * NWAVES;
        constexpr int R1 = T0 % NGWC, R2 = (R1 + T1) % NGWC, R3 = (R2 + T2) % NGWC, R4 = (R3 + T2) % NGWC, R5 = (R4 + T2) % NGWC, R6 = (R5 + T5) % NGWC, R7 = (R6 + T6) % NGWC, R8 = (R7 + T7) % NGWC, R9 = (R8 + T1) % NGWC;
        static_assert((NE * (D / 256) * (FF / 32)) % NGWC == 0, "fp6 item count per matrix is a multiple of the wave count");
        tr_matrix<0, 2>(args.in[I_RGWIN], 1, D,      2 * D,    (bf16_t*)(ws + W_IN1),   2 * D,      0,   gw, NGW, scr, lane, WSI8);
        tr_matrix<0>(args.in[I_RGWOUT], 1,  D,      D,        (bf16_t*)(ws + W_OUT1),  D,          R1,  gw, NGW, scr, lane);
        tr_matrix<1, 2>(args.in[I_FFG], 1,  D,      FF,       (bf16_t*)(ws + W_FFGU),  2 * FF,     R2,  gw, NGW, scr, lane, WSI8);
        tr_matrix<2, 2>(args.in[I_FFU], 1,  D,      FF,       (bf16_t*)(ws + W_FFGU),  2 * FF,     R3,  gw, NGW, scr, lane, WSI8);
        tr_matrix<0, 2>(args.in[I_FFD],  1,  FF,     D,        (bf16_t*)(ws + W_FFD),   D,          R4,  gw, NGW, scr, lane, WSD8);
        tr_matrix<0, 2>(args.in[I_MLAWIN], 1, D,     MLA_IN,   (bf16_t*)(ws + W_MLAIN), MLA_IN_PAD, R5,  gw, NGW, scr, lane, WSI8);
        tr_matrix<0, 2>(args.in[I_WQUP],  1,  QLORA,  NH * QKD, (bf16_t*)(ws + W_QUP),   NH * QKD,   R6,  gw, NGW, scr, lane, WSU8);
        tr_matrix<0, 2>(args.in[I_WKVUP], 1,  KVLORA, NH * 256, (bf16_t*)(ws + W_KVUP),  NH * 256,   R7,  gw, NGW, scr, lane, WSU8);
        tr_matrix<0, 1>(args.in[I_MLAWO], 1,  D,      D,        (bf16_t*)(ws + W_MLAO),  D,          R8,  gw, NGW, scr, lane);
        tr_matrix6<1>(args.in[I_MOEG], NE, D, FF, ws + W_MOEGU, 2 * FF, R9, gw, NGW, lane, WSC6);
        tr_matrix6<2>(args.in[I_MOEU], NE, D, FF, ws + W_MOEGU, 2 * FF, R9, gw, NGW, lane, WSC6);
        { u32x4* z = (u32x4*)(ws + W_MLAIN + (size_t)MLA_IN * D); const int nz = (MLA_IN_PAD - MLA_IN) * D / 16;
          for (int i = gtid; i < nz; i += NGT) z[i] = (u32x4){0u, 0u, 0u, 0u}; }
        { bf16_t* Wg = (bf16_t*)(ws + W_GATE); const float* wa = args.in[I_RGWA]; const float* wx = args.in[I_RGWX];
          for (int idx = gtid; idx < 16 * 256 * 256; idx += NGT) { const int h = idx >> 16, n = (idx >> 8) & 255, k = idx & 255, kl = k - 128 * (h & 1);
              float v = 0.f; if (kl >= 0 && kl < 128) v = (n < 128) ? wa[((size_t)h * 128 + kl) * 128 + n] : wx[((size_t)h * 128 + kl) * 128 + (n - 128)];
              Wg[idx] = (bf16_t)(cvtpk(v, 0.f) & 0xffffu); } }
        for (int c = gtid; c < D; c += NGT) { const float lam = args.in[I_LAM][c]; csp[c] = 8.0f * 1.4426950408889634f * log1pf(expf(-lam)); }
        norm_rows<true>(args.in[I_X], args.in[I_ANM], XB, gw, NGW, lane);
    }
    GRID_BAR();

    if (PH(1)) RP(1)
    {
        pg8::Gemm g{XB, (const bf16_t*)(ws + W_IN1), D, D, D};
        pg8::SchedPlain S; S.T.init(M / 256, 2 * D / 256, G, bx); S.atile = (size_t)256 * D; S.btile = (size_t)256 * D;
        pg8::EpiBf16 E{(bf16_t*)(ws + A_U), 2 * D, 1.0f / (WSI8 * ASI8)};
        pg8::gemm_phase8<pg8::EpiBf16, pg8::SchedPlain, 2>(lds, g, S, E);
    }
    GRID_BAR();

    if (PH(2)) RP(2)
    {
        IDS();
        const bf16_t* __restrict__ U = (const bf16_t*)(ws + A_U); bf16_t* __restrict__ XC = (bf16_t*)(ws + A_XC);
        const float* __restrict__ cw = args.in[I_CONVW]; const float* __restrict__ cb = args.in[I_CONVB];
        const int cg = tid & 255, r0 = bx * RPB + (tid >> 8) * (RPB / 2);
        float wk[4][8], bias[8];
#pragma unroll
        for (int k = 0; k < 4; ++k) { const f32x4 w0 = *(const f32x4*)(cw + k * D + cg * 8), w1 = *(const f32x4*)(cw + k * D + cg * 8 + 4);
            wk[k][0] = w0.x; wk[k][1] = w0.y; wk[k][2] = w0.z; wk[k][3] = w0.w; wk[k][4] = w1.x; wk[k][5] = w1.y; wk[k][6] = w1.z; wk[k][7] = w1.w; }
        { const f32x4 b0 = *(const f32x4*)(cb + cg * 8), b1 = *(const f32x4*)(cb + cg * 8 + 4); bias[0] = b0.x; bias[1] = b0.y; bias[2] = b0.z; bias[3] = b0.w; bias[4] = b1.x; bias[5] = b1.y; bias[6] = b1.z; bias[7] = b1.w; }
        const bf16_t* rec = U + (size_t)r0 * (2 * D) + D + cg * 8;
        bf16_t* dst = XC + (size_t)r0 * D + cg * 8;
        u32x4 x3 = {0u, 0u, 0u, 0u}, x2 = x3, x1 = x3;
        if ((r0 & (SEQ - 1)) != 0) { x3 = *(const u32x4*)(rec - 3 * (2 * D)); x2 = *(const u32x4*)(rec - 2 * (2 * D)); x1 = *(const u32x4*)(rec - 1 * (2 * D)); }
#pragma unroll 1
        for (int tb = 0; tb < RPB / 2; tb += 8) {
            u32x4 xn[8];
#pragma unroll
            for (int u = 0; u < 8; ++u) xn[u] = *(const u32x4*)(rec + (size_t)(tb + u) * (2 * D));
#pragma unroll
            for (int u = 0; u < 8; ++u) {
                const u32x4 x0 = xn[u]; float acc[8];
#define CONV_TAP(K_, X_) do { acc[0] += wk[K_][0] * bflo(X_.x); acc[1] += wk[K_][1] * bfhi(X_.x); acc[2] += wk[K_][2] * bflo(X_.y); acc[3] += wk[K_][3] * bfhi(X_.y); \
                              acc[4] += wk[K_][4] * bflo(X_.z); acc[5] += wk[K_][5] * bfhi(X_.z); acc[6] += wk[K_][6] * bflo(X_.w); acc[7] += wk[K_][7] * bfhi(X_.w); } while (0)
#pragma unroll
                for (int e = 0; e < 8; ++e) acc[e] = bias[e];
                CONV_TAP(0, x3); CONV_TAP(1, x2); CONV_TAP(2, x1); CONV_TAP(3, x0);
#undef CONV_TAP
                u32x4 o; o.x = cvtpk(acc[0], acc[1]); o.y = cvtpk(acc[2], acc[3]); o.z = cvtpk(acc[4], acc[5]); o.w = cvtpk(acc[6], acc[7]);
                *(u32x4*)(dst + (size_t)(tb + u) * D) = o;
                x3 = x2; x2 = x1; x1 = x0;
            }
        }
    }
    GRID_BAR();

    if (PH(3)) RP(3)
    {
        pg8::Gemm g{(const bf16_t*)(ws + A_XC), (const bf16_t*)(ws + W_GATE), D, 256, 256};
        pg8::SchedGate S; S.T.init(M / 256, 16, G, bx);
        pg8::EpiGate E{(const bf16_t*)(ws + A_XC), args.in[I_RGBA], args.in[I_RGBX], csp, (unsigned*)(ws + A_AV)};
        pg8::gemm_phase(lds, g, S, E);
    }
    GRID_BAR();

    if (PH(4)) RP(4)
    {
        IDS();
        const unsigned* __restrict__ AB = (const unsigned*)(ws + A_AV);
        float* __restrict__ AGA = (float*)(ws + WS_AGGA); float* __restrict__ AGB = (float*)(ws + WS_AGGB);
        for (int item = bx; item < NBATCH * NCH; item += G) {
            const size_t r0 = (size_t)item * SCH;
            f32x4 A = {1.f, 1.f, 1.f, 1.f}, B = {0.f, 0.f, 0.f, 0.f};
#pragma unroll 8
            for (int t = 0; t < SCH; ++t) { const u32x4 w = *(const u32x4*)(AB + (r0 + t) * D + 4 * tid);
                const f32x4 a = {__builtin_amdgcn_exp2f(bflo(w.x)), __builtin_amdgcn_exp2f(bflo(w.y)), __builtin_amdgcn_exp2f(bflo(w.z)), __builtin_amdgcn_exp2f(bflo(w.w))};
                const f32x4 b = {bfhi(w.x), bfhi(w.y), bfhi(w.z), bfhi(w.w)}; A = A * a; B = a * B + b; }
            *(f32x4*)(AGA + (size_t)item * D + 4 * tid) = A; *(f32x4*)(AGB + (size_t)item * D + 4 * tid) = B;
        }
    }
    GRID_BAR();

    if (PH(5)) RP(5)
    {
        IDS();
        const unsigned* __restrict__ AB = (const unsigned*)(ws + A_AV);
        const float* __restrict__ AGA = (const float*)(ws + WS_AGGA); const float* __restrict__ AGB = (const float*)(ws + WS_AGGB);
        const bf16_t* __restrict__ U = (const bf16_t*)(ws + A_U); bf16_t* __restrict__ Y = (bf16_t*)(ws + A_Y);
        for (int item = bx; item < NBATCH * NCH; item += G) {
            const int b = item / NCH, ch = item - b * NCH; const size_t r0 = (size_t)item * SCH;
            f32x4 h = {0.f, 0.f, 0.f, 0.f};
#pragma unroll 8
            for (int c = 0; c < ch; ++c) { const f32x4 a = *(const f32x4*)(AGA + (size_t)(b * NCH + c) * D + 4 * tid), bb = *(const f32x4*)(AGB + (size_t)(b * NCH + c) * D + 4 * tid); h = a * h + bb; }
#pragma unroll 8
            for (int t = 0; t < SCH; ++t) {
                const u32x4 pw = *(const u32x4*)(AB + (r0 + t) * D + 4 * tid);
                const f32x4 a = {__builtin_amdgcn_exp2f(bflo(pw.x)), __builtin_amdgcn_exp2f(bflo(pw.y)), __builtin_amdgcn_exp2f(bflo(pw.z)), __builtin_amdgcn_exp2f(bflo(pw.w))};
                const f32x4 bb = {bfhi(pw.x), bfhi(pw.y), bfhi(pw.z), bfhi(pw.w)};
                const u32x2 gw2 = *(const u32x2*)(U + (r0 + t) * (2 * D) + 4 * tid);
                h = a * h + bb;
                const float y0 = h.x * gelu_tanh(bflo(gw2.x)), y1 = h.y * gelu_tanh(bfhi(gw2.x)), y2 = h.z * gelu_tanh(bflo(gw2.y)), y3 = h.w * gelu_tanh(bfhi(gw2.y));
                u32x2 w; w.x = cvtpk(y0, y1); w.y = cvtpk(y2, y3);
                *(u32x2*)(Y + (r0 + t) * D + 4 * tid) = w;
            }
        }
    }
    GRID_BAR();

    if (PH(6)) RP(6)
    {
        pg8::Gemm g{(const bf16_t*)(ws + A_Y), (const bf16_t*)(ws + W_OUT1), D, D, D};
        pg8::SchedPlain S; S.T.init(M / 256, D / 256, G, bx); S.atile = (size_t)256 * D * 2; S.btile = (size_t)256 * D * 2;
        pg8::EpiResidual E{args.in[I_X], out, D, 1.0f};
        pg8::gemm_phase(lds, g, S, E);
    }
    GRID_BAR();
    if (PH(7)) RP(7)
    { IDS(); norm_rows<true>(out, args.in[I_ANF], XB, gw, NGW, lane); }
    GRID_BAR();
    if (PH(8)) RP(8)
    {
        pg8::Gemm g{XB, (const bf16_t*)(ws + W_FFGU), D, D, D};
        pg8::SchedPlain S; S.T.init(M / 256, 2 * FF / 256, G, bx); S.atile = (size_t)256 * D; S.btile = (size_t)256 * D;
        pg8::EpiSwiglu<2> E{(void*)(ws + A_H), FF, 1.0f / (WSI8 * ASI8), HSI8};
        pg8::gemm_phase8<pg8::EpiSwiglu<2>, pg8::SchedPlain, 2>(lds, g, S, E);
    }
    GRID_BAR();
    if (PH(9)) RP(9)
    {
        pg8::Gemm g{(const bf16_t*)(ws + A_H), (const bf16_t*)(ws + W_FFD), FF, FF, FF};
        pg8::SchedPlain S; S.T.init(M / 256, D / 256, G, bx); S.atile = (size_t)256 * FF; S.btile = (size_t)256 * FF;
        pg8::EpiResidual E{out, out, D, 1.0f / (WSD8 * HSI8)};
        pg8::gemm_phase8<pg8::EpiResidual, pg8::SchedPlain, 2>(lds, g, S, E);
    }
    GRID_BAR();
    if (PH(10)) RP(10)
    { IDS(); norm_rows<true>(out, args.in[I_BNM], XB, gw, NGW, lane); }
    GRID_BAR();
    if (PH(11)) RP(11)
    {
        pg8::Gemm g{XB, (const bf16_t*)(ws + W_MLAIN), D, D, D};
        pg8::SchedPlain S; S.T.init(M / 256, 4, G, bx); S.atile = (size_t)256 * D; S.btile = (size_t)256 * D;
        pg8::EpiBf16 E{(bf16_t*)(ws + A_CU), MLA_IN_PAD, 1.0f / (WSI8 * ASI8)};
        pg8::gemm_phase8<pg8::EpiBf16, pg8::SchedPlain, 2>(lds, g, S, E);
    }
    if (PH(11)) RP(11)
    {
        pg8::Gemm g{XB, (const bf16_t*)(ws + W_MLAIN), D, D, D / 4};
        pg8::SchedKSplit S{G, bx, M / 256, 4, 4, (size_t)256 * D, (size_t)256 * D, (size_t)(D / 4)};
        pg8::EpiKpe E{(float*)(ws + A_KPP), 4, 1.0f / (WSI8 * ASI8)};
        pg8::gemm_phase8<pg8::EpiKpe, pg8::SchedKSplit, 2>(lds, g, S, E);
    }
    GRID_BAR();
    if (PH(12)) RP(12)
    {
        IDS();
        const bf16_t* __restrict__ CU = (const bf16_t*)(ws + A_CU); bf16_t* __restrict__ CQ = (bf16_t*)(ws + A_CQ); bf16_t* __restrict__ CKV = (bf16_t*)(ws + A_CKV); bf16_t* __restrict__ KPE = (bf16_t*)(ws + A_KPE);
        const int* __restrict__ posv = args.positions; float* __restrict__ CST = (float*)(ws + A_CST); const float* __restrict__ KPP = (const float*)(ws + A_KPP);
        const f32x4 gq0 = *(const f32x4*)(args.in[I_QNORM] + 4 * lane), gq1 = *(const f32x4*)(args.in[I_QNORM] + 256 + 4 * lane);
        const f32x4 gk0 = *(const f32x4*)(args.in[I_KVNORM] + 4 * lane), gk1 = *(const f32x4*)(args.in[I_KVNORM] + 256 + 4 * lane);
        const double invf = INV_FREQ[lane & 31];
#pragma unroll 2
        for (int m = gw; m < M; m += NGW) {
            const bf16_t* r = CU + (size_t)m * MLA_IN_PAD;
            const u32x2 wq0 = *(const u32x2*)(r + 4 * lane), wq1 = *(const u32x2*)(r + 256 + 4 * lane), wk0 = *(const u32x2*)(r + 512 + 4 * lane), wk1 = *(const u32x2*)(r + 768 + 4 * lane);
            const f32x4 q0 = {bflo(wq0.x), bfhi(wq0.x), bflo(wq0.y), bfhi(wq0.y)}, q1 = {bflo(wq1.x), bfhi(wq1.x), bflo(wq1.y), bfhi(wq1.y)};
            const f32x4 k0 = {bflo(wk0.x), bfhi(wk0.x), bflo(wk0.y), bfhi(wk0.y)}, k1 = {bflo(wk1.x), bfhi(wk1.x), bflo(wk1.y), bfhi(wk1.y)};
            const float* kp = KPP + (size_t)m * 64 + (lane & 31);
            const float x1 = (kp[0] + kp[(size_t)M * 64]) + (kp[(size_t)2 * M * 64] + kp[(size_t)3 * M * 64]), x2 = (kp[32] + kp[(size_t)M * 64 + 32]) + (kp[(size_t)2 * M * 64 + 32] + kp[(size_t)3 * M * 64 + 32]);
            const float rq = 1.0f / sqrtf(wave_sum(dot4(q0) + dot4(q1)) * (1.0f / QLORA) + EPS), rk = 1.0f / sqrtf(wave_sum(dot4(k0) + dot4(k1)) * (1.0f / KVLORA) + EPS);
            { const f32x4 y0 = q0 * (rq * ASI8) * gq0, y1 = q1 * (rq * ASI8) * gq1;
              *(unsigned*)((unsigned char*)CQ + (size_t)m * QLORA + 4 * lane) = pk4_i8(y0.x, y0.y, y0.z, y0.w); *(unsigned*)((unsigned char*)CQ + (size_t)m * QLORA + 256 + 4 * lane) = pk4_i8(y1.x, y1.y, y1.z, y1.w); }
            { const f32x4 y0 = k0 * (rk * ASI8) * gk0, y1 = k1 * (rk * ASI8) * gk1;
              *(unsigned*)((unsigned char*)CKV + (size_t)m * KVLORA + 4 * lane) = pk4_i8(y0.x, y0.y, y0.z, y0.w); *(unsigned*)((unsigned char*)CKV + (size_t)m * KVLORA + 256 + 4 * lane) = pk4_i8(y1.x, y1.y, y1.z, y1.w); }
            float cs, sn; rope_cs(posv[m], invf, cs, sn);
            const float o1 = x1 * cs - x2 * sn, o2 = x2 * cs + x1 * sn;
            CST[(size_t)m * 64 + lane] = (lane < 32) ? cs : sn;
            if (lane < 32) { KPE[(size_t)m * ROPE + lane] = (bf16_t)(cvtpk(o1, 0.f) & 0xffffu); KPE[(size_t)m * ROPE + 32 + lane] = (bf16_t)(cvtpk(o2, 0.f) & 0xffffu); }
        }
    }
    GRID_BAR();
    if (PH(13)) RP(13)
    {
        pg8::Gemm g{(const bf16_t*)(ws + A_CQ), (const bf16_t*)(ws + W_QUP), QLORA, QLORA, QLORA};
        pg8::SchedPlain S; S.T.init(M / 256, NH * QKD / 256, G, bx); S.atile = (size_t)256 * QLORA; S.btile = (size_t)256 * QLORA;
        pg8::EpiFp8 E{ws + A_Q, NH * QKD, QSCALE * att::QS8 / (WSU8 * ASI8)};
        pg8::gemm_phase8<pg8::EpiFp8, pg8::SchedPlain, 2>(lds, g, S, E);
    }
    if (PH(22)) RP(22)
    {
        pg8::Gemm g{(const bf16_t*)(ws + A_CKV), (const bf16_t*)(ws + W_KVUP), KVLORA, KVLORA, KVLORA};
        pg8::SchedPlain S; S.T.init(M / 256, NH * 256 / 256, G, bx); S.atile = (size_t)256 * KVLORA; S.btile = (size_t)256 * KVLORA;
        pg8::EpiFp8 E{ws + A_KV, NH * 256, 1.0f / (WSU8 * ASI8)};
        pg8::gemm_phase8<pg8::EpiFp8, pg8::SchedPlain, 2>(lds, g, S, E);
    }
    GRID_BAR();
    if (PH(15)) RP(15)
    {
        const int vcu = (G % 8 == 0) ? (bx % 8) * (G / 8) + bx / 8 : bx;
        att::CvtState cs{args.in[I_MOED], ws + W_MOED, gw * att::CV_IPW, (gw + 1) * att::CV_IPW};
        for (int L = vcu; L < NBATCH * NH * 8; L += G) {
            const int bh = L >> 3, x = L & 7, b = bh / NH, h = bh - b * NH;
#pragma nounroll
            for (int pass = 0; pass < 2; ++pass)
                att::attn_unit(lds, ws + A_Q, ws + A_KV, (const bf16_t*)(ws + A_KPE), (const float*)(ws + A_CST), (bf16_t*)(ws + A_O), b, h, pass ? x : 15 - x, cs);
        }
        { const int lane_ = opaque_tid() & 63;
#pragma nounroll
          while (cs.next < cs.end) { f32x4 cv[8]; att::cvt_load(cs, lane_, cv); att::cvt_store(cs, lane_, cv); } }
    }
    GRID_BAR();
    if (PH(16)) RP(16)
    {
        pg8::Gemm g{(const bf16_t*)(ws + A_O), (const bf16_t*)(ws + W_MLAO), D, D, D};
        pg8::SchedPlain S; S.T.init(M / 256, D / 256, G, bx); S.atile = (size_t)256 * D; S.btile = (size_t)256 * D;
        pg8::EpiResidual E{out, out, D, 1.0f / (WSC8 * att::OSC8)};
        pg8::gemm_phase8<pg8::EpiResidual, pg8::SchedPlain, 0>(lds, g, S, E);
    }
    GRID_BAR();
    int* CNT = (int*)(ws + TAB_CNT); int* TILE = (int*)(ws + TAB_TILE); int* SLOT = (int*)(ws + TAB_SLOT); float* GATE = (float*)(ws + TAB_GATE); int* TOPE = (int*)(ws + TAB_TOPE);
    if (PH(17)) RP(17)
    {
        IDS();
        LAS float* wr = (LAS float*)lds;
        LAS int* tl = (LAS int*)(lds + 65536);
        const float* gain = args.in[I_BNF]; const float* wrt = args.in[I_ROUTER];
        for (int d = tid; d < D; d += NTHREADS) { const float gd = gain[d]; const f32x4 a = *(const f32x4*)(wrt + (size_t)d * 8), c = *(const f32x4*)(wrt + (size_t)d * 8 + 4);
            wr[0 * D + d] = a.x * gd; wr[1 * D + d] = a.y * gd; wr[2 * D + d] = a.z * gd; wr[3 * D + d] = a.w * gd; wr[4 * D + d] = c.x * gd; wr[5 * D + d] = c.y * gd; wr[6 * D + d] = c.z * gd; wr[7 * D + d] = c.w * gd; }
        f32x4 g[8];
#pragma unroll
        for (int j = 0; j < 8; ++j) g[j] = *(const f32x4*)(gain + 4 * lane + 256 * j);
        __syncthreads();
        for (int i = 0; i < RPB / NWAVES; i += 2) {
            const int rl = wave * (RPB / NWAVES) + i, m = bx * RPB + rl;
            const f32x4* xr = (const f32x4*)(out + (size_t)m * D) + lane;
            f32x4 va[8], vb[8]; float sa = 0.f, sb = 0.f;
#pragma unroll
            for (int j = 0; j < 8; ++j) { va[j] = xr[64 * j]; vb[j] = xr[64 * j + D / 4]; }
#pragma unroll
            for (int j = 0; j < 8; ++j) { sa += dot4(va[j]); sb += dot4(vb[j]); }
            float la[8], lb[8];
#pragma unroll
            for (int e = 0; e < 8; ++e) { float a = 0.f, b = 0.f;
#pragma unroll
                for (int j = 0; j < 8; ++j) { const f32x4 w = *(const LAS f32x4*)(wr + e * D + 4 * lane + 256 * j);
                    a += (va[j].x * w.x + va[j].y * w.y) + (va[j].z * w.z + va[j].w * w.w); b += (vb[j].x * w.x + vb[j].y * w.y) + (vb[j].z * w.z + vb[j].w * w.w); }
                la[e] = a; lb[e] = b; }
            const float ra = 1.0f / sqrtf(wave_sum(sa) * (1.0f / D) + EPS), rb = 1.0f / sqrtf(wave_sum(sb) * (1.0f / D) + EPS);
#pragma unroll
            for (int e = 0; e < 8; ++e) { la[e] = wave_sum(la[e]) * ra; lb[e] = wave_sum(lb[e]) * rb; }
#pragma unroll
            for (int rr = 0; rr < 2; ++rr) {
                float lg[8];
#pragma unroll
                for (int e = 0; e < 8; ++e) lg[e] = rr ? lb[e] : la[e];
                int e1 = 0; float v1 = lg[0];
#pragma unroll
                for (int e = 1; e < 8; ++e) if (lg[e] > v1) { v1 = lg[e]; e1 = e; }
                int e2 = -1; float v2 = -__builtin_inff();
#pragma unroll
                for (int e = 0; e < 8; ++e) if (e != e1 && lg[e] > v2) { v2 = lg[e]; e2 = e; }
                const float g2 = 1.0f / (1.0f + expf(v1 - v2)), g1 = 1.0f - g2;
                if (lane == 0) { tl[2 * (rl + rr)] = e1; tl[2 * (rl + rr) + 1] = e2; TOPE[2 * (m + rr)] = e1; TOPE[2 * (m + rr) + 1] = e2; GATE[2 * (m + rr)] = g1; GATE[2 * (m + rr) + 1] = g2; }
            }
            u32x2* o = (u32x2*)(XB + (size_t)m * D) + lane;
#pragma unroll
            for (int j = 0; j < 8; ++j) { const f32x4 ya = va[j] * ra * g[j], yb = vb[j] * rb * g[j]; u32x2 wa, wb; wa.x = cvtpk(ya.x, ya.y); wa.y = cvtpk(ya.z, ya.w); wb.x = cvtpk(yb.x, yb.y); wb.y = cvtpk(yb.z, yb.w);
                o[64 * j] = wa; o[64 * j + D / 4] = wb; }
        }
        __syncthreads();
        if (tid < NE) { int c = 0; for (int i = 0; i < 2 * RPB; ++i) c += (tl[i] == tid) ? 1 : 0; CNT[bx * NE + tid] = c; }
        __syncthreads();
    }
    GRID_BAR();
    if (PH(18)) RP(18)
    {
        IDS();
        LAS int* sh = (LAS int*)lds;
        if (tid < NE) { int before = 0, total = 0; for (int bb = 0; bb < G; ++bb) { const int c = CNT[bb * NE + tid]; total += c; before += (bb < bx) ? c : 0; } sh[tid] = before; sh[16 + tid] = total; }
        if (tid >= 64 && tid < 64 + 2 * RPB) sh[32 + (tid - 64)] = TOPE[2 * bx * RPB + (tid - 64)];
        __syncthreads();
        if (tid == 0) { int ps = 0; for (int e = 0; e < NE; ++e) { sh[8 + e] = ps; ps += ((sh[16 + e] + 255) >> 8) << 8; }
            if (bx == 0) { int ti = 0; for (int e = 0; e < NE; ++e) { const int ntl = (sh[16 + e] + 255) >> 8; for (int q = 0; q < ntl; ++q) TILE[ti++] = e; } TILE[255] = ti; } }
        __syncthreads();
        if (tid < 2 * RPB) { const int e = sh[32 + tid]; int rank = 0; for (int j = 0; j < tid; ++j) rank += (sh[32 + j] == e) ? 1 : 0;
            const int slot = sh[8 + e] + sh[e] + rank; sh[160 + tid] = slot; SLOT[2 * bx * RPB + tid] = slot; }
        __syncthreads();
        unsigned char* BUF = ws + A_BUF;
        for (int en = wave; en < 2 * RPB; en += 2 * NWAVES) {
            u32x4 s[2][4]; int slot[2];
#pragma unroll
            for (int qq = 0; qq < 2; ++qq) { const int e_ = en + qq * NWAVES, m = bx * RPB + (e_ >> 1); slot[qq] = sh[160 + e_];
                const u32x4* src = (const u32x4*)(XB + (size_t)m * D + 32 * lane);
#pragma unroll
                for (int j = 0; j < 4; ++j) s[qq][j] = src[j]; }
#pragma unroll
            for (int qq = 0; qq < 2; ++qq) { float x[32];
#pragma unroll
                for (int j = 0; j < 4; ++j) { const u32x4 t = s[qq][j]; x[8 * j + 0] = bflo(t.x) * ASC6; x[8 * j + 1] = bfhi(t.x) * ASC6; x[8 * j + 2] = bflo(t.y) * ASC6; x[8 * j + 3] = bfhi(t.y) * ASC6;
                    x[8 * j + 4] = bflo(t.z) * ASC6; x[8 * j + 5] = bfhi(t.z) * ASC6; x[8 * j + 6] = bflo(t.w) * ASC6; x[8 * j + 7] = bfhi(t.w) * ASC6; }
                const v6u w = pk32_fp6(x); unsigned char* dst = BUF + (size_t)slot[qq] * D + 32 * lane;
                *(u32x4*)dst = (u32x4){w[0], w[1], w[2], w[3]}; *(u32x4*)(dst + 16) = (u32x4){w[4], w[5], 0u, 0u}; } }
        __syncthreads();
    }
    GRID_BAR();
    if (PH(19)) RP(19)
    {
        LAS int* tlds = (LAS int*)(lds + LDSCTL_OFF + 1024);
        { IDS(); if (tid < 256) tlds[tid] = TILE[tid]; __syncthreads(); }
        const int ntiles = tlds[255];
        pg8::Gemm g{(const bf16_t*)(ws + A_BUF), (const bf16_t*)(ws + W_MOEGU), D, D, D};
        pg8::SchedMoe S; S.T.init(ntiles, 2 * FF / 256, G, bx); S.tile_e = tlds; S.atile = (size_t)256 * D; S.btile = (size_t)256 * D; S.nN = 2 * FF / 256;
        pg8::EpiSwiglu<1> E{(void*)(ws + A_HM), FF, 1.0f / (WSC6 * ASC6), HSC8};
        pg8::gemm_phase8<pg8::EpiSwiglu<1>, pg8::SchedMoe, 1>(lds, g, S, E);
    }
    GRID_BAR();
    if (PH(20)) RP(20)
    {
        LAS int* tlds = (LAS int*)(lds + LDSCTL_OFF + 1024);
        { IDS(); if (tid < 256) tlds[tid] = TILE[tid]; __syncthreads(); }
        const int ntiles = tlds[255], nmain = ntiles < MAIN_TILES ? ntiles : MAIN_TILES;
        {
            pg8::Gemm g{(const bf16_t*)(ws + A_HM), (const bf16_t*)(ws + W_MOED), FF, FF, FF};
            pg8::SchedMoe S; S.T.init(nmain, D / 256, G, bx); S.tile_e = tlds; S.atile = (size_t)256 * FF; S.btile = (size_t)256 * FF; S.nN = D / 256;
            pg8::EpiBf16 E{(bf16_t*)(ws + A_YM), D, 1.0f / (WSC8 * HSC8)};
            pg8::gemm_phase8(lds, g, S, E);
        }
        if (ntiles > MAIN_TILES) {
            pg8::Gemm g{(const bf16_t*)(ws + A_HM), (const bf16_t*)(ws + W_MOED), FF, FF, FF / KSPLIT};
            pg8::SchedMoeSplit S; S.G = G; S.c = bx; S.pm0 = MAIN_TILES; S.nN = D / 256; S.ntl = (ntiles - MAIN_TILES) * (D / 256); S.KS = KSPLIT; S.tile_e = tlds;
            S.atile = (size_t)256 * FF; S.btile = (size_t)256 * FF; S.kbytes = FF / KSPLIT;
            pg8::EpiBf16Split E{(bf16_t*)(ws + A_YP) - (size_t)MAIN_TILES * 256 * D, D, 1.0f / (WSC8 * HSC8), (size_t)(MAXT - MAIN_TILES) * 256 * D};
            pg8::gemm_phase8(lds, g, S, E);
        }
    }
    GRID_BAR();
    if (PH(21)) RP(21)
    {
        IDS();
        const bf16_t* YM = (const bf16_t*)(ws + A_YM); const float* gain = args.in[I_FNORM];
        const bf16_t* YP = (const bf16_t*)(ws + A_YP); constexpr size_t YPS = (size_t)(MAXT - MAIN_TILES) * 256 * D;
        const bool poison = xb_ld((unsigned*)(ws + WS_CTL) + 1024 + XB_TMO) != 0u;
        f32x4 g[8];
#pragma unroll
        for (int j = 0; j < 8; ++j) g[j] = *(const f32x4*)(gain + 4 * lane + 256 * j);
        for (int m = gw; m < M; m += NGW) {
            const int s1 = SLOT[2 * m], s2 = SLOT[2 * m + 1]; const float g1 = GATE[2 * m], g2 = GATE[2 * m + 1];
            f32x4* xr = (f32x4*)(out + (size_t)m * D) + lane;
            const u32x2* y1 = (const u32x2*)(YM + (size_t)s1 * D) + lane; const u32x2* y2 = (const u32x2*)(YM + (size_t)s2 * D) + lane;
            f32x4 v[8]; float s = 0.f;
            if (s1 < MAIN_TILES * 256 && s2 < MAIN_TILES * 256) {
#pragma unroll
            for (int j = 0; j < 8; ++j) { const f32x4 x = xr[64 * j]; const u32x2 a = y1[64 * j], b = y2[64 * j];
                f32x4 t; t.x = x.x + g1 * bflo(a.x) + g2 * bflo(b.x); t.y = x.y + g1 * bfhi(a.x) + g2 * bfhi(b.x); t.z = x.z + g1 * bflo(a.y) + g2 * bflo(b.y); t.w = x.w + g1 * bfhi(a.y) + g2 * bfhi(b.y);
                v[j] = t; s += dot4(t); }
            } else {
#pragma unroll
                for (int j = 0; j < 8; ++j) v[j] = xr[64 * j];
#pragma unroll
                for (int k = 0; k < 2; ++k) { const int sl = k ? s2 : s1; const float gk = k ? g2 : g1;
                    const int np = (sl < MAIN_TILES * 256) ? 1 : KSPLIT;
                    const bf16_t* base = (sl < MAIN_TILES * 256) ? YM + (size_t)sl * D : YP + (size_t)(sl - MAIN_TILES * 256) * D;
                    for (int kc = 0; kc < np; ++kc) { const u32x2* y = (const u32x2*)(base + (size_t)kc * YPS) + lane;
#pragma unroll
                        for (int j = 0; j < 8; ++j) { const u32x2 a = y[64 * j]; v[j].x += gk * bflo(a.x); v[j].y += gk * bfhi(a.x); v[j].z += gk * bflo(a.y); v[j].w += gk * bfhi(a.y); } } }
#pragma unroll
                for (int j = 0; j < 8; ++j) s += dot4(v[j]);
            }
            float rstd = 1.0f / sqrtf(wave_sum(s) * (1.0f / D) + EPS);
            if (poison) rstd = __builtin_nanf("");
#pragma unroll
            for (int j = 0; j < 8; ++j) xr[64 * j] = v[j] * rstd * g[j];
        }
    }
}

extern "C" void kernel_launch(void* const* d_in, const int* in_sizes, int n_in, void* d_out, int out_size, void* d_ws, size_t ws_size, hipStream_t stream) {
    static int ready = 0;
    if (ready == 0) {
        if (n_in != 29 || in_sizes[0] != M * D || out_size != M * D || ws_size < WS_END) {
            fprintf(stderr, "kernel_launch: unexpected shapes (n_in %d, in0 %d, out %d, ws %zu, need %zu); nothing launched\n", n_in, n_in > 0 ? in_sizes[0] : -1, out_size, ws_size, (size_t)WS_END); ready = -1; return; }
        if (hipFuncSetAttribute((const void*)fwd_kernel, hipFuncAttributeMaxDynamicSharedMemorySize, LDS_BYTES) != hipSuccess) { fprintf(stderr, "kernel_launch: hipFuncSetAttribute failed\n"); ready = -1; return; }
        int per_cu = 0;
        if (hipOccupancyMaxActiveBlocksPerMultiprocessor(&per_cu, (const void*)fwd_kernel, NTHREADS, LDS_BYTES) != hipSuccess || per_cu < 1) fprintf(stderr, "kernel_launch: occupancy query reports %d workgroups per CU\n", per_cu);
        (void)hipGetLastError();
        ready = 1;
    }
    if (ready < 0) return;
    (void)hipMemsetAsync((char*)d_ws + WS_CTL, 0, CTL_ZERO_BYTES, stream);
    Args a{};
    for (int i = 0; i < 29; ++i) a.in[i] = (const float*)d_in[i];
    a.positions = (const int*)d_in[I_POS]; a.out = (float*)d_out; a.ws = (unsigned char*)d_ws;
    hipLaunchKernelGGL(fwd_kernel, dim3(GRID), dim3(NTHREADS), LDS_BYTES, stream, a);
}
```

```cpp
#include <hip/hip_runtime.h>
#include <cstdio>
#include <cstdint>

#define GAS __attribute__((address_space(1)))
#define LAS __attribute__((address_space(3)))
typedef unsigned short bf16_t;
typedef short bf16x8 __attribute__((ext_vector_type(8)));
typedef short s16x4 __attribute__((ext_vector_type(4)));
typedef float f32x2 __attribute__((ext_vector_type(2)));
typedef float f32x4 __attribute__((ext_vector_type(4)));
typedef float f32x16 __attribute__((ext_vector_type(16)));
typedef unsigned u32x2 __attribute__((ext_vector_type(2)));
typedef unsigned u32x4 __attribute__((ext_vector_type(4)));

constexpr int D = 2048, SEQ = 4096, NBATCH = 4, M = NBATCH * SEQ;
constexpr int NH = 16, QLORA = 512, KVLORA = 512, NOPE = 128, ROPE = 64, VDIM = 128, QKD = 192;
constexpr int MLA_IN = 1088, MLA_IN_PAD = 1280;
constexpr int FF = 7168, NE = 8;
constexpr int PMAX = 2 * M + NE * 256;
constexpr int MAXT = PMAX / 256;
constexpr float EPS = 1e-6f;
constexpr float QSCALE = 0.10411754627697264f;
constexpr int GRID = 256, NWAVES = 8, NTHREADS = 512;
constexpr int RPB = M / GRID;
constexpr int SCH = 64, NCH = SEQ / SCH;

constexpr size_t MiB = 1u << 20;
constexpr size_t WS_CTL = 0, CTL_ZERO_BYTES = 64 * 1024;
constexpr size_t WS_TAB = 1 * MiB;
constexpr size_t TAB_CSP = WS_TAB, TAB_CNT = WS_TAB + 64 * 1024, TAB_TILE = WS_TAB + 128 * 1024, TAB_SLOT = WS_TAB + 256 * 1024,
                 TAB_GATE = WS_TAB + 512 * 1024, TAB_TOPE = WS_TAB + 768 * 1024;
constexpr size_t WS_AGGA = 2 * MiB, WS_AGGB = 4 * MiB;
constexpr size_t W_IN1 = 8 * MiB, W_GATE = 24 * MiB, W_OUT1 = 26 * MiB, W_FFGU = 34 * MiB, W_FFD = 90 * MiB, W_MLAIN = 118 * MiB,
                 W_QUP = 123 * MiB, W_KVUP = 126 * MiB, W_MLAO = 130 * MiB, W_MOEGU = 138 * MiB, W_MOED = 586 * MiB;
constexpr size_t WS_XB = 810 * MiB, WS_ACT = 874 * MiB;
constexpr size_t A_U = WS_ACT, A_XC = WS_ACT + 128 * MiB, A_AV = WS_ACT + 192 * MiB, A_BV = WS_ACT + 320 * MiB, A_Y = WS_ACT + 448 * MiB;
constexpr size_t A_H = WS_ACT;
constexpr size_t A_KPP = WS_ACT + 48 * MiB;
constexpr size_t A_CST = WS_ACT + 88 * MiB;
constexpr size_t A_CU = WS_ACT, A_CQ = WS_ACT + 80 * MiB, A_CKV = WS_ACT + 96 * MiB, A_KPE = WS_ACT + 112 * MiB, A_Q = WS_ACT + 114 * MiB,
                 A_KV = WS_ACT + 210 * MiB, A_O = WS_ACT + 338 * MiB;
constexpr size_t A_YP = WS_ACT + 400 * MiB;
constexpr int MAIN_TILES = 128, KSPLIT = 4;
constexpr size_t A_BUF = WS_ACT, A_HM = WS_ACT + 136 * MiB, A_YM = WS_ACT + 612 * MiB, WS_END = WS_ACT + 748 * MiB;
static_assert((size_t)PMAX * D * 2 <= 136 * MiB && (size_t)PMAX * FF * 2 <= 476 * MiB, "moe buffers");

constexpr int RING_BYTES = 135168;
constexpr int LDSCTL_OFF = RING_BYTES;
constexpr int LDS_BYTES = 147456;

__device__ const double INV_FREQ[32] = {1.0, 0.7498942093324559, 0.5623413251903491, 0.4216965034285822, 0.31622776601683794, 0.23713737056616552, 0.1778279410038923, 0.1333521432163324, 0.1,
    0.07498942093324558, 0.05623413251903491, 0.042169650342858224, 0.03162277660168379, 0.023713737056616554, 0.01778279410038923, 0.01333521432163324, 0.01, 0.007498942093324558,
    0.005623413251903491, 0.004216965034285823, 0.0031622776601683794, 0.0023713737056616554, 0.0017782794100389228, 0.001333521432163324, 0.001, 0.0007498942093324559, 0.0005623413251903491,
    0.00042169650342858224, 0.00031622776601683794, 0.00023713737056616554, 0.00017782794100389227, 0.0001333521432163324};

__device__ __forceinline__ int opaque_tid() { int t = threadIdx.x; asm volatile("" : "+v"(t)); return t; }
#define LDS_WAIT() asm volatile("s_waitcnt lgkmcnt(0)" ::: "memory")
#define VM_WAIT() asm volatile("s_waitcnt vmcnt(0)" ::: "memory")
__device__ __forceinline__ unsigned cvtpk(float lo, float hi) { unsigned r; asm volatile("v_cvt_pk_bf16_f32 %0, %1, %2" : "=v"(r) : "v"(lo), "v"(hi)); return r; }
typedef int v8i __attribute__((ext_vector_type(8)));
typedef short v2s __attribute__((ext_vector_type(2)));
typedef __bf16 v2bf __attribute__((ext_vector_type(2)));
typedef int v4i __attribute__((ext_vector_type(4)));
__device__ __forceinline__ unsigned pk4_fp8(float a, float b, float c, float d) {
    a = __builtin_amdgcn_fmed3f(a, -448.f, 448.f); b = __builtin_amdgcn_fmed3f(b, -448.f, 448.f); c = __builtin_amdgcn_fmed3f(c, -448.f, 448.f); d = __builtin_amdgcn_fmed3f(d, -448.f, 448.f);
    int w = __builtin_amdgcn_cvt_pk_fp8_f32(a, b, 0, false); w = __builtin_amdgcn_cvt_pk_fp8_f32(c, d, w, true); return (unsigned)w; }
__device__ __forceinline__ unsigned pk4_i8(float a, float b, float c, float d) {
    const unsigned ua = __float_as_uint(__builtin_amdgcn_fmed3f(a, -127.f, 127.f) + 12582912.f), ub = __float_as_uint(__builtin_amdgcn_fmed3f(b, -127.f, 127.f) + 12582912.f);
    const unsigned uc = __float_as_uint(__builtin_amdgcn_fmed3f(c, -127.f, 127.f) + 12582912.f), ud = __float_as_uint(__builtin_amdgcn_fmed3f(d, -127.f, 127.f) + 12582912.f);
    const unsigned t1 = __builtin_amdgcn_perm(ub, ua, 0x0c0c0400u), t2 = __builtin_amdgcn_perm(ud, uc, 0x0c0c0400u);
    return __builtin_amdgcn_perm(t2, t1, 0x05040100u); }
typedef float v16f __attribute__((ext_vector_type(16)));
typedef unsigned v6u __attribute__((ext_vector_type(6)));
typedef int v6i __attribute__((ext_vector_type(6)));
typedef int v2i __attribute__((ext_vector_type(2)));
__device__ __forceinline__ v6u pk32_fp6(const float (&x)[32]) {
    v16f a, b;
#pragma unroll
    for (int i = 0; i < 16; ++i) { a[i] = __builtin_amdgcn_fmed3f(x[i], -7.5f, 7.5f); b[i] = __builtin_amdgcn_fmed3f(x[16 + i], -7.5f, 7.5f); }
    return __builtin_amdgcn_cvt_scalef32_2xpk16_fp6_f32(a, b, 1.0f);
}
__device__ __forceinline__ float bf2f(unsigned short u) { return __uint_as_float((unsigned)u << 16); }
__device__ __forceinline__ float bflo(unsigned w) { return __uint_as_float(w << 16); }
__device__ __forceinline__ float bfhi(unsigned w) { return __uint_as_float(w & 0xffff0000u); }
__device__ __forceinline__ float wave_sum(float v) {
#pragma unroll
    for (int o = 1; o < 64; o <<= 1) v += __shfl_xor(v, o);
    return v;
}
__device__ __forceinline__ float dot4(f32x4 a) { return (a.x * a.x + a.y * a.y) + (a.z * a.z + a.w * a.w); }
__device__ __forceinline__ float sigmoidf_(float x) { return __builtin_amdgcn_rcpf(1.0f + __expf(-x)); }
__device__ __forceinline__ float gelu_tanh(float x) { const float u = 1.5957691216057308f * (x + 0.044715f * x * x * x); return x * sigmoidf_(u); }

namespace pg8 {
constexpr int BM = 256, BK = 64, HALF = 128, HTB = HALF * BK * 2, STAGE_BYTES = 8 * HTB, NXCD = 8, WGM = 8;
__host__ __device__ __forceinline__ int lds_byte(int r, int c) { const int st = (r >> 4) * 2 + (c >> 5), rr = r & 15, cc = c & 31, ob = rr * 64 + cc * 2; return st * 1024 + (ob ^ (((ob >> 9) & 1) << 5)); }
__host__ __device__ __forceinline__ void stage_rc(int b, int& R, int& C) { const int st = b / 1024, sb = b % 1024, swz = sb ^ (((sb >> 9) & 1) << 5); R = (st >> 1) * 16 + swz / 64; C = (st & 1) * 32 + (swz % 64) / 2; }
__host__ __device__ __forceinline__ int perm32(int rho) { const int n = rho >> 4, i = rho & 15; return 8 * (i >> 2) + 4 * n + (i & 3); }

struct Unit { int pm, pn; size_t aoff, boff; };
struct Gemm { const bf16_t* A; const bf16_t* Bt; int lda, ldb, K; };

struct TileOrder {
    int nM, nN, nwg, G, c;
    __host__ __device__ void init(int nM_, int nN_, int G_, int c_) { nM = nM_; nN = nN_; nwg = nM * nN; G = G_; c = c_; }
    __host__ __device__ bool tile(int i, int& pm, int& pn) const {
        const long L = (long)i * G + c; if (L >= nwg) return false;
        int wgid = (int)L; { const int q = nwg / NXCD, r = nwg % NXCD, xcd = wgid % NXCD, off = wgid / NXCD; wgid = (xcd < r ? xcd * (q + 1) : r * (q + 1) + (xcd - r) * q) + off; }
        const int nig = WGM * nN, gid = wgid / nig, fm = gid * WGM, gsz = (nM - fm) < WGM ? (nM - fm) : WGM;
        pm = fm + ((wgid % nig) % gsz); pn = (wgid % nig) / gsz; return true;
    }
};
struct SchedPlain {
    TileOrder T; size_t atile, btile;
    __device__ __forceinline__ bool next(int i, Unit& u) const { if (!T.tile(i, u.pm, u.pn)) return false; u.aoff = (size_t)u.pm * atile; u.boff = (size_t)u.pn * btile; return true; }
    __device__ __forceinline__ void a_ready(const Unit&) const {}
    __device__ __forceinline__ void done(const Unit&) const {}
};
struct SchedKSplit {
    int G, c, nM, KS, pn0; size_t atile, btile, kbytes;
    __device__ __forceinline__ bool next(int i, Unit& u) const { const int L = i * G + c; if (L >= nM * KS) return false; const int kc = L / nM; u.pm = L - kc * nM; u.pn = pn0 + kc;
        u.aoff = (size_t)u.pm * atile + (size_t)kc * kbytes; u.boff = (size_t)pn0 * btile + (size_t)kc * kbytes; return true; }
    __device__ __forceinline__ void a_ready(const Unit&) const {}
    __device__ __forceinline__ void done(const Unit&) const {}
};
struct SchedMoeSplit {
    int G, c, pm0, ntl, nN, KS; const LAS int* tile_e; size_t atile, btile, kbytes;
    __device__ __forceinline__ bool next(int i, Unit& u) const { const int L = i * G + c; if (L >= ntl * KS) return false; const int kc = L / ntl, t = L - kc * ntl, pn = t % nN; u.pm = pm0 + t / nN; u.pn = pn + nN * kc;
        const int e = tile_e[u.pm] & 7; u.aoff = (size_t)u.pm * atile + (size_t)kc * kbytes; u.boff = ((size_t)e * nN + pn) * btile + (size_t)kc * kbytes; return true; }
    __device__ __forceinline__ void a_ready(const Unit&) const {}
    __device__ __forceinline__ void done(const Unit&) const {}
};
struct SchedGate {
    TileOrder T;
    __device__ __forceinline__ bool next(int i, Unit& u) const { if (!T.tile(i, u.pm, u.pn)) return false; u.aoff = (size_t)u.pm * 256 * D * 2 + (size_t)(u.pn >> 1) * 512; u.boff = (size_t)u.pn * 256 * 256 * 2; return true; }
    __device__ __forceinline__ void a_ready(const Unit&) const {}
    __device__ __forceinline__ void done(const Unit&) const {}
};
struct SchedMoe {
    TileOrder T; const LAS int* tile_e; size_t atile, btile; int nN;
    __device__ __forceinline__ bool next(int i, Unit& u) const { if (!T.tile(i, u.pm, u.pn)) return false; const int e = tile_e[u.pm] & 7; u.aoff = (size_t)u.pm * atile; u.boff = ((size_t)e * nN + u.pn) * btile; return true; }
    __device__ __forceinline__ void a_ready(const Unit&) const {}
    __device__ __forceinline__ void done(const Unit&) const {}
};

typedef f32x4 Acc[2][2][4][2];
struct EpiBf16 {
    static constexpr bool PERM = true;
    bf16_t* O; int ldc; float scale;
    __device__ __forceinline__ void operator()(const Acc& acc, const Unit& u, int wr, int wc, int fr, int fq) const {
        const int row0 = u.pm * BM + wr * 64 + fr, col0 = u.pn * BM + wc * 32 + 8 * fq;
#pragma unroll
        for (int ai = 0; ai < 2; ++ai)
#pragma unroll
            for (int m = 0; m < 4; ++m) { bf16_t* rowp = O + (size_t)(row0 + ai * HALF + m * 16) * ldc + col0;
#pragma unroll
                for (int bj = 0; bj < 2; ++bj) { const f32x4 v0 = acc[ai][bj][m][0] * scale, v1 = acc[ai][bj][m][1] * scale;
                    u32x4 w; w.x = cvtpk(v0[0], v0[1]); w.y = cvtpk(v0[2], v0[3]); w.z = cvtpk(v1[0], v1[1]); w.w = cvtpk(v1[2], v1[3]);
                    *(u32x4*)(rowp + bj * HALF) = w; } }
    }
};
struct EpiFp8 {
    static constexpr bool PERM = true;
    unsigned char* O; int ldc; float scale;
    __device__ __forceinline__ void operator()(const Acc& acc, const Unit& u, int wr, int wc, int fr, int fq) const {
        const int row0 = u.pm * BM + wr * 64 + fr, col0 = u.pn * BM + wc * 32 + 8 * fq;
#pragma unroll
        for (int ai = 0; ai < 2; ++ai)
#pragma unroll
            for (int m = 0; m < 4; ++m) { unsigned char* rowp = O + (size_t)(row0 + ai * HALF + m * 16) * ldc + col0;
#pragma unroll
                for (int bj = 0; bj < 2; ++bj) { const f32x4 v0 = acc[ai][bj][m][0] * scale, v1 = acc[ai][bj][m][1] * scale;
                    u32x2 w; w.x = pk4_fp8(v0[0], v0[1], v0[2], v0[3]); w.y = pk4_fp8(v1[0], v1[1], v1[2], v1[3]);
                    *(u32x2*)(rowp + bj * HALF) = w; } }
    }
};
struct EpiBf16Split {
    static constexpr bool PERM = true;
    bf16_t* O; int ldc; float scale; size_t kstride;
    __device__ __forceinline__ void operator()(const Acc& acc, const Unit& u, int wr, int wc, int fr, int fq) const {
        const int row0 = u.pm * BM + wr * 64 + fr, col0 = (u.pn & 7) * BM + wc * 32 + 8 * fq;
        bf16_t* Ob = O + (size_t)(u.pn >> 3) * kstride;
#pragma unroll
        for (int ai = 0; ai < 2; ++ai)
#pragma unroll
            for (int m = 0; m < 4; ++m) { bf16_t* rowp = Ob + (size_t)(row0 + ai * HALF + m * 16) * ldc + col0;
#pragma unroll
                for (int bj = 0; bj < 2; ++bj) { const f32x4 v0 = acc[ai][bj][m][0] * scale, v1 = acc[ai][bj][m][1] * scale;
                    u32x4 w; w.x = cvtpk(v0[0], v0[1]); w.y = cvtpk(v0[2], v0[3]); w.z = cvtpk(v1[0], v1[1]); w.w = cvtpk(v1[2], v1[3]);
                    *(u32x4*)(rowp + bj * HALF) = w; } }
    }
};
struct EpiKpe {
    static constexpr bool PERM = false;
    float* O; int pn0; float scale;
    __device__ __forceinline__ void operator()(const Acc& acc, const Unit& u, int wr, int wc, int fr, int fq) const {
        if (wc >= 2) return;
        const int kc = u.pn - pn0, row0 = u.pm * BM + wr * 64 + fr, col0 = wc * 32 + 4 * fq;
#pragma unroll
        for (int ai = 0; ai < 2; ++ai)
#pragma unroll
            for (int m = 0; m < 4; ++m) { float* rowp = O + ((size_t)kc * M + row0 + ai * HALF + m * 16) * 64 + col0;
#pragma unroll
                for (int n = 0; n < 2; ++n) *(f32x4*)(rowp + n * 16) = acc[ai][0][m][n] * scale; }
    }
};
struct EpiF32 {
    static constexpr bool PERM = false;
    float* O; int ldc; float scale;
    __device__ __forceinline__ void operator()(const Acc& acc, const Unit& u, int wr, int wc, int fr, int fq) const {
        const int row0 = u.pm * BM + wr * 64 + fr, col0 = u.pn * BM + wc * 32 + 4 * fq;
#pragma unroll
        for (int ai = 0; ai < 2; ++ai)
#pragma unroll
            for (int m = 0; m < 4; ++m) { float* rowp = O + (size_t)(row0 + ai * HALF + m * 16) * ldc + col0;
#pragma unroll
                for (int bj = 0; bj < 2; ++bj)
#pragma unroll
                    for (int n = 0; n < 2; ++n) *(f32x4*)(rowp + bj * HALF + n * 16) = acc[ai][bj][m][n] * scale; }
    }
};
struct EpiResidual {
    static constexpr bool PERM = false;
    const float* res; float* out; int ldc; float scale;
    __device__ __forceinline__ void operator()(const Acc& acc, const Unit& u, int wr, int wc, int fr, int fq) const {
        const int row0 = u.pm * BM + wr * 64 + fr, col0 = u.pn * BM + wc * 32 + 4 * fq;
        f32x4 ra[2][2][2], rb[2][2][2];
#define ER_LOAD(R, ai, mp) do { _Pragma("unroll") for (int m2 = 0; m2 < 2; ++m2) { const size_t off = (size_t)(row0 + (ai) * HALF + ((mp) * 2 + m2) * 16) * ldc + col0; \
            _Pragma("unroll") for (int bj = 0; bj < 2; ++bj) _Pragma("unroll") for (int n = 0; n < 2; ++n) R[m2][bj][n] = *(const f32x4*)(res + off + bj * HALF + n * 16); } } while (0)
#define ER_STORE(R, ai, mp) do { _Pragma("unroll") for (int m2 = 0; m2 < 2; ++m2) { const size_t off = (size_t)(row0 + (ai) * HALF + ((mp) * 2 + m2) * 16) * ldc + col0; \
            _Pragma("unroll") for (int bj = 0; bj < 2; ++bj) _Pragma("unroll") for (int n = 0; n < 2; ++n) *(f32x4*)(out + off + bj * HALF + n * 16) = R[m2][bj][n] + acc[ai][bj][(mp) * 2 + m2][n] * scale; } } while (0)
        ER_LOAD(ra, 0, 0);
        ER_LOAD(rb, 0, 1); ER_STORE(ra, 0, 0);
        ER_LOAD(ra, 1, 0); ER_STORE(rb, 0, 1);
        ER_LOAD(rb, 1, 1); ER_STORE(ra, 1, 0);
        ER_STORE(rb, 1, 1);
#undef ER_LOAD
#undef ER_STORE
    }
};
template <int FP8OUT>
struct EpiSwiglu {
    static constexpr bool PERM = true;
    void* H; int ldc; float in_scale, out_scale;
    __device__ __forceinline__ void operator()(const Acc& acc, const Unit& u, int wr, int wc, int fr, int fq) const {
        const int row0 = u.pm * BM + wr * 64 + fr, col0 = u.pn * HALF + wc * 32 + 8 * fq;
        const float k_ = in_scale * in_scale * out_scale, c1 = -in_scale * 1.4426950408889634f, c0 = -__builtin_log2f(k_), c3 = 1.0f / k_;
#pragma unroll
        for (int ai = 0; ai < 2; ++ai)
#pragma unroll
            for (int m = 0; m < 4; ++m) { const size_t off = (size_t)(row0 + ai * HALF + m * 16) * ldc + col0;
                float h[8];
#pragma unroll
                for (int n = 0; n < 2; ++n)
#pragma unroll
                    for (int e = 0; e < 4; ++e) { const float a0 = acc[ai][0][m][n][e], a1 = acc[ai][1][m][n][e];
                        h[n * 4 + e] = (a0 * a1) * __builtin_amdgcn_rcpf(c3 + __builtin_amdgcn_exp2f(fmaf(a0, c1, c0))); }
                if constexpr (FP8OUT == 2) { u32x2 w; w.x = pk4_i8(h[0], h[1], h[2], h[3]); w.y = pk4_i8(h[4], h[5], h[6], h[7]); *(u32x2*)((unsigned char*)H + off) = w; }
                else if constexpr (FP8OUT == 1) { u32x2 w; w.x = pk4_fp8(h[0], h[1], h[2], h[3]); w.y = pk4_fp8(h[4], h[5], h[6], h[7]); *(u32x2*)((unsigned char*)H + off) = w; }
                else { u32x4 w; w.x = cvtpk(h[0], h[1]); w.y = cvtpk(h[2], h[3]); w.z = cvtpk(h[4], h[5]); w.w = cvtpk(h[6], h[7]); *(u32x4*)((bf16_t*)H + off) = w; } }
    }
};
struct EpiGate {
    static constexpr bool PERM = true;
    const bf16_t* XC; const float* b_a; const float* b_x; const float* csp; unsigned* AB;
    __device__ __forceinline__ void operator()(const Acc& acc, const Unit& u, int wr, int wc, int fr, int fq) const {
        const int row0 = u.pm * BM + wr * 64 + fr, c0 = u.pn * HALF + wc * 32 + 8 * fq;
#pragma unroll
        for (int n = 0; n < 2; ++n) {
            const f32x4 ba = *(const f32x4*)(b_a + c0 + 4 * n) * -1.4426950408889634f, bx = *(const f32x4*)(b_x + c0 + 4 * n) * -1.4426950408889634f, sp = *(const f32x4*)(csp + c0 + 4 * n);
            u32x2 xws[2][4];
#pragma unroll
            for (int ai = 0; ai < 2; ++ai)
#pragma unroll
                for (int m = 0; m < 4; ++m) xws[ai][m] = *(const u32x2*)(XC + (size_t)(row0 + ai * HALF + m * 16) * D + c0 + 4 * n);
#pragma unroll
            for (int ai = 0; ai < 2; ++ai)
#pragma unroll
                for (int m = 0; m < 4; ++m) { const size_t off = (size_t)(row0 + ai * HALF + m * 16) * D + c0 + 4 * n;
                    const u32x2 xw = xws[ai][m];
                    const float xc[4] = {bflo(xw.x), bfhi(xw.x), bflo(xw.y), bfhi(xw.y)};
                    u32x4 pk;
#pragma unroll
                    for (int e = 0; e < 4; ++e) {
                        const float r = __builtin_amdgcn_rcpf(1.0f + __builtin_amdgcn_exp2f(fmaf(acc[ai][0][m][n][e], -1.4426950408889634f, ba[e]))), ig = __builtin_amdgcn_rcpf(1.0f + __builtin_amdgcn_exp2f(fmaf(acc[ai][1][m][n][e], -1.4426950408889634f, bx[e])));
                        const float la2 = -sp[e] * r;
                        const float om = fmaxf(1.0f - __builtin_amdgcn_exp2f(la2 + la2), 0.0f);
                        pk[e] = cvtpk(la2, __builtin_amdgcn_sqrtf(om) * ig * xc[e]); }
                    *(u32x4*)(AB + off) = pk; }
        }
    }
};

template <class Epi, class Sched>
__device__ __forceinline__ void gemm_phase(LAS unsigned char* lds, const Gemm g, const Sched& S, const Epi& E) {
    const int tid = opaque_tid(), wid = __builtin_amdgcn_readfirstlane(tid >> 6), lane = tid & 63, wr = wid >> 2, wc = wid & 3, fr = lane & 15, fq = lane >> 4;
    const int K = g.K, nt = K / BK;
    unsigned voffA[2], voffB[2];
#pragma unroll
    for (int i = 0; i < 2; ++i) { int R, C; stage_rc(tid * 16 + i * 8192, R, C); const int Rb = Epi::PERM ? ((R & ~31) + perm32(R & 31)) : R;
        voffA[i] = (unsigned)(R * g.lda + C) * 2u; voffB[i] = (unsigned)(Rb * g.ldb + C) * 2u; }
    const size_t kstep = (size_t)(BK * 2);
    const size_t hstepA = (size_t)HALF * g.lda * 2, hstepB = (size_t)HALF * g.ldb * 2;
    const unsigned ldsw = (unsigned)wid * 1024u;
    const int aoff = lds_byte(wr * 64 + fr, fq * 8), boff = lds_byte(wc * 32 + fr, fq * 8);
#define PG8_SA(b, h) (((b) * 2 + (h)) * HTB)
#define PG8_SB(b, h) ((4 + (b) * 2 + (h)) * HTB)
#define PG8_STAGE(bufoff, gbase, voff) do { _Pragma("unroll") for (int _i = 0; _i < 2; ++_i) \
        __builtin_amdgcn_global_load_lds((const unsigned*)((const char*)(gbase) + (voff)[_i]), (LAS unsigned*)(lds + (bufoff) + ldsw + _i * 8192), 16, 0, 0); } while (0)
#define PG8_LDA(dst, b, h) do { _Pragma("unroll") for (int m = 0; m < 4; ++m) _Pragma("unroll") for (int k = 0; k < 2; ++k) dst[m][k] = *(const LAS bf16x8*)(lds + PG8_SA(b, h) + aoff + m * 2048 + k * 1024); } while (0)
#define PG8_LDB(dst, b, h) do { _Pragma("unroll") for (int n = 0; n < 2; ++n) _Pragma("unroll") for (int k = 0; k < 2; ++k) dst[n][k] = *(const LAS bf16x8*)(lds + PG8_SB(b, h) + boff + n * 2048 + k * 1024); } while (0)
#define PG8_MMA(ai, bj, At, Bt) do { __builtin_amdgcn_s_setprio(1); _Pragma("unroll") for (int m = 0; m < 4; ++m) _Pragma("unroll") for (int n = 0; n < 2; ++n) _Pragma("unroll") for (int k = 0; k < 2; ++k) \
        acc[ai][bj][m][n] = __builtin_amdgcn_mfma_f32_16x16x32_bf16(Bt[n][k], At[m][k], acc[ai][bj][m][n], 0, 0, 0); __builtin_amdgcn_s_setprio(0); } while (0)
#define PG8_WAIT_V(n) asm volatile("s_waitcnt vmcnt(" #n ")" ::: "memory")
#define PG8_WAIT_L(n) asm volatile("s_waitcnt lgkmcnt(" #n ")" ::: "memory")
#define PG8_BAR __builtin_amdgcn_s_barrier()
#define PG8_SCHED __builtin_amdgcn_sched_barrier(0)
    Unit cur, nxt; int ui = 0;
    if (!S.next(0, cur)) return;
    Acc acc;
#pragma unroll
    for (int a = 0; a < 2; ++a)
#pragma unroll
        for (int b = 0; b < 2; ++b)
#pragma unroll
            for (int m = 0; m < 4; ++m)
#pragma unroll
                for (int n = 0; n < 2; ++n) acc[a][b][m][n] = (f32x4){0.f, 0.f, 0.f, 0.f};
    bf16x8 At[4][2], B0[2][2], B1[2][2];
    const char* cA = (const char*)g.A + cur.aoff; const char* cB = (const char*)g.Bt + cur.boff;
    S.a_ready(cur);
    PG8_STAGE(PG8_SB(0, 0), cB, voffB); PG8_STAGE(PG8_SB(0, 1), cB + hstepB, voffB); PG8_STAGE(PG8_SA(0, 0), cA, voffA); PG8_STAGE(PG8_SA(0, 1), cA + hstepA, voffA);
    if (wr == 1) PG8_BAR;
    PG8_WAIT_V(2); PG8_BAR;
    PG8_STAGE(PG8_SB(1, 0), cB + kstep, voffB); PG8_STAGE(PG8_SA(1, 0), cA + kstep, voffA); PG8_STAGE(PG8_SB(1, 1), cB + hstepB + kstep, voffB);
    PG8_WAIT_V(6); PG8_BAR;
    for (;;) {
        const bool has_next = S.next(ui + 1, nxt);
        const char* nA = has_next ? (const char*)g.A + nxt.aoff : cA; const char* nB = has_next ? (const char*)g.Bt + nxt.boff : cB;
#pragma nounroll
        for (int t = 0; t < nt; t += 2) {
            const bool last = (t == nt - 2);
            const char* a1 = cA + (size_t)(t + 1) * kstep;
            const char* a2 = last ? nA : cA + (size_t)(t + 2) * kstep; const char* b2 = last ? nB : cB + (size_t)(t + 2) * kstep;
            const char* a3 = a2 + kstep; const char* b3 = b2 + kstep;
            if (last && has_next) S.a_ready(nxt);
            PG8_LDB(B0, 0, 0); PG8_LDB(B1, 0, 1); PG8_SCHED; PG8_LDA(At, 0, 0); PG8_STAGE(PG8_SA(1, 1), a1 + hstepA, voffA);
            PG8_WAIT_V(8); PG8_WAIT_L(0); PG8_BAR; PG8_MMA(0, 0, At, B0); PG8_MMA(0, 1, At, B1); PG8_BAR; PG8_SCHED;
            PG8_LDA(At, 0, 1); PG8_STAGE(PG8_SB(0, 0), b2, voffB); PG8_STAGE(PG8_SB(0, 1), b2 + hstepB, voffB); PG8_STAGE(PG8_SA(0, 0), a2, voffA);
            PG8_WAIT_V(8); PG8_WAIT_L(0); PG8_BAR; PG8_MMA(1, 0, At, B0); PG8_MMA(1, 1, At, B1); PG8_BAR; PG8_SCHED;
            PG8_LDB(B0, 1, 0); PG8_LDB(B1, 1, 1); PG8_SCHED; PG8_LDA(At, 1, 0); PG8_STAGE(PG8_SA(0, 1), a2 + hstepA, voffA);
            PG8_WAIT_V(8); PG8_WAIT_L(0); PG8_BAR; PG8_MMA(0, 0, At, B0); PG8_MMA(0, 1, At, B1); PG8_BAR; PG8_SCHED;
            PG8_LDA(At, 1, 1); PG8_STAGE(PG8_SB(1, 0), b3, voffB); PG8_STAGE(PG8_SB(1, 1), b3 + hstepB, voffB); PG8_STAGE(PG8_SA(1, 0), a3, voffA);
            PG8_WAIT_V(8); PG8_WAIT_L(0); PG8_BAR; PG8_MMA(1, 0, At, B0); PG8_MMA(1, 1, At, B1); PG8_BAR; PG8_SCHED;
        }
        if (wr == 0) PG8_BAR;
        E(acc, cur, wr, wc, fr, fq); S.done(cur);
        if (!has_next) break;
#pragma unroll
        for (int a = 0; a < 2; ++a)
#pragma unroll
            for (int b = 0; b < 2; ++b)
#pragma unroll
                for (int m = 0; m < 4; ++m)
#pragma unroll
                    for (int n = 0; n < 2; ++n) acc[a][b][m][n] = (f32x4){0.f, 0.f, 0.f, 0.f};
        cur = nxt; cA = nA; cB = nB; ++ui;
        if (wr == 1) PG8_BAR;
    }
    PG8_WAIT_V(0);
    PG8_BAR;
#undef PG8_SA
#undef PG8_SB
#undef PG8_STAGE
#undef PG8_LDA
#undef PG8_LDB
#undef PG8_MMA
#undef PG8_WAIT_V
#undef PG8_WAIT_L
#undef PG8_BAR
#undef PG8_SCHED
}

__host__ __device__ __forceinline__ int g8(int rr) { const int q = rr >> 1; return ((2 * q) & 7) | (q >> 2); }
__host__ __device__ __forceinline__ void stage_rc8(int b, int& R, int& Cb) { const int s = b >> 11, rr = (b >> 7) & 15, p = (b >> 4) & 7; R = s * 16 + rr; Cb = (p ^ g8(rr)) << 4; }
__host__ __device__ __forceinline__ int lds_byte8(int r, int c) { const int rr = r & 15; return (r >> 4) * 2048 + rr * 128 + ((c ^ g8(rr)) << 4); }
template <bool FP6> struct Frag8 { typedef v8i T; };
template <> struct Frag8<true> { typedef v6i T; };
template <class Epi, class Sched, int MODE = 0>
__device__ __forceinline__ void gemm_phase8(LAS unsigned char* lds, const Gemm g, const Sched& S, const Epi& E) {
    constexpr bool FP6 = (MODE == 1);
    const int tid = opaque_tid(), wid = __builtin_amdgcn_readfirstlane(tid >> 6), lane = tid & 63, wr = wid >> 2, wc = wid & 3, fr = lane & 15, fq = lane >> 4;
    const int K = g.K, nt = K / 128;
    unsigned voffA[2], voffB[2];
#pragma unroll
    for (int i = 0; i < 2; ++i) { int R, C; stage_rc8(tid * 16 + i * 8192, R, C); const int Rb = Epi::PERM ? ((R & ~31) + perm32(R & 31)) : R;
        voffA[i] = (unsigned)(R * g.lda + C); voffB[i] = (unsigned)(Rb * g.ldb + C); }
    const size_t kstep = 128;
    const size_t hstepA = (size_t)HALF * g.lda, hstepB = (size_t)HALF * g.ldb;
    const unsigned ldsw = (unsigned)wid * 1024u;
    const int aoff0 = lds_byte8(wr * 64 + fr, 2 * fq), aoff1 = lds_byte8(wr * 64 + fr, 2 * fq + 1), boff0 = lds_byte8(wc * 32 + fr, 2 * fq), boff1 = lds_byte8(wc * 32 + fr, 2 * fq + 1);
#define PG8_SA(b, h) (((b) * 2 + (h)) * HTB)
#define PG8_SB(b, h) ((4 + (b) * 2 + (h)) * HTB)
#define PG8_STAGE(bufoff, gbase, voff) do { _Pragma("unroll") for (int _i = 0; _i < 2; ++_i) \
        __builtin_amdgcn_global_load_lds((const unsigned*)((const char*)(gbase) + (voff)[_i]), (LAS unsigned*)(lds + (bufoff) + ldsw + _i * 8192), 16, 0, 0); } while (0)
#define PG8_LD1(dst, off0, off1) do { const v4i lo_ = *(const LAS v4i*)(lds + (off0)); \
        if constexpr (FP6) { const v2i hi_ = *(const LAS v2i*)(lds + (off1)); dst = (v6i){lo_[0], lo_[1], lo_[2], lo_[3], hi_[0], hi_[1]}; } \
        else { const v4i hi_ = *(const LAS v4i*)(lds + (off1)); dst = __builtin_shufflevector(lo_, hi_, 0, 1, 2, 3, 4, 5, 6, 7); } } while (0)
#define PG8_LDA(dst, b, h) do { _Pragma("unroll") for (int m = 0; m < 4; ++m) PG8_LD1(dst[m], PG8_SA(b, h) + aoff0 + m * 2048, PG8_SA(b, h) + aoff1 + m * 2048); } while (0)
#define PG8_LDB(dst, b, h) do { _Pragma("unroll") for (int n = 0; n < 2; ++n) PG8_LD1(dst[n], PG8_SB(b, h) + boff0 + n * 2048, PG8_SB(b, h) + boff1 + n * 2048); } while (0)
#define PG8_MMA(ai, bj, At, Bt) do { __builtin_amdgcn_s_setprio(1); \
        if constexpr (MODE == 2) { \
            _Pragma("unroll") for (int m = 0; m < 4; ++m) _Pragma("unroll") for (int n = 0; n < 2; ++n) { const v4i bl_ = __builtin_shufflevector(Bt[n], Bt[n], 0, 1, 2, 3), al_ = __builtin_shufflevector(At[m], At[m], 0, 1, 2, 3); \
                asm volatile("v_mfma_i32_16x16x64_i8 %0, %1, %2, %0" : "+v"(acc[ai][bj][m][n]) : "v"(bl_), "v"(al_)); } \
            _Pragma("unroll") for (int m = 0; m < 4; ++m) _Pragma("unroll") for (int n = 0; n < 2; ++n) { const v4i bh_ = __builtin_shufflevector(Bt[n], Bt[n], 4, 5, 6, 7), ah_ = __builtin_shufflevector(At[m], At[m], 4, 5, 6, 7); \
                asm volatile("v_mfma_i32_16x16x64_i8 %0, %1, %2, %0" : "+v"(acc[ai][bj][m][n]) : "v"(bh_), "v"(ah_)); } \
        } else { _Pragma("unroll") for (int m = 0; m < 4; ++m) _Pragma("unroll") for (int n = 0; n < 2; ++n) \
        { if constexpr (MODE == 1) asm volatile("v_mfma_f32_16x16x128_f8f6f4 %0, %1, %2, %0 cbsz:2 blgp:2" : "+v"(acc[ai][bj][m][n]) : "v"(Bt[n]), "v"(At[m])); \
          else asm volatile("v_mfma_f32_16x16x128_f8f6f4 %0, %1, %2, %0" : "+v"(acc[ai][bj][m][n]) : "v"(Bt[n]), "v"(At[m])); } } __builtin_amdgcn_s_setprio(0); } while (0)
#define PG8_WAIT_V(n) asm volatile("s_waitcnt vmcnt(" #n ")" ::: "memory")
#define PG8_WAIT_L(n) asm volatile("s_waitcnt lgkmcnt(" #n ")" ::: "memory")
#define PG8_BAR __builtin_amdgcn_s_barrier()
#define PG8_SCHED __builtin_amdgcn_sched_barrier(0)
    Unit cur, nxt; int ui = 0;
    if (!S.next(0, cur)) return;
    Acc acc;
#pragma unroll
    for (int a = 0; a < 2; ++a)
#pragma unroll
        for (int b = 0; b < 2; ++b)
#pragma unroll
            for (int m = 0; m < 4; ++m)
#pragma unroll
                for (int n = 0; n < 2; ++n) acc[a][b][m][n] = (f32x4){0.f, 0.f, 0.f, 0.f};
    typename Frag8<FP6>::T At[4], B0[2], B1[2];
    const char* cA = (const char*)g.A + cur.aoff; const char* cB = (const char*)g.Bt + cur.boff;
    S.a_ready(cur);
    PG8_STAGE(PG8_SB(0, 0), cB, voffB); PG8_STAGE(PG8_SB(0, 1), cB + hstepB, voffB); PG8_STAGE(PG8_SA(0, 0), cA, voffA); PG8_STAGE(PG8_SA(0, 1), cA + hstepA, voffA);
    if (wr == 1) PG8_BAR;
    PG8_WAIT_V(2); PG8_BAR;
    PG8_STAGE(PG8_SB(1, 0), cB + kstep, voffB); PG8_STAGE(PG8_SA(1, 0), cA + kstep, voffA); PG8_STAGE(PG8_SB(1, 1), cB + hstepB + kstep, voffB);
    PG8_WAIT_V(6); PG8_BAR;
    for (;;) {
        const bool has_next = S.next(ui + 1, nxt);
        const char* nA = has_next ? (const char*)g.A + nxt.aoff : cA; const char* nB = has_next ? (const char*)g.Bt + nxt.boff : cB;
#pragma nounroll
        for (int t = 0; t < nt; t += 2) {
            const bool last = (t == nt - 2);
            const char* a1 = cA + (size_t)(t + 1) * kstep;
            const char* a2 = last ? nA : cA + (size_t)(t + 2) * kstep; const char* b2 = last ? nB : cB + (size_t)(t + 2) * kstep;
            const char* a3 = a2 + kstep; const char* b3 = b2 + kstep;
            if (last && has_next) S.a_ready(nxt);
            PG8_LDB(B0, 0, 0); PG8_LDB(B1, 0, 1); PG8_SCHED; PG8_LDA(At, 0, 0); PG8_STAGE(PG8_SA(1, 1), a1 + hstepA, voffA);
            PG8_WAIT_V(8); PG8_WAIT_L(0); PG8_BAR; PG8_MMA(0, 0, At, B0); PG8_MMA(0, 1, At, B1); PG8_BAR; PG8_SCHED;
            PG8_LDA(At, 0, 1); PG8_STAGE(PG8_SB(0, 0), b2, voffB); PG8_STAGE(PG8_SB(0, 1), b2 + hstepB, voffB); PG8_STAGE(PG8_SA(0, 0), a2, voffA);
            PG8_WAIT_V(8); PG8_WAIT_L(0); PG8_BAR; PG8_MMA(1, 0, At, B0); PG8_MMA(1, 1, At, B1); PG8_BAR; PG8_SCHED;
            PG8_LDB(B0, 1, 0); PG8_LDB(B1, 1, 1); PG8_SCHED; PG8_LDA(At, 1, 0); PG8_STAGE(PG8_SA(0, 1), a2 + hstepA, voffA);
            PG8_WAIT_V(8); PG8_WAIT_L(0); PG8_BAR; PG8_MMA(0, 0, At, B0); PG8_MMA(0, 1, At, B1); PG8_BAR; PG8_SCHED;
            PG8_LDA(At, 1, 1); PG8_STAGE(PG8_SB(1, 0), b3, voffB); PG8_STAGE(PG8_SB(1, 1), b3 + hstepB, voffB); PG8_STAGE(PG8_SA(1, 0), a3, voffA);
            PG8_WAIT_V(8); PG8_WAIT_L(0); PG8_BAR; PG8_MMA(1, 0, At, B0); PG8_MMA(1, 1, At, B1); PG8_BAR; PG8_SCHED;
        }
        asm volatile("s_nop 15\n\ts_nop 15" ::: "memory");
        if (wr == 0) PG8_BAR;
        if constexpr (MODE == 2) {
#pragma unroll
            for (int a = 0; a < 2; ++a)
#pragma unroll
                for (int b = 0; b < 2; ++b)
#pragma unroll
                    for (int m = 0; m < 4; ++m)
#pragma unroll
                        for (int n = 0; n < 2; ++n)
                        { const f32x4 t_ = acc[a][b][m][n]; f32x4 r_;
                          r_.x = (float)__float_as_int(t_.x); r_.y = (float)__float_as_int(t_.y); r_.z = (float)__float_as_int(t_.z); r_.w = (float)__float_as_int(t_.w); acc[a][b][m][n] = r_; }
        }
        E(acc, cur, wr, wc, fr, fq); S.done(cur);
        if (!has_next) break;
#pragma unroll
        for (int a = 0; a < 2; ++a)
#pragma unroll
            for (int b = 0; b < 2; ++b)
#pragma unroll
                for (int m = 0; m < 4; ++m)
#pragma unroll
                    for (int n = 0; n < 2; ++n) acc[a][b][m][n] = (f32x4){0.f, 0.f, 0.f, 0.f};
        cur = nxt; cA = nA; cB = nB; ++ui;
        if (wr == 1) PG8_BAR;
    }
    PG8_WAIT_V(0);
    PG8_BAR;
#undef PG8_SA
#undef PG8_SB
#undef PG8_STAGE
#undef PG8_LDA
#undef PG8_LD1
#undef PG8_LDB
#undef PG8_MMA
#undef PG8_WAIT_V
#undef PG8_WAIT_L
#undef PG8_BAR
#undef PG8_SCHED
}
}

namespace att {
constexpr int KROW = 208, KBUF = 64 * KROW,     VROW = 80, VBUF = 128 * VROW,     VOFF = 2 * KBUF, LDS_TOTAL = VOFF + 3 * VBUF;
static_assert(LDS_TOTAL <= RING_BYTES, "attention LDS");
constexpr float THR = 4.5f, PSH = 4.f, QS8 = 16.f, OSC8 = 16.f;
__device__ __forceinline__ int crow(int r, int hi) { return (r & 3) + 8 * (r >> 2) + 4 * hi; }

constexpr int CV_KB = FF / 128, CV_NB = D / 16, CV_ITEMS = NE * CV_NB * CV_KB, CV_IPW = CV_ITEMS / (GRID * NWAVES);
static_assert(CV_ITEMS % (GRID * NWAVES) == 0 && CV_KB % CV_IPW == 0, "MoE-down conversion items per wave");
constexpr float CV_WS = 64.f;
struct CvtState { const float* W; unsigned char* WT; int next, end; };
__device__ __forceinline__ void cvt_load(const CvtState& cs, int lane, f32x4 (&v)[8]) {
    const int kb = cs.next % CV_KB, tmp = cs.next / CV_KB, nb = tmp % CV_NB, e = tmp / CV_NB;
    const float* src = cs.W + ((size_t)e * FF + (size_t)(128 * kb + 8 * (lane >> 2))) * D + 16 * nb + 4 * (lane & 3);
#pragma unroll
    for (int i = 0; i < 8; ++i) v[i] = *(const f32x4*)(src + (size_t)i * D);
}
__device__ __forceinline__ void cvt_store(CvtState& cs, int lane, const f32x4 (&v)[8]) {
    const int kb = cs.next % CV_KB, tmp = cs.next / CV_KB, nb = tmp % CV_NB, e = tmp / CV_NB;
    unsigned char* dst = cs.WT + ((size_t)e * D + (size_t)(16 * nb + 4 * (lane & 3))) * FF + 128 * kb + 8 * (lane >> 2);
#pragma unroll
    for (int j = 0; j < 4; ++j) { u32x2 w; w.x = pk4_fp8(v[0][j] * CV_WS, v[1][j] * CV_WS, v[2][j] * CV_WS, v[3][j] * CV_WS); w.y = pk4_fp8(v[4][j] * CV_WS, v[5][j] * CV_WS, v[6][j] * CV_WS, v[7][j] * CV_WS);
        *(u32x2*)(dst + (size_t)j * FF) = w; }
    ++cs.next;
}

__device__ __forceinline__ void attn_unit(LAS unsigned char* lds, const unsigned char* Q, const unsigned char* KV, const bf16_t* KPE, const float* CST, bf16_t* O, int b, int h, int qb, CvtState& cs) {
    const int tid = opaque_tid(), wid = __builtin_amdgcn_readfirstlane(tid >> 6), lane = tid & 63, r32 = lane & 31, hi = lane >> 5;
    const bool lag = wid >= 4;
    if (lag) __builtin_amdgcn_s_setprio(1);
    const size_t rowb = (size_t)b * SEQ;
    const int qlo = qb * 256 + wid * 32;
    v8i qf[3];
    const unsigned qo = (unsigned)((rowb + qlo + r32) * (NH * QKD) + h * QKD + hi * 32);
    { const v4i a0 = *(const v4i*)((const char*)Q + qo), a1 = *(const v4i*)((const char*)Q + qo + 16), b0 = *(const v4i*)((const char*)Q + qo + 64), b1 = *(const v4i*)((const char*)Q + qo + 80);
      qf[0] = __builtin_shufflevector(a0, a1, 0, 1, 2, 3, 4, 5, 6, 7); qf[1] = __builtin_shufflevector(b0, b1, 0, 1, 2, 3, 4, 5, 6, 7); }
    { const float* cst = CST + (size_t)(rowb + qlo + r32) * 64;
      const v4i t0 = *(const v4i*)((const char*)Q + qo + 128), t1 = *(const v4i*)((const char*)Q + qo + 144);
#pragma unroll
      for (int d = 0; d < 8; ++d) {
          const int own = (d < 4) ? t0[d & 3] : t1[d & 3];
          const auto rr = __builtin_amdgcn_permlane32_swap((unsigned)own, (unsigned)own, false, false); const int par = (int)(rr[0] ^ rr[1]) ^ own;
          const f32x4 c = *(const f32x4*)(cst + 4 * d); f32x4 sn = *(const f32x4*)(cst + 32 + 4 * d);
          if (hi == 0) sn = -sn;
          const float o0 = __builtin_amdgcn_cvt_f32_fp8(own, 0) * c[0] + __builtin_amdgcn_cvt_f32_fp8(par, 0) * sn[0], o1 = __builtin_amdgcn_cvt_f32_fp8(own, 1) * c[1] + __builtin_amdgcn_cvt_f32_fp8(par, 1) * sn[1];
          const float o2 = __builtin_amdgcn_cvt_f32_fp8(own, 2) * c[2] + __builtin_amdgcn_cvt_f32_fp8(par, 2) * sn[2], o3 = __builtin_amdgcn_cvt_f32_fp8(own, 3) * c[3] + __builtin_amdgcn_cvt_f32_fp8(par, 3) * sn[3];
          qf[2][d] = (int)pk4_fp8(o0, o1, o2, o3); } }
    const int NT = 4 * (qb + 1);
    const int sr = tid >> 4, sc = (tid & 15) * 8, pr = tid >> 3, pc = (tid & 7) * 8;
    const unsigned kvo = (unsigned)((rowb + sr) * 4096 + h * 256 + sc);
    const unsigned kpo = (unsigned)(((rowb + pr) * 64 + pc) * 2);
    const int kw0 = sr * KROW + sc, kw1 = (sr + 32) * KROW + sc, kwp = pr * KROW + 128 + pc;
    const int vkg = (wid & 3) * 4 + (lane >> 4), vdg = (wid >> 2) * 16 + (lane & 15);
    const unsigned kvv = (unsigned)((rowb + 4 * vkg) * 4096 + h * 256 + 128 + 4 * vdg);
    const int vw = VOFF + 4 * vdg * VROW + (vkg & 1) * 32 + (((vkg >> 3) * 4 + ((vkg & 7) >> 1)) * 4);
    u32x2 sk0, sk1; bf16x8 skp; unsigned sv0, sv1, sv2, sv3;
#define ATT_LOAD(t) do { const unsigned k1_ = kvo + (unsigned)(t) * (64u * 4096u), k2_ = kpo + (unsigned)(t) * (64u * 128u); const char* kvb_ = (const char*)KV; \
        const unsigned k3_ = kvv + (unsigned)(t) * (64u * 4096u); \
        sk0 = *(const u32x2*)(kvb_ + k1_); sk1 = *(const u32x2*)(kvb_ + k1_ + 32u * 4096u); skp = *(const bf16x8*)((const char*)KPE + k2_); \
        sv0 = *(const unsigned*)(kvb_ + k3_); sv1 = *(const unsigned*)(kvb_ + k3_ + 4096u); sv2 = *(const unsigned*)(kvb_ + k3_ + 2u * 4096u); sv3 = *(const unsigned*)(kvb_ + k3_ + 3u * 4096u); } while (0)
#define B8_(x_, y_) ({ const unsigned bx_ = (x_), by_ = (y_); __builtin_bit_cast(unsigned, __builtin_amdgcn_cvt_scalef32_pk_fp8_bf16(__builtin_amdgcn_cvt_scalef32_pk_fp8_bf16((v2s){0, 0}, __builtin_bit_cast(v2bf, bx_), 1.0f, false), __builtin_bit_cast(v2bf, by_), 1.0f, true)); })
#define K8_(S) ({ const u32x4 t_ = __builtin_bit_cast(u32x4, S); u32x2 w_; w_.x = B8_(t_.x, t_.y); w_.y = B8_(t_.z, t_.w); w_; })
#define VL_(a_, b_) __builtin_amdgcn_perm(b_, a_, 0x05040100u)
#define VH_(a_, b_) __builtin_amdgcn_perm(b_, a_, 0x07060302u)
#define V8_(a_, b_, c_, d_) ((unsigned)__builtin_amdgcn_cvt_pk_fp8_f32(c_, d_, __builtin_amdgcn_cvt_pk_fp8_f32(a_, b_, 0, false), true))
#define ATT_WRITE(kb, vb) do { LAS unsigned char* kb_ = lds + (kb) * KBUF; LAS unsigned char* vb_ = lds + (vb) * VBUF; *(LAS u32x2*)(kb_ + kw0) = sk0; *(LAS u32x2*)(kb_ + kw1) = sk1; *(LAS u32x2*)(kb_ + kwp) = K8_(skp); \
        const unsigned a_ = __builtin_amdgcn_perm(sv1, sv0, 0x05010400u), b_ = __builtin_amdgcn_perm(sv3, sv2, 0x05010400u), c_ = __builtin_amdgcn_perm(sv1, sv0, 0x07030602u), d_ = __builtin_amdgcn_perm(sv3, sv2, 0x07030602u); \
        *(LAS unsigned*)(vb_ + vw) = VL_(a_, b_); *(LAS unsigned*)(vb_ + vw + VROW) = VH_(a_, b_); *(LAS unsigned*)(vb_ + vw + 2 * VROW) = VL_(c_, d_); *(LAS unsigned*)(vb_ + vw + 3 * VROW) = VH_(c_, d_); } while (0)
    ATT_LOAD(0); ATT_WRITE(0, 0);
    __syncthreads();
    float m_reg = -1e30f, l_reg = 0.f;
    f32x16 o[4];
#pragma unroll
    for (int d = 0; d < 4; ++d)
#pragma unroll
        for (int r = 0; r < 16; ++r) o[d][r] = 0.f;
    const unsigned vrd = (unsigned)(uintptr_t)lds + (unsigned)(VOFF + r32 * VROW + hi * 32);
#define DSR(dst, addr, off) asm volatile("ds_read_b128 %0, %1 offset:%2" : "=v"(dst) : "v"(addr), "i"(off))
#define DSW4(n, a, b, c, d) asm volatile("s_waitcnt lgkmcnt(" #n ")" : "+v"(a), "+v"(b), "+v"(c), "+v"(d))
#define CAT8(a, b) __builtin_shufflevector(a, b, 0, 1, 2, 3, 4, 5, 6, 7)
#define MMA8(A, B, C) __builtin_amdgcn_mfma_scale_f32_32x32x64_f8f6f4(A, B, C, 0, 0, 0, 0, 0, 0)
    v8i pf = {0, 0, 0, 0, 0, 0, 0, 0};
    bool pend = false; int vs = 0;
    v4i va0, va1, va2, va3, va4, va5, va6, va7;
#define PV_READ(slot) do { const unsigned vb0 = vrd + (unsigned)((slot) * VBUF); DSR(va0, vb0, 0); DSR(va1, vb0, 16); DSR(va2, vb0, 32 * VROW); DSR(va3, vb0, 32 * VROW + 16); \
        DSR(va4, vb0, 64 * VROW); DSR(va5, vb0, 64 * VROW + 16); DSR(va6, vb0, 96 * VROW); DSR(va7, vb0, 96 * VROW + 16); } while (0)
#define PV_MMA() do { DSW4(4, va0, va1, va2, va3); o[0] = MMA8(CAT8(va0, va1), pf, o[0]); o[1] = MMA8(CAT8(va2, va3), pf, o[1]); \
        DSW4(0, va4, va5, va6, va7); o[2] = MMA8(CAT8(va4, va5), pf, o[2]); o[3] = MMA8(CAT8(va6, va7), pf, o[3]); } while (0)
    f32x4 cv[8]; bool cvt_pend = false;
    for (int t = 0; t < NT; ++t) {
        if (t + 1 < NT) ATT_LOAD(t + 1);
        if (cvt_pend) { cvt_store(cs, lane, cv); cvt_pend = false; }
        if (lag && pend) { PV_MMA(); pend = false; }
        const int kb0 = t * 64;
        const bool cvt_now = ((t & 3) == 0) && cs.next < cs.end;
        if (cvt_now && !(kb0 <= qlo + 31)) cvt_load(cs, lane, cv);
        if (kb0 <= qlo + 31) {
            const unsigned ka = (unsigned)(uintptr_t)lds + (unsigned)((t & 1) * KBUF + r32 * KROW + hi * 32);
            f32x16 p0, p1;
#pragma unroll
            for (int r = 0; r < 16; ++r) { p0[r] = 0.f; p1[r] = 0.f; }
            { v4i k0, k1, k2, k3, k4, k5, k6, k7, k8, k9, k10, k11;
              DSR(k0, ka, 0); DSR(k1, ka, 16); DSR(k2, ka, 32 * KROW); DSR(k3, ka, 32 * KROW + 16);
              DSR(k4, ka, 64); DSR(k5, ka, 80); DSR(k6, ka, 32 * KROW + 64); DSR(k7, ka, 32 * KROW + 80);
              DSR(k8, ka, 128); DSR(k9, ka, 144); DSR(k10, ka, 32 * KROW + 128); DSR(k11, ka, 32 * KROW + 144);
              DSW4(8, k0, k1, k2, k3);
              p0 = MMA8(CAT8(k0, k1), qf[0], p0); p1 = MMA8(CAT8(k2, k3), qf[0], p1);
              PV_READ(vs);
              DSW4(12, k4, k5, k6, k7);
              p0 = MMA8(CAT8(k4, k5), qf[1], p0); p1 = MMA8(CAT8(k6, k7), qf[1], p1);
              DSW4(8, k8, k9, k10, k11);
              p0 = MMA8(CAT8(k8, k9), qf[2], p0); p1 = MMA8(CAT8(k10, k11), qf[2], p1); }
            if (cvt_now) cvt_load(cs, lane, cv);
            if (kb0 + 63 > qlo) {
                const int dq = qlo + r32 - 4 * hi - kb0; const float NEG = -__builtin_inff();
#pragma unroll
                for (int r = 0; r < 16; ++r) { const int c = (r & 3) + 8 * (r >> 2); if (dq - c < 0) p0[r] = NEG; if (dq - c - 32 < 0) p1[r] = NEG; }
            }
            float pmax = p0[0];
#pragma unroll
            for (int r = 1; r < 16; ++r) pmax = fmaxf(pmax, p0[r]);
#pragma unroll
            for (int r = 0; r < 16; ++r) pmax = fmaxf(pmax, p1[r]);
            { auto rr = __builtin_amdgcn_permlane32_swap(__float_as_uint(pmax), __float_as_uint(pmax), false, false); pmax = fmaxf(__uint_as_float(rr[0]), __uint_as_float(rr[1])); }
            float mn, alpha;
            constexpr float QI8 = 1.0f / QS8;
            if (__all((pmax - m_reg) <= THR * QS8)) { mn = m_reg; alpha = 1.f; }
            else { mn = fmaxf(m_reg, pmax); alpha = __builtin_amdgcn_exp2f((m_reg - mn) * QI8); m_reg = mn; }
            const float mnq = PSH - mn * QI8;
            float ps = 0.f;
#pragma unroll
            for (int r = 0; r < 16; ++r) { p0[r] = __builtin_amdgcn_exp2f(fmaf(p0[r], QI8, mnq)); ps += p0[r]; }
#pragma unroll
            for (int r = 0; r < 16; ++r) { p1[r] = __builtin_amdgcn_exp2f(fmaf(p1[r], QI8, mnq)); ps += p1[r]; }
            { auto rr = __builtin_amdgcn_permlane32_swap(__float_as_uint(ps), __float_as_uint(ps), false, false); ps = __uint_as_float(rr[0]) + __uint_as_float(rr[1]); }
            l_reg = l_reg * alpha + ps;
            if (__any(alpha < 1.f)) {
#pragma unroll
                for (int d = 0; d < 4; ++d)
#pragma unroll
                    for (int r = 0; r < 16; ++r) o[d][r] *= alpha;
            }
#pragma unroll
            for (int i = 0; i < 4; ++i) { pf[i] = (int)V8_(p0[4 * i], p0[4 * i + 1], p0[4 * i + 2], p0[4 * i + 3]); pf[4 + i] = (int)V8_(p1[4 * i], p1[4 * i + 1], p1[4 * i + 2], p1[4 * i + 3]); }
            if (!lag) PV_MMA(); else pend = true;
        }
        if (cvt_now) cvt_pend = true;
        const int vn = (vs == 2) ? 0 : vs + 1;
        if (t + 1 < NT) ATT_WRITE((t + 1) & 1, vn);
        asm volatile("s_waitcnt lgkmcnt(0)" ::: "memory");
        __syncthreads();
        vs = vn;
    }
    if (lag && pend) PV_MMA();
    if (cvt_pend) cvt_store(cs, lane, cv);
    __builtin_amdgcn_s_setprio(0);
    __syncthreads();
#undef PV_READ
#undef PV_MMA
#undef DSR
#undef DSW4
#undef CAT8
#undef MMA8
#undef ATT_LOAD
#undef ATT_WRITE
#undef K8_
#undef V8_
#undef B8_
#undef VL_
#undef VH_
    { const float rl = __builtin_amdgcn_rcpf(l_reg) * OSC8;
      const unsigned oo = (unsigned)((rowb + qlo + r32) * D + h * VDIM + 4 * hi);
#pragma unroll
      for (int d0 = 0; d0 < 4; ++d0)
#pragma unroll
          for (int j = 0; j < 4; ++j)
              *(unsigned*)((char*)O + oo + (unsigned)(d0 * 32 + j * 8)) = pk4_fp8(o[d0][4 * j] * rl, o[d0][4 * j + 1] * rl, o[d0][4 * j + 2] * rl, o[d0][4 * j + 3] * rl); }
}
}

#define XB_TMO      128
#define XB_XCNT(j)  (256  + 64 * (j))
#define XB_XSUB(j)  (1280 + 64 * (j))
#define XB_XGEN(j)  (2304 + 64 * (j))
#define XB_TOP      3328
#define XB_TOPGEN   3392
#define XCD_BAR_WORDS 3456
#define XB_SPIN_CAP (1u << 18)
__device__ __forceinline__ unsigned xb_ld(unsigned* p)              { return __hip_atomic_load(p, __ATOMIC_RELAXED, __HIP_MEMORY_SCOPE_AGENT); }
__device__ __forceinline__ unsigned xb_add(unsigned* p, unsigned v) { return __hip_atomic_fetch_add(p, v, __ATOMIC_RELAXED, __HIP_MEMORY_SCOPE_AGENT); }
__device__ __forceinline__ unsigned xb_xcc_id() { return (unsigned)__builtin_amdgcn_s_getreg((3 << 11) | 20) & 0xFu; }
#define XB_SPIN(cond, bar) do { unsigned _sp = 0; while (cond) { __builtin_amdgcn_s_sleep(1); \
    if ((++_sp & 255u) == 0u) { if (xb_ld(&(bar)[XB_TMO])) break; if (_sp > XB_SPIN_CAP) { atomicAdd(&(bar)[XB_TMO], 1u); break; } } } } while (0)
struct XcdBarrier { unsigned* bar; unsigned x; volatile LAS unsigned* st; };
__device__ __forceinline__ XcdBarrier xcd_barrier_post(unsigned* bar, volatile LAS unsigned* st) {
    XcdBarrier b; b.bar = bar; b.x = xb_xcc_id(); b.st = st;
    if (threadIdx.x == 0) (void)xb_add(&bar[XB_XCNT(b.x)], 1u);
    return b;
}
__device__ __forceinline__ void xcd_barrier_complete(unsigned* bar, unsigned x, unsigned& nloc, unsigned& nx) {
    const unsigned G = gridDim.x * gridDim.y * gridDim.z;
    unsigned sum, cnt, mine, sp = 0u;
    for (;;) {
        sum = 0u; cnt = 0u; mine = 0u;
#pragma unroll
        for (unsigned j = 0; j < 16; ++j) { const unsigned c = xb_ld(&bar[XB_XCNT(j)]); sum += c; cnt += (c > 0u) ? 1u : 0u; mine = (j == x) ? c : mine; }
        if (sum == G) break;
        __builtin_amdgcn_s_sleep(1);
        if ((++sp & 255u) == 0u) { if (xb_ld(&bar[XB_TMO])) break; if (sp > XB_SPIN_CAP) { atomicAdd(&bar[XB_TMO], 1u); break; } }
    }
    nloc = mine > 0u ? mine : 1u; nx = cnt > 0u ? cnt : 1u;
}
__device__ __forceinline__ void xcd_barrier(const XcdBarrier& b) {
    asm volatile("s_waitcnt vmcnt(0)" ::: "memory");
    __syncthreads();
    if (threadIdx.x == 0) {
        unsigned* bar = b.bar;
        __builtin_amdgcn_s_waitcnt(0);
        unsigned nloc = b.st[0], nx = b.st[1];
        if (nloc == 0u) { xcd_barrier_complete(bar, b.x, nloc, nx); b.st[0] = nloc; b.st[1] = nx; }
        const unsigned old = xb_add(&bar[XB_XSUB(b.x)], 1u);
        const unsigned gen = old / nloc;
        if (old + 1u == (gen + 1u) * nloc) {
            __builtin_amdgcn_fence(__ATOMIC_RELEASE, "agent");
            asm volatile("s_waitcnt vmcnt(0)" ::: "memory");
            const unsigned og = xb_add(&bar[XB_TOP], 1u);
            const unsigned tg = og / nx;
            if (og + 1u == (tg + 1u) * nx) xb_add(&bar[XB_TOPGEN], 1u);
            else XB_SPIN(xb_ld(&bar[XB_TOPGEN]) == tg, bar);
            __builtin_amdgcn_fence(__ATOMIC_ACQUIRE, "agent");
            xb_add(&bar[XB_XGEN(b.x)], 1u);
            asm volatile("s_waitcnt vmcnt(0)" ::: "memory");
        } else {
            XB_SPIN(xb_ld(&bar[XB_XGEN(b.x)]) == gen, bar);
            __builtin_amdgcn_fence(__ATOMIC_ACQUIRE, "agent");
            asm volatile("s_waitcnt vmcnt(0)" ::: "memory");
        }
    }
    __syncthreads();
}

struct Args { const float* in[29]; const int* positions; float* out; unsigned char* ws; };
enum { I_X = 0, I_POS = 1, I_ANM = 2, I_RGWIN = 3, I_CONVW = 4, I_CONVB = 5, I_RGWA = 6, I_RGBA = 7, I_RGWX = 8, I_RGBX = 9, I_LAM = 10, I_RGWOUT = 11, I_ANF = 12, I_FFG = 13, I_FFU = 14, I_FFD = 15,
       I_BNM = 16, I_MLAWIN = 17, I_QNORM = 18, I_WQUP = 19, I_KVNORM = 20, I_WKVUP = 21, I_MLAWO = 22, I_BNF = 23, I_ROUTER = 24, I_MOEG = 25, I_MOEU = 26, I_MOED = 27, I_FNORM = 28 };

constexpr float WSC8 = 64.f, ASC8 = 8.f, HSC8 = 4.f; static_assert(WSC8 == att::CV_WS, "e4m3 weight scale");
__device__ __forceinline__ void tr_load(const float* W, int N, int k0, int n0, int lane, f32x4 (&v)[16]) {
    const float* src = W + (size_t)(k0 + 16 * (lane >> 4)) * N + n0 + 4 * (lane & 15);
#pragma unroll
    for (int i = 0; i < 16; ++i) v[i] = *(const f32x4*)(src + (size_t)i * N);
}
constexpr float WSI8 = 1400.f, ASI8 = 31.f, WSU8 = 700.f, WSD8 = 2600.f, HSI8 = 16.f;
template <int FP8>
__device__ __forceinline__ void tr_store(const f32x4 (&v)[16], void* WT, int K, int k0, int drow0, int lane, float wsc) {
    const int c = lane & 15, q = lane >> 4;
#pragma unroll
    for (int j = 0; j < 4; ++j) {
        const size_t eoff = (size_t)(drow0 + 4 * c + j) * K + k0 + 16 * q;
        if constexpr (FP8 == 2) { u32x4 o;
            o.x = pk4_i8(v[0][j] * wsc, v[1][j] * wsc, v[2][j] * wsc, v[3][j] * wsc); o.y = pk4_i8(v[4][j] * wsc, v[5][j] * wsc, v[6][j] * wsc, v[7][j] * wsc);
            o.z = pk4_i8(v[8][j] * wsc, v[9][j] * wsc, v[10][j] * wsc, v[11][j] * wsc); o.w = pk4_i8(v[12][j] * wsc, v[13][j] * wsc, v[14][j] * wsc, v[15][j] * wsc);
            *(u32x4*)((unsigned char*)WT + eoff) = o; }
        else if constexpr (FP8 == 1) { u32x4 o;
            o.x = pk4_fp8(v[0][j] * WSC8, v[1][j] * WSC8, v[2][j] * WSC8, v[3][j] * WSC8); o.y = pk4_fp8(v[4][j] * WSC8, v[5][j] * WSC8, v[6][j] * WSC8, v[7][j] * WSC8);
            o.z = pk4_fp8(v[8][j] * WSC8, v[9][j] * WSC8, v[10][j] * WSC8, v[11][j] * WSC8); o.w = pk4_fp8(v[12][j] * WSC8, v[13][j] * WSC8, v[14][j] * WSC8, v[15][j] * WSC8);
            *(u32x4*)((unsigned char*)WT + eoff) = o; }
        else { u32x4 o0, o1;
            o0.x = cvtpk(v[0][j], v[1][j]); o0.y = cvtpk(v[2][j], v[3][j]); o0.z = cvtpk(v[4][j], v[5][j]); o0.w = cvtpk(v[6][j], v[7][j]);
            o1.x = cvtpk(v[8][j], v[9][j]); o1.y = cvtpk(v[10][j], v[11][j]); o1.z = cvtpk(v[12][j], v[13][j]); o1.w = cvtpk(v[14][j], v[15][j]);
            *(u32x4*)((bf16_t*)WT + eoff) = o0; *(u32x4*)((bf16_t*)WT + eoff + 8) = o1; }
    }
}
template <int MODE, int FP8 = 0>
__device__ __forceinline__ void tr_matrix(const float* W, int nb, int K, int N, void* WT, int drows, int rot, int gw, int NGW, LAS float* scr, int lane, float wsc = 1.0f) {
    const int nbn = N / 64, per = (K / 128) * nbn, total = nb * per;
    int it = gw - rot; if (it < 0) it += NGW;
    if (it >= total) return;
    f32x4 va[16], vb[16];
    int e = it / per, r = it - e * per, kb = r / nbn, nbk = r - kb * nbn, n0 = nbk * 64, k0 = kb * 128;
    const float* Wp = W + (size_t)e * K * N; unsigned char* WTp = (unsigned char*)WT + (size_t)e * drows * K * (FP8 ? 1 : 2);
    tr_load(Wp, N, k0, n0, lane, va);
    for (;;) {
        tr_load(Wp, N, k0 + 64, n0, lane, vb);
        const int drow0 = (MODE == 0) ? n0 : ((n0 >> 7) * 256 + (n0 & 127) + (MODE == 2 ? 128 : 0));
        tr_store<FP8>(va, WTp, K, k0, drow0, lane, wsc);
        const int nit = it + NGW; const bool more = nit < total;
        int n0n = n0, k0n = k0; const float* Wpn = Wp; unsigned char* WTpn = WTp;
        if (more) { e = nit / per; r = nit - e * per; kb = r / nbn; nbk = r - kb * nbn; n0n = nbk * 64; k0n = kb * 128;
            Wpn = W + (size_t)e * K * N; WTpn = (unsigned char*)WT + (size_t)e * drows * K * (FP8 ? 1 : 2);
            tr_load(Wpn, N, k0n, n0n, lane, va); }
        tr_store<FP8>(vb, WTp, K, k0 + 64, drow0, lane, wsc);
        if (!more) break;
        it = nit; n0 = n0n; k0 = k0n; Wp = Wpn; WTp = WTpn;
    }
}
constexpr float WSC6 = 90.f, ASC6 = 2.f;
template <int MODE>
__device__ __forceinline__ void tr_matrix6(const float* W, int nb, int K, int N, unsigned char* WT, int drows, int rot, int gw, int NGW, int lane, float wscale) {
    const int nbn = N / 32, per = (K / 256) * nbn, total = nb * per;
    int it = gw - rot; if (it < 0) it += NGW;
    const int c = lane & 7, q = lane >> 3;
    for (; it < total; it += NGW) {
        const int e = it / per, r = it - e * per, kb = r / nbn, nbk = r - kb * nbn, n0 = nbk * 32, k0 = kb * 256;
        const float* src = W + (size_t)e * K * N + (size_t)(k0 + 32 * q) * N + n0 + 4 * c;
        f32x4 v[32];
#pragma unroll
        for (int i = 0; i < 32; ++i) v[i] = *(const f32x4*)(src + (size_t)i * N);
        const int drow0 = (MODE == 0) ? n0 : ((n0 >> 7) * 256 + (n0 & 127) + (MODE == 2 ? 128 : 0));
        unsigned char* dst = WT + (size_t)e * drows * K + (size_t)(drow0 + 4 * c) * K + k0 + 32 * q;
#pragma unroll
        for (int j = 0; j < 4; ++j) { float x[32];
#pragma unroll
            for (int i = 0; i < 32; ++i) x[i] = v[i][j] * wscale;
            const v6u w = pk32_fp6(x);
            *(u32x4*)(dst + (size_t)j * K) = (u32x4){w[0], w[1], w[2], w[3]}; *(u32x4*)(dst + (size_t)j * K + 16) = (u32x4){w[4], w[5], 0u, 0u}; }
    }
}
template <bool I8OUT = false>
__device__ __forceinline__ void norm_rows(const float* __restrict__ X, const float* __restrict__ gain, bf16_t* __restrict__ O, int gw, int NGW, int lane) {
    f32x4 g[8];
#pragma unroll
    for (int j = 0; j < 8; ++j) g[j] = *(const f32x4*)(gain + 4 * lane + 256 * j);
    for (int m = gw; m < M; m += 2 * NGW) {
        const f32x4* xa = (const f32x4*)(X + (size_t)m * D) + lane; const f32x4* xb = (const f32x4*)(X + (size_t)(m + NGW) * D) + lane;
        f32x4 va[8], vb[8]; float sa = 0.f, sb = 0.f;
#pragma unroll
        for (int j = 0; j < 8; ++j) { va[j] = xa[64 * j]; vb[j] = xb[64 * j]; }
#pragma unroll
        for (int j = 0; j < 8; ++j) { sa += dot4(va[j]); sb += dot4(vb[j]); }
        const float ra = 1.0f / sqrtf(wave_sum(sa) * (1.0f / D) + EPS), rb = 1.0f / sqrtf(wave_sum(sb) * (1.0f / D) + EPS);
        if constexpr (I8OUT) { unsigned* oa = (unsigned*)((unsigned char*)O + (size_t)m * D) + lane; unsigned* ob = (unsigned*)((unsigned char*)O + (size_t)(m + NGW) * D) + lane;
#pragma unroll
            for (int j = 0; j < 8; ++j) { const f32x4 ya = va[j] * (ra * ASI8) * g[j], yb = vb[j] * (rb * ASI8) * g[j]; oa[64 * j] = pk4_i8(ya.x, ya.y, ya.z, ya.w); ob[64 * j] = pk4_i8(yb.x, yb.y, yb.z, yb.w); } }
        else {
        u32x2* oa = (u32x2*)(O + (size_t)m * D) + lane; u32x2* ob = (u32x2*)(O + (size_t)(m + NGW) * D) + lane;
#pragma unroll
        for (int j = 0; j < 8; ++j) { const f32x4 ya = va[j] * ra * g[j], yb = vb[j] * rb * g[j]; u32x2 wa, wb; wa.x = cvtpk(ya.x, ya.y); wa.y = cvtpk(ya.z, ya.w); wb.x = cvtpk(yb.x, yb.y); wb.y = cvtpk(yb.z, yb.w);
            oa[64 * j] = wa; ob[64 * j] = wb; } }
    }
}
__device__ __forceinline__ void rope_cs(int pos, double invf, float& c, float& s) {
    const double rev = (double)pos * invf * 0.15915494309189535; const float fr = (float)(rev - __builtin_floor(rev));
    s = __builtin_amdgcn_sinf(fr); c = __builtin_amdgcn_cosf(fr);
}

#ifndef PHASES
#define PHASES 0xffffffffu
#endif
#define PH(n) (((PHASES) >> (n)) & 1u)
#ifndef REPEAT
#define REPEAT 0u
#endif
#define RP(n) _Pragma("nounroll") for (int rep_ = 0; rep_ < (int)(((REPEAT) >> (n)) & 1u) + 1; ++rep_)
__global__ void __launch_bounds__(NTHREADS, 2) fwd_kernel(Args args) {
    extern __shared__ __attribute__((aligned(16))) unsigned char lds_raw[];
    LAS unsigned char* lds = (LAS unsigned char*)lds_raw;
    volatile LAS unsigned* MISC = (volatile LAS unsigned*)(lds + LDSCTL_OFF);
    const int wave = __builtin_amdgcn_readfirstlane(opaque_tid() >> 6);
    const int G = gridDim.x, bx = blockIdx.x;
    const int gw = bx * NWAVES + wave, NGW = G * NWAVES, NGT = G * NTHREADS;
#define IDS() const int tid = opaque_tid(), lane = tid & 63, gtid = bx * NTHREADS + tid; (void)lane; (void)gtid
    unsigned char* ws = args.ws;
    float* out = args.out;
    { IDS(); for (int u = tid; u < (LDS_BYTES - LDSCTL_OFF) / 4; u += NTHREADS) ((LAS unsigned*)(lds + LDSCTL_OFF))[u] = 0u; }
    __syncthreads();
    XcdBarrier bar = xcd_barrier_post((unsigned*)(ws + WS_CTL) + 1024, MISC + 8);
#define GRID_BAR() xcd_barrier(bar)

    bf16_t* XB = (bf16_t*)(ws + WS_XB);
    float* csp = (float*)(ws + TAB_CSP);

    if (PH(0)) RP(0)
    {
        IDS();
        LAS float* scr = (LAS float*)(lds + wave * 16640);
        constexpr int T0 = (D / 128) * (2 * D / 64), T1 = (D / 128) * (D / 64), T2 = (D / 128) * (FF / 64), T5 = (D / 128) * (MLA_IN / 64), T6 = (QLORA / 128) * (NH * QKD / 64), T7 = (KVLORA / 128) * (NH * 256 / 64);
        constexpr int NGWC = GRID * NWAVES;
        constexpr int R1 = T0 % NGWC, R2 = (R1 + T1) % NGWC, R3 = (R2 + T2) % NGWC, R4 = (R3 + T2) % NGWC, R5 = (R4 + T2) % NGWC, R6 = (R5 + T5) % NGWC, R7 = (R6 + T6) % NGWC, R8 = (R7 + T7) % NGWC, R9 = (R8 + T1) % NGWC;
        static_assert((NE * (D / 256) * (FF / 32)) % NGWC == 0, "fp6 item count per matrix is a multiple of the wave count");
        tr_matrix<0, 2>(args.in[I_RGWIN], 1, D,      2 * D,    (bf16_t*)(ws + W_IN1),   2 * D,      0,   gw, NGW, scr, lane, WSI8);
        tr_matrix<0>(args.in[I_RGWOUT], 1,  D,      D,        (bf16_t*)(ws + W_OUT1),  D,          R1,  gw, NGW, scr, lane);
        tr_matrix<1, 2>(args.in[I_FFG], 1,  D,      FF,       (bf16_t*)(ws + W_FFGU),  2 * FF,     R2,  gw, NGW, scr, lane, WSI8);
        tr_matrix<2, 2>(args.in[I_FFU], 1,  D,      FF,       (bf16_t*)(ws + W_FFGU),  2 * FF,     R3,  gw, NGW, scr, lane, WSI8);
        tr_matrix<0, 2>(args.in[I_FFD],  1,  FF,     D,        (bf16_t*)(ws + W_FFD),   D,          R4,  gw, NGW, scr, lane, WSD8);
        tr_matrix<0, 2>(args.in[I_MLAWIN], 1, D,     MLA_IN,   (bf16_t*)(ws + W_MLAIN), MLA_IN_PAD, R5,  gw, NGW, scr, lane, WSI8);
        tr_matrix<0, 2>(args.in[I_WQUP],  1,  QLORA,  NH * QKD, (bf16_t*)(ws + W_QUP),   NH * QKD,   R6,  gw, NGW, scr, lane, WSU8);
        tr_matrix<0, 2>(args.in[I_WKVUP], 1,  KVLORA, NH * 256, (bf16_t*)(ws + W_KVUP),  NH * 256,   R7,  gw, NGW, scr, lane, WSU8);
        tr_matrix<0, 1>(args.in[I_MLAWO], 1,  D,      D,        (bf16_t*)(ws + W_MLAO),  D,          R8,  gw, NGW, scr, lane);
        tr_matrix6<1>(args.in[I_MOEG], NE, D, FF, ws + W_MOEGU, 2 * FF, R9, gw, NGW, lane, WSC6);
        tr_matrix6<2>(args.in[I_MOEU], NE, D, FF, ws + W_MOEGU, 2 * FF, R9, gw, NGW, lane, WSC6);
        { u32x4* z = (u32x4*)(ws + W_MLAIN + (size_t)MLA_IN * D); const int nz = (MLA_IN_PAD - MLA_IN) * D / 16;
          for (int i = gtid; i < nz; i += NGT) z[i] = (u32x4){0u, 0u, 0u, 0u}; }
        { bf16_t* Wg = (bf16_t*)(ws + W_GATE); const float* wa = args.in[I_RGWA]; const float* wx = args.in[I_RGWX];
          for (int idx = gtid; idx < 16 * 256 * 256; idx += NGT) { const int h = idx >> 16, n = (idx >> 8) & 255, k = idx & 255, kl = k - 128 * (h & 1);
              float v = 0.f; if (kl >= 0 && kl < 128) v = (n < 128) ? wa[((size_t)h * 128 + kl) * 128 + n] : wx[((size_t)h * 128 + kl) * 128 + (n - 128)];
              Wg[idx] = (bf16_t)(cvtpk(v, 0.f) & 0xffffu); } }
        for (int c = gtid; c < D; c += NGT) { const float lam = args.in[I_LAM][c]; csp[c] = 8.0f * 1.4426950408889634f * log1pf(expf(-lam)); }
        norm_rows<true>(args.in[I_X], args.in[I_ANM], XB, gw, NGW, lane);
    }
    GRID_BAR();

    if (PH(1)) RP(1)
    {
        pg8::Gemm g{XB, (const bf16_t*)(ws + W_IN1), D, D, D};
        pg8::SchedPlain S; S.T.init(M / 256, 2 * D / 256, G, bx); S.atile = (size_t)256 * D; S.btile = (size_t)256 * D;
        pg8::EpiBf16 E{(bf16_t*)(ws + A_U), 2 * D, 1.0f / (WSI8 * ASI8)};
        pg8::gemm_phase8<pg8::EpiBf16, pg8::SchedPlain, 2>(lds, g, S, E);
    }
    GRID_BAR();

    if (PH(2)) RP(2)
    {
        IDS();
        const bf16_t* __restrict__ U = (const bf16_t*)(ws + A_U); bf16_t* __restrict__ XC = (bf16_t*)(ws + A_XC);
        const float* __restrict__ cw = args.in[I_CONVW]; const float* __restrict__ cb = args.in[I_CONVB];
        const int cg = tid & 255, r0 = bx * RPB + (tid >> 8) * (RPB / 2);
        float wk[4][8], bias[8];
#pragma unroll
        for (int k = 0; k < 4; ++k) { const f32x4 w0 = *(const f32x4*)(cw + k * D + cg * 8), w1 = *(const f32x4*)(cw + k * D + cg * 8 + 4);
            wk[k][0] = w0.x; wk[k][1] = w0.y; wk[k][2] = w0.z; wk[k][3] = w0.w; wk[k][4] = w1.x; wk[k][5] = w1.y; wk[k][6] = w1.z; wk[k][7] = w1.w; }
        { const f32x4 b0 = *(const f32x4*)(cb + cg * 8), b1 = *(const f32x4*)(cb + cg * 8 + 4); bias[0] = b0.x; bias[1] = b0.y; bias[2] = b0.z; bias[3] = b0.w; bias[4] = b1.x; bias[5] = b1.y; bias[6] = b1.z; bias[7] = b1.w; }
        const bf16_t* rec = U + (size_t)r0 * (2 * D) + D + cg * 8;
        bf16_t* dst = XC + (size_t)r0 * D + cg * 8;
        u32x4 x3 = {0u, 0u, 0u, 0u}, x2 = x3, x1 = x3;
        if ((r0 & (SEQ - 1)) != 0) { x3 = *(const u32x4*)(rec - 3 * (2 * D)); x2 = *(const u32x4*)(rec - 2 * (2 * D)); x1 = *(const u32x4*)(rec - 1 * (2 * D)); }
#pragma unroll 1
        for (int tb = 0; tb < RPB / 2; tb += 8) {
            u32x4 xn[8];
#pragma unroll
            for (int u = 0; u < 8; ++u) xn[u] = *(const u32x4*)(rec + (size_t)(tb + u) * (2 * D));
#pragma unroll
            for (int u = 0; u < 8; ++u) {
                const u32x4 x0 = xn[u]; float acc[8];
#define CONV_TAP(K_, X_) do { acc[0] += wk[K_][0] * bflo(X_.x); acc[1] += wk[K_][1] * bfhi(X_.x); acc[2] += wk[K_][2] * bflo(X_.y); acc[3] += wk[K_][3] * bfhi(X_.y); \
                              acc[4] += wk[K_][4] * bflo(X_.z); acc[5] += wk[K_][5] * bfhi(X_.z); acc[6] += wk[K_][6] * bflo(X_.w); acc[7] += wk[K_][7] * bfhi(X_.w); } while (0)
#pragma unroll
                for (int e = 0; e < 8; ++e) acc[e] = bias[e];
                CONV_TAP(0, x3); CONV_TAP(1, x2); CONV_TAP(2, x1); CONV_TAP(3, x0);
#undef CONV_TAP
                u32x4 o; o.x = cvtpk(acc[0], acc[1]); o.y = cvtpk(acc[2], acc[3]); o.z = cvtpk(acc[4], acc[5]); o.w = cvtpk(acc[6], acc[7]);
                *(u32x4*)(dst + (size_t)(tb + u) * D) = o;
                x3 = x2; x2 = x1; x1 = x0;
            }
        }
    }
    GRID_BAR();

    if (PH(3)) RP(3)
    {
        pg8::Gemm g{(const bf16_t*)(ws + A_XC), (const bf16_t*)(ws + W_GATE), D, 256, 256};
        pg8::SchedGate S; S.T.init(M / 256, 16, G, bx);
        pg8::EpiGate E{(const bf16_t*)(ws + A_XC), args.in[I_RGBA], args.in[I_RGBX], csp, (unsigned*)(ws + A_AV)};
        pg8::gemm_phase(lds, g, S, E);
    }
    GRID_BAR();

    if (PH(4)) RP(4)
    {
        IDS();
        const unsigned* __restrict__ AB = (const unsigned*)(ws + A_AV);
        float* __restrict__ AGA = (float*)(ws + WS_AGGA); float* __restrict__ AGB = (float*)(ws + WS_AGGB);
        for (int item = bx; item < NBATCH * NCH; item += G) {
            const size_t r0 = (size_t)item * SCH;
            f32x4 A = {1.f, 1.f, 1.f, 1.f}, B = {0.f, 0.f, 0.f, 0.f};
#pragma unroll 8
            for (int t = 0; t < SCH; ++t) { const u32x4 w = *(const u32x4*)(AB + (r0 + t) * D + 4 * tid);
                const f32x4 a = {__builtin_amdgcn_exp2f(bflo(w.x)), __builtin_amdgcn_exp2f(bflo(w.y)), __builtin_amdgcn_exp2f(bflo(w.z)), __builtin_amdgcn_exp2f(bflo(w.w))};
                const f32x4 b = {bfhi(w.x), bfhi(w.y), bfhi(w.z), bfhi(w.w)}; A = A * a; B = a * B + b; }
            *(f32x4*)(AGA + (size_t)item * D + 4 * tid) = A; *(f32x4*)(AGB + (size_t)item * D + 4 * tid) = B;
        }
    }
    GRID_BAR();

    if (PH(5)) RP(5)
    {
        IDS();
        const unsigned* __restrict__ AB = (const unsigned*)(ws + A_AV);
        const float* __restrict__ AGA = (const float*)(ws + WS_AGGA); const float* __restrict__ AGB = (const float*)(ws + WS_AGGB);
        const bf16_t* __restrict__ U = (const bf16_t*)(ws + A_U); bf16_t* __restrict__ Y = (bf16_t*)(ws + A_Y);
        for (int item = bx; item < NBATCH * NCH; item += G) {
            const int b = item / NCH, ch = item - b * NCH; const size_t r0 = (size_t)item * SCH;
            f32x4 h = {0.f, 0.f, 0.f, 0.f};
#pragma unroll 8
            for (int c = 0; c < ch; ++c) { const f32x4 a = *(const f32x4*)(AGA + (size_t)(b * NCH + c) * D + 4 * tid), bb = *(const f32x4*)(AGB + (size_t)(b * NCH + c) * D + 4 * tid); h = a * h + bb; }
#pragma unroll 8
            for (int t = 0; t < SCH; ++t) {
                const u32x4 pw = *(const u32x4*)(AB + (r0 + t) * D + 4 * tid);
                const f32x4 a = {__builtin_amdgcn_exp2f(bflo(pw.x)), __builtin_amdgcn_exp2f(bflo(pw.y)), __builtin_amdgcn_exp2f(bflo(pw.z)), __builtin_amdgcn_exp2f(bflo(pw.w))};
                const f32x4 bb = {bfhi(pw.x), bfhi(pw.y), bfhi(pw.z), bfhi(pw.w)};
                const u32x2 gw2 = *(const u32x2*)(U + (r0 + t) * (2 * D) + 4 * tid);
                h = a * h + bb;
                const float y0 = h.x * gelu_tanh(bflo(gw2.x)), y1 = h.y * gelu_tanh(bfhi(gw2.x)), y2 = h.z * gelu_tanh(bflo(gw2.y)), y3 = h.w * gelu_tanh(bfhi(gw2.y));
                u32x2 w; w.x = cvtpk(y0, y1); w.y = cvtpk(y2, y3);
                *(u32x2*)(Y + (r0 + t) * D + 4 * tid) = w;
            }
        }
    }
    GRID_BAR();

    if (PH(6)) RP(6)
    {
        pg8::Gemm g{(const bf16_t*)(ws + A_Y), (const bf16_t*)(ws + W_OUT1), D, D, D};
        pg8::SchedPlain S; S.T.init(M / 256, D / 256, G, bx); S.atile = (size_t)256 * D * 2; S.btile = (size_t)256 * D * 2;
        pg8::EpiResidual E{args.in[I_X], out, D, 1.0f};
        pg8::gemm_phase(lds, g, S, E);
    }
    GRID_BAR();
    if (PH(7)) RP(7)
    { IDS(); norm_rows<true>(out, args.in[I_ANF], XB, gw, NGW, lane); }
    GRID_BAR();
    if (PH(8)) RP(8)
    {
        pg8::Gemm g{XB, (const bf16_t*)(ws + W_FFGU), D, D, D};
        pg8::SchedPlain S; S.T.init(M / 256, 2 * FF / 256, G, bx); S.atile = (size_t)256 * D; S.btile = (size_t)256 * D;
        pg8::EpiSwiglu<2> E{(void*)(ws + A_H), FF, 1.0f / (WSI8 * ASI8), HSI8};
        pg8::gemm_phase8<pg8::EpiSwiglu<2>, pg8::SchedPlain, 2>(lds, g, S, E);
    }
    GRID_BAR();
    if (PH(9)) RP(9)
    {
        pg8::Gemm g{(const bf16_t*)(ws + A_H), (const bf16_t*)(ws + W_FFD), FF, FF, FF};
        pg8::SchedPlain S; S.T.init(M / 256, D / 256, G, bx); S.atile = (size_t)256 * FF; S.btile = (size_t)256 * FF;
        pg8::EpiResidual E{out, out, D, 1.0f / (WSD8 * HSI8)};
        pg8::gemm_phase8<pg8::EpiResidual, pg8::SchedPlain, 2>(lds, g, S, E);
    }
    GRID_BAR();
    if (PH(10)) RP(10)
    { IDS(); norm_rows<true>(out, args.in[I_BNM], XB, gw, NGW, lane); }
    GRID_BAR();
    if (PH(11)) RP(11)
    {
        pg8::Gemm g{XB, (const bf16_t*)(ws + W_MLAIN), D, D, D};
        pg8::SchedPlain S; S.T.init(M / 256, 4, G, bx); S.atile = (size_t)256 * D; S.btile = (size_t)256 * D;
        pg8::EpiBf16 E{(bf16_t*)(ws + A_CU), MLA_IN_PAD, 1.0f / (WSI8 * ASI8)};
        pg8::gemm_phase8<pg8::EpiBf16, pg8::SchedPlain, 2>(lds, g, S, E);
    }
    if (PH(11)) RP(11)
    {
        pg8::Gemm g{XB, (const bf16_t*)(ws + W_MLAIN), D, D, D / 4};
        pg8::SchedKSplit S{G, bx, M / 256, 4, 4, (size_t)256 * D, (size_t)256 * D, (size_t)(D / 4)};
        pg8::EpiKpe E{(float*)(ws + A_KPP), 4, 1.0f / (WSI8 * ASI8)};
        pg8::gemm_phase8<pg8::EpiKpe, pg8::SchedKSplit, 2>(lds, g, S, E);
    }
    GRID_BAR();
    if (PH(12)) RP(12)
    {
        IDS();
        const bf16_t* __restrict__ CU = (const bf16_t*)(ws + A_CU); bf16_t* __restrict__ CQ = (bf16_t*)(ws + A_CQ); bf16_t* __restrict__ CKV = (bf16_t*)(ws + A_CKV); bf16_t* __restrict__ KPE = (bf16_t*)(ws + A_KPE);
        const int* __restrict__ posv = args.positions; float* __restrict__ CST = (float*)(ws + A_CST); const float* __restrict__ KPP = (const float*)(ws + A_KPP);
        const f32x4 gq0 = *(const f32x4*)(args.in[I_QNORM] + 4 * lane), gq1 = *(const f32x4*)(args.in[I_QNORM] + 256 + 4 * lane);
        const f32x4 gk0 = *(const f32x4*)(args.in[I_KVNORM] + 4 * lane), gk1 = *(const f32x4*)(args.in[I_KVNORM] + 256 + 4 * lane);
        const double invf = INV_FREQ[lane & 31];
#pragma unroll 2
        for (int m = gw; m < M; m += NGW) {
            const bf16_t* r = CU + (size_t)m * MLA_IN_PAD;
            const u32x2 wq0 = *(const u32x2*)(r + 4 * lane), wq1 = *(const u32x2*)(r + 256 + 4 * lane), wk0 = *(const u32x2*)(r + 512 + 4 * lane), wk1 = *(const u32x2*)(r + 768 + 4 * lane);
            const f32x4 q0 = {bflo(wq0.x), bfhi(wq0.x), bflo(wq0.y), bfhi(wq0.y)}, q1 = {bflo(wq1.x), bfhi(wq1.x), bflo(wq1.y), bfhi(wq1.y)};
            const f32x4 k0 = {bflo(wk0.x), bfhi(wk0.x), bflo(wk0.y), bfhi(wk0.y)}, k1 = {bflo(wk1.x), bfhi(wk1.x), bflo(wk1.y), bfhi(wk1.y)};
            const float* kp = KPP + (size_t)m * 64 + (lane & 31);
            const float x1 = (kp[0] + kp[(size_t)M * 64]) + (kp[(size_t)2 * M * 64] + kp[(size_t)3 * M * 64]), x2 = (kp[32] + kp[(size_t)M * 64 + 32]) + (kp[(size_t)2 * M * 64 + 32] + kp[(size_t)3 * M * 64 + 32]);
            const float rq = 1.0f / sqrtf(wave_sum(dot4(q0) + dot4(q1)) * (1.0f / QLORA) + EPS), rk = 1.0f / sqrtf(wave_sum(dot4(k0) + dot4(k1)) * (1.0f / KVLORA) + EPS);
            { const f32x4 y0 = q0 * (rq * ASI8) * gq0, y1 = q1 * (rq * ASI8) * gq1;
              *(unsigned*)((unsigned char*)CQ + (size_t)m * QLORA + 4 * lane) = pk4_i8(y0.x, y0.y, y0.z, y0.w); *(unsigned*)((unsigned char*)CQ + (size_t)m * QLORA + 256 + 4 * lane) = pk4_i8(y1.x, y1.y, y1.z, y1.w); }
            { const f32x4 y0 = k0 * (rk * ASI8) * gk0, y1 = k1 * (rk * ASI8) * gk1;
              *(unsigned*)((unsigned char*)CKV + (size_t)m * KVLORA + 4 * lane) = pk4_i8(y0.x, y0.y, y0.z, y0.w); *(unsigned*)((unsigned char*)CKV + (size_t)m * KVLORA + 256 + 4 * lane) = pk4_i8(y1.x, y1.y, y1.z, y1.w); }
            float cs, sn; rope_cs(posv[m], invf, cs, sn);
            const float o1 = x1 * cs - x2 * sn, o2 = x2 * cs + x1 * sn;
            CST[(size_t)m * 64 + lane] = (lane < 32) ? cs : sn;
            if (lane < 32) { KPE[(size_t)m * ROPE + lane] = (bf16_t)(cvtpk(o1, 0.f) & 0xffffu); KPE[(size_t)m * ROPE + 32 + lane] = (bf16_t)(cvtpk(o2, 0.f) & 0xffffu); }
        }
    }
    GRID_BAR();
    if (PH(13)) RP(13)
    {
        pg8::Gemm g{(const bf16_t*)(ws + A_CQ), (const bf16_t*)(ws + W_QUP), QLORA, QLORA, QLORA};
        pg8::SchedPlain S; S.T.init(M / 256, NH * QKD / 256, G, bx); S.atile = (size_t)256 * QLORA; S.btile = (size_t)256 * QLORA;
        pg8::EpiFp8 E{ws + A_Q, NH * QKD, QSCALE * att::QS8 / (WSU8 * ASI8)};
        pg8::gemm_phase8<pg8::EpiFp8, pg8::SchedPlain, 2>(lds, g, S, E);
    }
    if (PH(22)) RP(22)
    {
        pg8::Gemm g{(const bf16_t*)(ws + A_CKV), (const bf16_t*)(ws + W_KVUP), KVLORA, KVLORA, KVLORA};
        pg8::SchedPlain S; S.T.init(M / 256, NH * 256 / 256, G, bx); S.atile = (size_t)256 * KVLORA; S.btile = (size_t)256 * KVLORA;
        pg8::EpiFp8 E{ws + A_KV, NH * 256, 1.0f / (WSU8 * ASI8)};
        pg8::gemm_phase8<pg8::EpiFp8, pg8::SchedPlain, 2>(lds, g, S, E);
    }
    GRID_BAR();
    if (PH(15)) RP(15)
    {
        const int vcu = (G % 8 == 0) ? (bx % 8) * (G / 8) + bx / 8 : bx;
        att::CvtState cs{args.in[I_MOED], ws + W_MOED, gw * att::CV_IPW, (gw + 1) * att::CV_IPW};
        for (int L = vcu; L < NBATCH * NH * 8; L += G) {
            const int bh = L >> 3, x = L & 7, b = bh / NH, h = bh - b * NH;
#pragma nounroll
            for (int pass = 0; pass < 2; ++pass)
                att::attn_unit(lds, ws + A_Q, ws + A_KV, (const bf16_t*)(ws + A_KPE), (const float*)(ws + A_CST), (bf16_t*)(ws + A_O), b, h, pass ? x : 15 - x, cs);
        }
        { const int lane_ = opaque_tid() & 63;
#pragma nounroll
          while (cs.next < cs.end) { f32x4 cv[8]; att::cvt_load(cs, lane_, cv); att::cvt_store(cs, lane_, cv); } }
    }
    GRID_BAR();
    if (PH(16)) RP(16)
    {
        pg8::Gemm g{(const bf16_t*)(ws + A_O), (const bf16_t*)(ws + W_MLAO), D, D, D};
        pg8::SchedPlain S; S.T.init(M / 256, D / 256, G, bx); S.atile = (size_t)256 * D; S.btile = (size_t)256 * D;
        pg8::EpiResidual E{out, out, D, 1.0f / (WSC8 * att::OSC8)};
        pg8::gemm_phase8<pg8::EpiResidual, pg8::SchedPlain, 0>(lds, g, S, E);
    }
    GRID_BAR();
    int* CNT = (int*)(ws + TAB_CNT); int* TILE = (int*)(ws + TAB_TILE); int* SLOT = (int*)(ws + TAB_SLOT); float* GATE = (float*)(ws + TAB_GATE); int* TOPE = (int*)(ws + TAB_TOPE);
    if (PH(17)) RP(17)
    {
        IDS();
        LAS float* wr = (LAS float*)lds;
        LAS int* tl = (LAS int*)(lds + 65536);
        const float* gain = args.in[I_BNF]; const float* wrt = args.in[I_ROUTER];
        for (int d = tid; d < D; d += NTHREADS) { const float gd = gain[d]; const f32x4 a = *(const f32x4*)(wrt + (size_t)d * 8), c = *(const f32x4*)(wrt + (size_t)d * 8 + 4);
            wr[0 * D + d] = a.x * gd; wr[1 * D + d] = a.y * gd; wr[2 * D + d] = a.z * gd; wr[3 * D + d] = a.w * gd; wr[4 * D + d] = c.x * gd; wr[5 * D + d] = c.y * gd; wr[6 * D + d] = c.z * gd; wr[7 * D + d] = c.w * gd; }
        f32x4 g[8];
#pragma unroll
        for (int j = 0; j < 8; ++j) g[j] = *(const f32x4*)(gain + 4 * lane + 256 * j);
        __syncthreads();
        for (int i = 0; i < RPB / NWAVES; i += 2) {
            const int rl = wave * (RPB / NWAVES) + i, m = bx * RPB + rl;
            const f32x4* xr = (const f32x4*)(out + (size_t)m * D) + lane;
            f32x4 va[8], vb[8]; float sa = 0.f, sb = 0.f;
#pragma unroll
            for (int j = 0; j < 8; ++j) { va[j] = xr[64 * j]; vb[j] = xr[64 * j + D / 4]; }
#pragma unroll
            for (int j = 0; j < 8; ++j) { sa += dot4(va[j]); sb += dot4(vb[j]); }
            float la[8], lb[8];
#pragma unroll
            for (int e = 0; e < 8; ++e) { float a = 0.f, b = 0.f;
#pragma unroll
                for (int j = 0; j < 8; ++j) { const f32x4 w = *(const LAS f32x4*)(wr + e * D + 4 * lane + 256 * j);
                    a += (va[j].x * w.x + va[j].y * w.y) + (va[j].z * w.z + va[j].w * w.w); b += (vb[j].x * w.x + vb[j].y * w.y) + (vb[j].z * w.z + vb[j].w * w.w); }
                la[e] = a; lb[e] = b; }
            const float ra = 1.0f / sqrtf(wave_sum(sa) * (1.0f / D) + EPS), rb = 1.0f / sqrtf(wave_sum(sb) * (1.0f / D) + EPS);
#pragma unroll
            for (int e = 0; e < 8; ++e) { la[e] = wave_sum(la[e]) * ra; lb[e] = wave_sum(lb[e]) * rb; }
#pragma unroll
            for (int rr = 0; rr < 2; ++rr) {
                float lg[8];
#pragma unroll
                for (int e = 0; e < 8; ++e) lg[e] = rr ? lb[e] : la[e];
                int e1 = 0; float v1 = lg[0];
#pragma unroll
                for (int e = 1; e < 8; ++e) if (lg[e] > v1) { v1 = lg[e]; e1 = e; }
                int e2 = -1; float v2 = -__builtin_inff();
#pragma unroll
                for (int e = 0; e < 8; ++e) if (e != e1 && lg[e] > v2) { v2 = lg[e]; e2 = e; }
                const float g2 = 1.0f / (1.0f + expf(v1 - v2)), g1 = 1.0f - g2;
                if (lane == 0) { tl[2 * (rl + rr)] = e1; tl[2 * (rl + rr) + 1] = e2; TOPE[2 * (m + rr)] = e1; TOPE[2 * (m + rr) + 1] = e2; GATE[2 * (m + rr)] = g1; GATE[2 * (m + rr) + 1] = g2; }
            }
            u32x2* o = (u32x2*)(XB + (size_t)m * D) + lane;
#pragma unroll
            for (int j = 0; j < 8; ++j) { const f32x4 ya = va[j] * ra * g[j], yb = vb[j] * rb * g[j]; u32x2 wa, wb; wa.x = cvtpk(ya.x, ya.y); wa.y = cvtpk(ya.z, ya.w); wb.x = cvtpk(yb.x, yb.y); wb.y = cvtpk(yb.z, yb.w);
                o[64 * j] = wa; o[64 * j + D / 4] = wb; }
        }
        __syncthreads();
        if (tid < NE) { int c = 0; for (int i = 0; i < 2 * RPB; ++i) c += (tl[i] == tid) ? 1 : 0; CNT[bx * NE + tid] = c; }
        __syncthreads();
    }
    GRID_BAR();
    if (PH(18)) RP(18)
    {
        IDS();
        LAS int* sh = (LAS int*)lds;
        if (tid < NE) { int before = 0, total = 0; for (int bb = 0; bb < G; ++bb) { const int c = CNT[bb * NE + tid]; total += c; before += (bb < bx) ? c : 0; } sh[tid] = before; sh[16 + tid] = total; }
        if (tid >= 64 && tid < 64 + 2 * RPB) sh[32 + (tid - 64)] = TOPE[2 * bx * RPB + (tid - 64)];
        __syncthreads();
        if (tid == 0) { int ps = 0; for (int e = 0; e < NE; ++e) { sh[8 + e] = ps; ps += ((sh[16 + e] + 255) >> 8) << 8; }
            if (bx == 0) { int ti = 0; for (int e = 0; e < NE; ++e) { const int ntl = (sh[16 + e] + 255) >> 8; for (int q = 0; q < ntl; ++q) TILE[ti++] = e; } TILE[255] = ti; } }
        __syncthreads();
        if (tid < 2 * RPB) { const int e = sh[32 + tid]; int rank = 0; for (int j = 0; j < tid; ++j) rank += (sh[32 + j] == e) ? 1 : 0;
            const int slot = sh[8 + e] + sh[e] + rank; sh[160 + tid] = slot; SLOT[2 * bx * RPB + tid] = slot; }
        __syncthreads();
        unsigned char* BUF = ws + A_BUF;
        for (int r = wave; r < RPB; r += 2 * NWAVES) {
            u32x4 s[2][4];
#pragma unroll
            for (int qq = 0; qq < 2; ++qq) { const int m = bx * RPB + r + qq * NWAVES;
                const u32x4* src = (const u32x4*)(XB + (size_t)m * D + 32 * lane);
#pragma unroll
                for (int j = 0; j < 4; ++j) s[qq][j] = src[j]; }
#pragma unroll
            for (int qq = 0; qq < 2; ++qq) { float x[32]; const int rr = r + qq * NWAVES;
#pragma unroll
                for (int j = 0; j < 4; ++j) { const u32x4 t = s[qq][j]; x[8 * j + 0] = bflo(t.x) * ASC6; x[8 * j + 1] = bfhi(t.x) * ASC6; x[8 * j + 2] = bflo(t.y) * ASC6; x[8 * j + 3] = bfhi(t.y) * ASC6;
                    x[8 * j + 4] = bflo(t.z) * ASC6; x[8 * j + 5] = bfhi(t.z) * ASC6; x[8 * j + 6] = bflo(t.w) * ASC6; x[8 * j + 7] = bfhi(t.w) * ASC6; }
                const v6u w = pk32_fp6(x); const u32x4 lo = {w[0], w[1], w[2], w[3]}, hi = {w[4], w[5], 0u, 0u};
                unsigned char* d0 = BUF + (size_t)sh[160 + 2 * rr] * D + 32 * lane; unsigned char* d1 = BUF + (size_t)sh[160 + 2 * rr + 1] * D + 32 * lane;
                *(u32x4*)d0 = lo; *(u32x4*)(d0 + 16) = hi; *(u32x4*)d1 = lo; *(u32x4*)(d1 + 16) = hi; } }
        __syncthreads();
    }
    GRID_BAR();
    if (PH(19)) RP(19)
    {
        LAS int* tlds = (LAS int*)(lds + LDSCTL_OFF + 1024);
        { IDS(); if (tid < 256) tlds[tid] = TILE[tid]; __syncthreads(); }
        const int ntiles = tlds[255];
        pg8::Gemm g{(const bf16_t*)(ws + A_BUF), (const bf16_t*)(ws + W_MOEGU), D, D, D};
        pg8::SchedMoe S; S.T.init(ntiles, 2 * FF / 256, G, bx); S.tile_e = tlds; S.atile = (size_t)256 * D; S.btile = (size_t)256 * D; S.nN = 2 * FF / 256;
        pg8::EpiSwiglu<1> E{(void*)(ws + A_HM), FF, 1.0f / (WSC6 * ASC6), HSC8};
        pg8::gemm_phase8<pg8::EpiSwiglu<1>, pg8::SchedMoe, 1>(lds, g, S, E);
    }
    GRID_BAR();
    if (PH(20)) RP(20)
    {
        LAS int* tlds = (LAS int*)(lds + LDSCTL_OFF + 1024);
        { IDS(); if (tid < 256) tlds[tid] = TILE[tid]; __syncthreads(); }
        const int ntiles = tlds[255], nmain = ntiles < MAIN_TILES ? ntiles : MAIN_TILES;
        {
            pg8::Gemm g{(const bf16_t*)(ws + A_HM), (const bf16_t*)(ws + W_MOED), FF, FF, FF};
            pg8::SchedMoe S; S.T.init(nmain, D / 256, G, bx); S.tile_e = tlds; S.atile = (size_t)256 * FF; S.btile = (size_t)256 * FF; S.nN = D / 256;
            pg8::EpiBf16 E{(bf16_t*)(ws + A_YM), D, 1.0f / (WSC8 * HSC8)};
            pg8::gemm_phase8(lds, g, S, E);
        }
        if (ntiles > MAIN_TILES) {
            pg8::Gemm g{(const bf16_t*)(ws + A_HM), (const bf16_t*)(ws + W_MOED), FF, FF, FF / KSPLIT};
            pg8::SchedMoeSplit S; S.G = G; S.c = bx; S.pm0 = MAIN_TILES; S.nN = D / 256; S.ntl = (ntiles - MAIN_TILES) * (D / 256); S.KS = KSPLIT; S.tile_e = tlds;
            S.atile = (size_t)256 * FF; S.btile = (size_t)256 * FF; S.kbytes = FF / KSPLIT;
            pg8::EpiBf16Split E{(bf16_t*)(ws + A_YP) - (size_t)MAIN_TILES * 256 * D, D, 1.0f / (WSC8 * HSC8), (size_t)(MAXT - MAIN_TILES) * 256 * D};
            pg8::gemm_phase8(lds, g, S, E);
        }
    }
    GRID_BAR();
    if (PH(21)) RP(21)
    {
        IDS();
        const bf16_t* YM = (const bf16_t*)(ws + A_YM); const float* gain = args.in[I_FNORM];
        const bf16_t* YP = (const bf16_t*)(ws + A_YP); constexpr size_t YPS = (size_t)(MAXT - MAIN_TILES) * 256 * D;
        const bool poison = xb_ld((unsigned*)(ws + WS_CTL) + 1024 + XB_TMO) != 0u;
        f32x4 g[8];
#pragma unroll
        for (int j = 0; j < 8; ++j) g[j] = *(const f32x4*)(gain + 4 * lane + 256 * j);
        for (int m = gw; m < M; m += NGW) {
            const int s1 = SLOT[2 * m], s2 = SLOT[2 * m + 1]; const float g1 = GATE[2 * m], g2 = GATE[2 * m + 1];
            f32x4* xr = (f32x4*)(out + (size_t)m * D) + lane;
            const u32x2* y1 = (const u32x2*)(YM + (size_t)s1 * D) + lane; const u32x2* y2 = (const u32x2*)(YM + (size_t)s2 * D) + lane;
            f32x4 v[8]; float s = 0.f;
            if (s1 < MAIN_TILES * 256 && s2 < MAIN_TILES * 256) {
#pragma unroll
            for (int j = 0; j < 8; ++j) { const f32x4 x = xr[64 * j]; const u32x2 a = y1[64 * j], b = y2[64 * j];
                f32x4 t; t.x = x.x + g1 * bflo(a.x) + g2 * bflo(b.x); t.y = x.y + g1 * bfhi(a.x) + g2 * bfhi(b.x); t.z = x.z + g1 * bflo(a.y) + g2 * bflo(b.y); t.w = x.w + g1 * bfhi(a.y) + g2 * bfhi(b.y);
                v[j] = t; s += dot4(t); }
            } else {
#pragma unroll
                for (int j = 0; j < 8; ++j) v[j] = xr[64 * j];
#pragma unroll
                for (int k = 0; k < 2; ++k) { const int sl = k ? s2 : s1; const float gk = k ? g2 : g1;
                    const int np = (sl < MAIN_TILES * 256) ? 1 : KSPLIT;
                    const bf16_t* base = (sl < MAIN_TILES * 256) ? YM + (size_t)sl * D : YP + (size_t)(sl - MAIN_TILES * 256) * D;
                    for (int kc = 0; kc < np; ++kc) { const u32x2* y = (const u32x2*)(base + (size_t)kc * YPS) + lane;
#pragma unroll
                        for (int j = 0; j < 8; ++j) { const u32x2 a = y[64 * j]; v[j].x += gk * bflo(a.x); v[j].y += gk * bfhi(a.x); v[j].z += gk * bflo(a.y); v[j].w += gk * bfhi(a.y); } } }
#pragma unroll
                for (int j = 0; j < 8; ++j) s += dot4(v[j]);
            }
            float rstd = 1.0f / sqrtf(wave_sum(s) * (1.0f / D) + EPS);
            if (poison) rstd = __builtin_nanf("");
#pragma unroll
            for (int j = 0; j < 8; ++j) xr[64 * j] = v[j] * rstd * g[j];
        }
    }
}

extern "C" void kernel_launch(void* const* d_in, const int* in_sizes, int n_in, void* d_out, int out_size, void* d_ws, size_t ws_size, hipStream_t stream) {
    static int ready = 0;
    if (ready == 0) {
        if (n_in != 29 || in_sizes[0] != M * D || out_size != M * D || ws_size < WS_END) {
            fprintf(stderr, "kernel_launch: unexpected shapes (n_in %d, in0 %d, out %d, ws %zu, need %zu); nothing launched\n", n_in, n_in > 0 ? in_sizes[0] : -1, out_size, ws_size, (size_t)WS_END); ready = -1; return; }
        if (hipFuncSetAttribute((const void*)fwd_kernel, hipFuncAttributeMaxDynamicSharedMemorySize, LDS_BYTES) != hipSuccess) { fprintf(stderr, "kernel_launch: hipFuncSetAttribute failed\n"); ready = -1; return; }
        int per_cu = 0;
        if (hipOccupancyMaxActiveBlocksPerMultiprocessor(&per_cu, (const void*)fwd_kernel, NTHREADS, LDS_BYTES) != hipSuccess || per_cu < 1) fprintf(stderr, "kernel_launch: occupancy query reports %d workgroups per CU\n", per_cu);
        (void)hipGetLastError();
        ready = 1;
    }
    if (ready < 0) return;
    (void)hipMemsetAsync((char*)d_ws + WS_CTL, 0, CTL_ZERO_BYTES, stream);
    Args a{};
    for (int i = 0; i < 29; ++i) a.in[i] = (const float*)d_in[i];
    a.positions = (const int*)d_in[I_POS]; a.out = (float*)d_out; a.ws = (unsigned char*)d_ws;
    hipLaunchKernelGGL(fwd_kernel, dim3(GRID), dim3(NTHREADS), LDS_BYTES, stream, a);
}
```

```cpp
#include <hip/hip_runtime.h>
#include <cstdio>
#include <cstdint>

#define GAS __attribute__((address_space(1)))
#define LAS __attribute__((address_space(3)))
typedef unsigned short bf16_t;
typedef short bf16x8 __attribute__((ext_vector_type(8)));
typedef short s16x4 __attribute__((ext_vector_type(4)));
typedef float f32x2 __attribute__((ext_vector_type(2)));
typedef float f32x4 __attribute__((ext_vector_type(4)));
typedef float f32x16 __attribute__((ext_vector_type(16)));
typedef unsigned u32x2 __attribute__((ext_vector_type(2)));
typedef unsigned u32x4 __attribute__((ext_vector_type(4)));

constexpr int D = 2048, SEQ = 4096, NBATCH = 4, M = NBATCH * SEQ;
constexpr int NH = 16, QLORA = 512, KVLORA = 512, NOPE = 128, ROPE = 64, VDIM = 128, QKD = 192;
constexpr int MLA_IN = 1088, MLA_IN_PAD = 1280;
constexpr int FF = 7168, NE = 8;
constexpr int PMAX = 2 * M + NE * 256;
constexpr int MAXT = PMAX / 256;
constexpr float EPS = 1e-6f;
constexpr float QSCALE = 0.10411754627697264f;
constexpr int GRID = 256, NWAVES = 8, NTHREADS = 512;
constexpr int RPB = M / GRID;
constexpr int SCH = 64, NCH = SEQ / SCH;

constexpr size_t MiB = 1u << 20;
constexpr size_t WS_CTL = 0, CTL_ZERO_BYTES = 64 * 1024;
constexpr size_t WS_TAB = 1 * MiB;
constexpr size_t TAB_CSP = WS_TAB, TAB_CNT = WS_TAB + 64 * 1024, TAB_TILE = WS_TAB + 128 * 1024, TAB_SLOT = WS_TAB + 256 * 1024,
                 TAB_GATE = WS_TAB + 512 * 1024, TAB_TOPE = WS_TAB + 768 * 1024;
constexpr size_t WS_AGGA = 2 * MiB, WS_AGGB = 4 * MiB;
constexpr size_t W_IN1 = 8 * MiB, W_GATE = 24 * MiB, W_OUT1 = 26 * MiB, W_FFGU = 34 * MiB, W_FFD = 90 * MiB, W_MLAIN = 118 * MiB,
                 W_QUP = 123 * MiB, W_KVUP = 126 * MiB, W_MLAO = 130 * MiB, W_MOEGU = 138 * MiB, W_MOED = 586 * MiB;
constexpr size_t WS_XB = 810 * MiB, WS_ACT = 874 * MiB;
constexpr size_t A_U = WS_ACT, A_XC = WS_ACT + 128 * MiB, A_AV = WS_ACT + 192 * MiB, A_BV = WS_ACT + 320 * MiB, A_Y = WS_ACT + 448 * MiB;
constexpr size_t A_H = WS_ACT;
constexpr size_t A_KPP = WS_ACT + 48 * MiB;
constexpr size_t A_CST = WS_ACT + 88 * MiB;
constexpr size_t A_CU = WS_ACT, A_CQ = WS_ACT + 80 * MiB, A_CKV = WS_ACT + 96 * MiB, A_KPE = WS_ACT + 112 * MiB, A_Q = WS_ACT + 114 * MiB,
                 A_KV = WS_ACT + 210 * MiB, A_O = WS_ACT + 338 * MiB;
constexpr size_t A_YP = WS_ACT + 400 * MiB;
constexpr int MAIN_TILES = 128, KSPLIT = 4;
constexpr size_t A_BUF = WS_ACT, A_HM = WS_ACT + 136 * MiB, A_YM = WS_ACT + 612 * MiB, WS_END = WS_ACT + 748 * MiB;
static_assert((size_t)PMAX * D * 2 <= 136 * MiB && (size_t)PMAX * FF * 2 <= 476 * MiB, "moe buffers");

constexpr int RING_BYTES = 135168;
constexpr int LDSCTL_OFF = RING_BYTES;
constexpr int LDS_BYTES = 147456;

__device__ const double INV_FREQ[32] = {1.0, 0.7498942093324559, 0.5623413251903491, 0.4216965034285822, 0.31622776601683794, 0.23713737056616552, 0.1778279410038923, 0.1333521432163324, 0.1,
    0.07498942093324558, 0.05623413251903491, 0.042169650342858224, 0.03162277660168379, 0.023713737056616554, 0.01778279410038923, 0.01333521432163324, 0.01, 0.007498942093324558,
    0.005623413251903491, 0.004216965034285823, 0.0031622776601683794, 0.0023713737056616554, 0.0017782794100389228, 0.001333521432163324, 0.001, 0.0007498942093324559, 0.0005623413251903491,
    0.00042169650342858224, 0.00031622776601683794, 0.00023713737056616554, 0.00017782794100389227, 0.0001333521432163324};

__device__ __forceinline__ int opaque_tid() { int t = threadIdx.x; asm volatile("" : "+v"(t)); return t; }
#define LDS_WAIT() asm volatile("s_waitcnt lgkmcnt(0)" ::: "memory")
#define VM_WAIT() asm volatile("s_waitcnt vmcnt(0)" ::: "memory")
__device__ __forceinline__ unsigned cvtpk(float lo, float hi) { unsigned r; asm volatile("v_cvt_pk_bf16_f32 %0, %1, %2" : "=v"(r) : "v"(lo), "v"(hi)); return r; }
typedef int v8i __attribute__((ext_vector_type(8)));
typedef short v2s __attribute__((ext_vector_type(2)));
typedef __bf16 v2bf __attribute__((ext_vector_type(2)));
typedef int v4i __attribute__((ext_vector_type(4)));
__device__ __forceinline__ unsigned pk4_fp8(float a, float b, float c, float d) {
    a = __builtin_amdgcn_fmed3f(a, -448.f, 448.f); b = __builtin_amdgcn_fmed3f(b, -448.f, 448.f); c = __builtin_amdgcn_fmed3f(c, -448.f, 448.f); d = __builtin_amdgcn_fmed3f(d, -448.f, 448.f);
    int w = __builtin_amdgcn_cvt_pk_fp8_f32(a, b, 0, false); w = __builtin_amdgcn_cvt_pk_fp8_f32(c, d, w, true); return (unsigned)w; }
__device__ __forceinline__ unsigned pk4_fp8_nc(float a, float b, float c, float d) {
    int w = __builtin_amdgcn_cvt_pk_fp8_f32(a, b, 0, false); w = __builtin_amdgcn_cvt_pk_fp8_f32(c, d, w, true); return (unsigned)w; }
__device__ __forceinline__ unsigned pk4_i8(float a, float b, float c, float d) {
    const unsigned ua = __float_as_uint(__builtin_amdgcn_fmed3f(a, -127.f, 127.f) + 12582912.f), ub = __float_as_uint(__builtin_amdgcn_fmed3f(b, -127.f, 127.f) + 12582912.f);
    const unsigned uc = __float_as_uint(__builtin_amdgcn_fmed3f(c, -127.f, 127.f) + 12582912.f), ud = __float_as_uint(__builtin_amdgcn_fmed3f(d, -127.f, 127.f) + 12582912.f);
    const unsigned t1 = __builtin_amdgcn_perm(ub, ua, 0x0c0c0400u), t2 = __builtin_amdgcn_perm(ud, uc, 0x0c0c0400u);
    return __builtin_amdgcn_perm(t2, t1, 0x05040100u); }
typedef float v16f __attribute__((ext_vector_type(16)));
typedef unsigned v6u __attribute__((ext_vector_type(6)));
typedef int v6i __attribute__((ext_vector_type(6)));
typedef int v2i __attribute__((ext_vector_type(2)));
__device__ __forceinline__ v6u pk32_fp6(const float (&x)[32]) {
    v16f a, b;
#pragma unroll
    for (int i = 0; i < 16; ++i) { a[i] = __builtin_amdgcn_fmed3f(x[i], -7.5f, 7.5f); b[i] = __builtin_amdgcn_fmed3f(x[16 + i], -7.5f, 7.5f); }
    return __builtin_amdgcn_cvt_scalef32_2xpk16_fp6_f32(a, b, 1.0f);
}
__device__ __forceinline__ float bf2f(unsigned short u) { return __uint_as_float((unsigned)u << 16); }
__device__ __forceinline__ float bflo(unsigned w) { return __uint_as_float(w << 16); }
__device__ __forceinline__ float bfhi(unsigned w) { return __uint_as_float(w & 0xffff0000u); }
__device__ __forceinline__ float wave_sum(float v) {
#pragma unroll
    for (int o = 1; o < 64; o <<= 1) v += __shfl_xor(v, o);
    return v;
}
__device__ __forceinline__ float dot4(f32x4 a) { return (a.x * a.x + a.y * a.y) + (a.z * a.z + a.w * a.w); }
__device__ __forceinline__ float sigmoidf_(float x) { return __builtin_amdgcn_rcpf(1.0f + __expf(-x)); }
__device__ __forceinline__ float gelu_tanh(float x) { const float u = 1.5957691216057308f * (x + 0.044715f * x * x * x); return x * sigmoidf_(u); }

namespace pg8 {
constexpr int BM = 256, BK = 64, HALF = 128, HTB = HALF * BK * 2, STAGE_BYTES = 8 * HTB, NXCD = 8, WGM = 8;
__host__ __device__ __forceinline__ int lds_byte(int r, int c) { const int st = (r >> 4) * 2 + (c >> 5), rr = r & 15, cc = c & 31, ob = rr * 64 + cc * 2; return st * 1024 + (ob ^ (((ob >> 9) & 1) << 5)); }
__host__ __device__ __forceinline__ void stage_rc(int b, int& R, int& C) { const int st = b / 1024, sb = b % 1024, swz = sb ^ (((sb >> 9) & 1) << 5); R = (st >> 1) * 16 + swz / 64; C = (st & 1) * 32 + (swz % 64) / 2; }
__host__ __device__ __forceinline__ int perm32(int rho) { const int n = rho >> 4, i = rho & 15; return 8 * (i >> 2) + 4 * n + (i & 3); }

struct Unit { int pm, pn; size_t aoff, boff; };
struct Gemm { const bf16_t* A; const bf16_t* Bt; int lda, ldb, K; };

struct TileOrder {
    int nM, nN, nwg, G, c;
    __host__ __device__ void init(int nM_, int nN_, int G_, int c_) { nM = nM_; nN = nN_; nwg = nM * nN; G = G_; c = c_; }
    __host__ __device__ bool tile(int i, int& pm, int& pn) const {
        const long L = (long)i * G + c; if (L >= nwg) return false;
        int wgid = (int)L; { const int q = nwg / NXCD, r = nwg % NXCD, xcd = wgid % NXCD, off = wgid / NXCD; wgid = (xcd < r ? xcd * (q + 1) : r * (q + 1) + (xcd - r) * q) + off; }
        const int nig = WGM * nN, gid = wgid / nig, fm = gid * WGM, gsz = (nM - fm) < WGM ? (nM - fm) : WGM;
        pm = fm + ((wgid % nig) % gsz); pn = (wgid % nig) / gsz; return true;
    }
};
struct SchedPlain {
    TileOrder T; size_t atile, btile;
    __device__ __forceinline__ bool next(int i, Unit& u) const { if (!T.tile(i, u.pm, u.pn)) return false; u.aoff = (size_t)u.pm * atile; u.boff = (size_t)u.pn * btile; return true; }
    __device__ __forceinline__ void a_ready(const Unit&) const {}
    __device__ __forceinline__ void done(const Unit&) const {}
};
struct SchedKSplit {
    int G, c, nM, KS, pn0; size_t atile, btile, kbytes;
    __device__ __forceinline__ bool next(int i, Unit& u) const { const int L = i * G + c; if (L >= nM * KS) return false; const int kc = L / nM; u.pm = L - kc * nM; u.pn = pn0 + kc;
        u.aoff = (size_t)u.pm * atile + (size_t)kc * kbytes; u.boff = (size_t)pn0 * btile + (size_t)kc * kbytes; return true; }
    __device__ __forceinline__ void a_ready(const Unit&) const {}
    __device__ __forceinline__ void done(const Unit&) const {}
};
struct SchedMoeSplit {
    int G, c, pm0, ntl, nN, KS; const LAS int* tile_e; size_t atile, btile, kbytes;
    __device__ __forceinline__ bool next(int i, Unit& u) const { const int L = i * G + c; if (L >= ntl * KS) return false; const int kc = L / ntl, t = L - kc * ntl, pn = t % nN; u.pm = pm0 + t / nN; u.pn = pn + nN * kc;
        const int e = tile_e[u.pm] & 7; u.aoff = (size_t)u.pm * atile + (size_t)kc * kbytes; u.boff = ((size_t)e * nN + pn) * btile + (size_t)kc * kbytes; return true; }
    __device__ __forceinline__ void a_ready(const Unit&) const {}
    __device__ __forceinline__ void done(const Unit&) const {}
};
struct SchedGate {
    TileOrder T;
    __device__ __forceinline__ bool next(int i, Unit& u) const { if (!T.tile(i, u.pm, u.pn)) return false; u.aoff = (size_t)u.pm * 256 * D * 2 + (size_t)(u.pn >> 1) * 512; u.boff = (size_t)u.pn * 256 * 256 * 2; return true; }
    __device__ __forceinline__ void a_ready(const Unit&) const {}
    __device__ __forceinline__ void done(const Unit&) const {}
};
struct SchedMoe {
    TileOrder T; const LAS int* tile_e; size_t atile, btile; int nN;
    __device__ __forceinline__ bool next(int i, Unit& u) const { if (!T.tile(i, u.pm, u.pn)) return false; const int e = tile_e[u.pm] & 7; u.aoff = (size_t)u.pm * atile; u.boff = ((size_t)e * nN + u.pn) * btile; return true; }
    __device__ __forceinline__ void a_ready(const Unit&) const {}
    __device__ __forceinline__ void done(const Unit&) const {}
};

typedef f32x4 Acc[2][2][4][2];
struct EpiBf16 {
    static constexpr bool PERM = true;
    bf16_t* O; int ldc; float scale;
    __device__ __forceinline__ void operator()(const Acc& acc, const Unit& u, int wr, int wc, int fr, int fq) const {
        const int row0 = u.pm * BM + wr * 64 + fr, col0 = u.pn * BM + wc * 32 + 8 * fq;
#pragma unroll
        for (int ai = 0; ai < 2; ++ai)
#pragma unroll
            for (int m = 0; m < 4; ++m) { bf16_t* rowp = O + (size_t)(row0 + ai * HALF + m * 16) * ldc + col0;
#pragma unroll
                for (int bj = 0; bj < 2; ++bj) { const f32x4 v0 = acc[ai][bj][m][0] * scale, v1 = acc[ai][bj][m][1] * scale;
                    u32x4 w; w.x = cvtpk(v0[0], v0[1]); w.y = cvtpk(v0[2], v0[3]); w.z = cvtpk(v1[0], v1[1]); w.w = cvtpk(v1[2], v1[3]);
                    *(u32x4*)(rowp + bj * HALF) = w; } }
    }
};
struct EpiFp8 {
    static constexpr bool PERM = true;
    unsigned char* O; int ldc; float scale;
    __device__ __forceinline__ void operator()(const Acc& acc, const Unit& u, int wr, int wc, int fr, int fq) const {
        const int row0 = u.pm * BM + wr * 64 + fr, col0 = u.pn * BM + wc * 32 + 8 * fq;
#pragma unroll
        for (int ai = 0; ai < 2; ++ai)
#pragma unroll
            for (int m = 0; m < 4; ++m) { unsigned char* rowp = O + (size_t)(row0 + ai * HALF + m * 16) * ldc + col0;
#pragma unroll
                for (int bj = 0; bj < 2; ++bj) { const f32x4 v0 = acc[ai][bj][m][0] * scale, v1 = acc[ai][bj][m][1] * scale;
                    u32x2 w; w.x = pk4_fp8_nc(v0[0], v0[1], v0[2], v0[3]); w.y = pk4_fp8_nc(v1[0], v1[1], v1[2], v1[3]);
                    *(u32x2*)(rowp + bj * HALF) = w; } }
    }
};
struct EpiBf16Split {
    static constexpr bool PERM = true;
    bf16_t* O; int ldc; float scale; size_t kstride;
    __device__ __forceinline__ void operator()(const Acc& acc, const Unit& u, int wr, int wc, int fr, int fq) const {
        const int row0 = u.pm * BM + wr * 64 + fr, col0 = (u.pn & 7) * BM + wc * 32 + 8 * fq;
        bf16_t* Ob = O + (size_t)(u.pn >> 3) * kstride;
#pragma unroll
        for (int ai = 0; ai < 2; ++ai)
#pragma unroll
            for (int m = 0; m < 4; ++m) { bf16_t* rowp = Ob + (size_t)(row0 + ai * HALF + m * 16) * ldc + col0;
#pragma unroll
                for (int bj = 0; bj < 2; ++bj) { const f32x4 v0 = acc[ai][bj][m][0] * scale, v1 = acc[ai][bj][m][1] * scale;
                    u32x4 w; w.x = cvtpk(v0[0], v0[1]); w.y = cvtpk(v0[2], v0[3]); w.z = cvtpk(v1[0], v1[1]); w.w = cvtpk(v1[2], v1[3]);
                    *(u32x4*)(rowp + bj * HALF) = w; } }
    }
};
struct EpiKpe {
    static constexpr bool PERM = false;
    float* O; int pn0; float scale;
    __device__ __forceinline__ void operator()(const Acc& acc, const Unit& u, int wr, int wc, int fr, int fq) const {
        if (wc >= 2) return;
        const int kc = u.pn - pn0, row0 = u.pm * BM + wr * 64 + fr, col0 = wc * 32 + 4 * fq;
#pragma unroll
        for (int ai = 0; ai < 2; ++ai)
#pragma unroll
            for (int m = 0; m < 4; ++m) { float* rowp = O + ((size_t)kc * M + row0 + ai * HALF + m * 16) * 64 + col0;
#pragma unroll
                for (int n = 0; n < 2; ++n) *(f32x4*)(rowp + n * 16) = acc[ai][0][m][n] * scale; }
    }
};
struct EpiF32 {
    static constexpr bool PERM = false;
    float* O; int ldc; float scale;
    __device__ __forceinline__ void operator()(const Acc& acc, const Unit& u, int wr, int wc, int fr, int fq) const {
        const int row0 = u.pm * BM + wr * 64 + fr, col0 = u.pn * BM + wc * 32 + 4 * fq;
#pragma unroll
        for (int ai = 0; ai < 2; ++ai)
#pragma unroll
            for (int m = 0; m < 4; ++m) { float* rowp = O + (size_t)(row0 + ai * HALF + m * 16) * ldc + col0;
#pragma unroll
                for (int bj = 0; bj < 2; ++bj)
#pragma unroll
                    for (int n = 0; n < 2; ++n) *(f32x4*)(rowp + bj * HALF + n * 16) = acc[ai][bj][m][n] * scale; }
    }
};
struct EpiResidual {
    static constexpr bool PERM = false;
    const float* res; float* out; int ldc; float scale;
    __device__ __forceinline__ void operator()(const Acc& acc, const Unit& u, int wr, int wc, int fr, int fq) const {
        const int row0 = u.pm * BM + wr * 64 + fr, col0 = u.pn * BM + wc * 32 + 4 * fq;
        f32x4 ra[2][2][2], rb[2][2][2];
#define ER_LOAD(R, ai, mp) do { _Pragma("unroll") for (int m2 = 0; m2 < 2; ++m2) { const size_t off = (size_t)(row0 + (ai) * HALF + ((mp) * 2 + m2) * 16) * ldc + col0; \
            _Pragma("unroll") for (int bj = 0; bj < 2; ++bj) _Pragma("unroll") for (int n = 0; n < 2; ++n) R[m2][bj][n] = *(const f32x4*)(res + off + bj * HALF + n * 16); } } while (0)
#define ER_STORE(R, ai, mp) do { _Pragma("unroll") for (int m2 = 0; m2 < 2; ++m2) { const size_t off = (size_t)(row0 + (ai) * HALF + ((mp) * 2 + m2) * 16) * ldc + col0; \
            _Pragma("unroll") for (int bj = 0; bj < 2; ++bj) _Pragma("unroll") for (int n = 0; n < 2; ++n) *(f32x4*)(out + off + bj * HALF + n * 16) = R[m2][bj][n] + acc[ai][bj][(mp) * 2 + m2][n] * scale; } } while (0)
        ER_LOAD(ra, 0, 0);
        ER_LOAD(rb, 0, 1); ER_STORE(ra, 0, 0);
        ER_LOAD(ra, 1, 0); ER_STORE(rb, 0, 1);
        ER_LOAD(rb, 1, 1); ER_STORE(ra, 1, 0);
        ER_STORE(rb, 1, 1);
#undef ER_LOAD
#undef ER_STORE
    }
};
template <int FP8OUT>
struct EpiSwiglu {
    static constexpr bool PERM = true;
    void* H; int ldc; float in_scale, out_scale;
    __device__ __forceinline__ void operator()(const Acc& acc, const Unit& u, int wr, int wc, int fr, int fq) const {
        const int row0 = u.pm * BM + wr * 64 + fr, col0 = u.pn * HALF + wc * 32 + 8 * fq;
        const float k_ = in_scale * in_scale * out_scale, c1 = -in_scale * 1.4426950408889634f, c0 = -__builtin_log2f(k_), c3 = 1.0f / k_;
#pragma unroll
        for (int ai = 0; ai < 2; ++ai)
#pragma unroll
            for (int m = 0; m < 4; ++m) { const size_t off = (size_t)(row0 + ai * HALF + m * 16) * ldc + col0;
                float h[8];
#pragma unroll
                for (int n = 0; n < 2; ++n)
#pragma unroll
                    for (int e = 0; e < 4; ++e) { const float a0 = acc[ai][0][m][n][e], a1 = acc[ai][1][m][n][e];
                        h[n * 4 + e] = (a0 * a1) * __builtin_amdgcn_rcpf(c3 + __builtin_amdgcn_exp2f(fmaf(a0, c1, c0))); }
                if constexpr (FP8OUT == 2) { u32x2 w; w.x = pk4_i8(h[0], h[1], h[2], h[3]); w.y = pk4_i8(h[4], h[5], h[6], h[7]); *(u32x2*)((unsigned char*)H + off) = w; }
                else if constexpr (FP8OUT == 1) { u32x2 w; w.x = pk4_fp8_nc(h[0], h[1], h[2], h[3]); w.y = pk4_fp8_nc(h[4], h[5], h[6], h[7]); *(u32x2*)((unsigned char*)H + off) = w; }
                else { u32x4 w; w.x = cvtpk(h[0], h[1]); w.y = cvtpk(h[2], h[3]); w.z = cvtpk(h[4], h[5]); w.w = cvtpk(h[6], h[7]); *(u32x4*)((bf16_t*)H + off) = w; } }
    }
};
struct EpiGate {
    static constexpr bool PERM = true;
    const bf16_t* XC; const float* b_a; const float* b_x; const float* csp; unsigned* AB;
    __device__ __forceinline__ void operator()(const Acc& acc, const Unit& u, int wr, int wc, int fr, int fq) const {
        const int row0 = u.pm * BM + wr * 64 + fr, c0 = u.pn * HALF + wc * 32 + 8 * fq;
#pragma unroll
        for (int n = 0; n < 2; ++n) {
            const f32x4 ba = *(const f32x4*)(b_a + c0 + 4 * n) * -1.4426950408889634f, bx = *(const f32x4*)(b_x + c0 + 4 * n) * -1.4426950408889634f, sp = *(const f32x4*)(csp + c0 + 4 * n);
            u32x2 xws[2][4];
#pragma unroll
            for (int ai = 0; ai < 2; ++ai)
#pragma unroll
                for (int m = 0; m < 4; ++m) xws[ai][m] = *(const u32x2*)(XC + (size_t)(row0 + ai * HALF + m * 16) * D + c0 + 4 * n);
#pragma unroll
            for (int ai = 0; ai < 2; ++ai)
#pragma unroll
                for (int m = 0; m < 4; ++m) { const size_t off = (size_t)(row0 + ai * HALF + m * 16) * D + c0 + 4 * n;
                    const u32x2 xw = xws[ai][m];
                    const float xc[4] = {bflo(xw.x), bfhi(xw.x), bflo(xw.y), bfhi(xw.y)};
                    u32x4 pk;
#pragma unroll
                    for (int e = 0; e < 4; ++e) {
                        const float r = __builtin_amdgcn_rcpf(1.0f + __builtin_amdgcn_exp2f(fmaf(acc[ai][0][m][n][e], -1.4426950408889634f, ba[e]))), ig = __builtin_amdgcn_rcpf(1.0f + __builtin_amdgcn_exp2f(fmaf(acc[ai][1][m][n][e], -1.4426950408889634f, bx[e])));
                        const float la2 = -sp[e] * r;
                        const float om = fmaxf(1.0f - __builtin_amdgcn_exp2f(la2 + la2), 0.0f);
                        pk[e] = cvtpk(la2, __builtin_amdgcn_sqrtf(om) * ig * xc[e]); }
                    *(u32x4*)(AB + off) = pk; }
        }
    }
};

template <class Epi, class Sched>
__device__ __forceinline__ void gemm_phase(LAS unsigned char* lds, const Gemm g, const Sched& S, const Epi& E) {
    const int tid = opaque_tid(), wid = __builtin_amdgcn_readfirstlane(tid >> 6), lane = tid & 63, wr = wid >> 2, wc = wid & 3, fr = lane & 15, fq = lane >> 4;
    const int K = g.K, nt = K / BK;
    unsigned voffA[2], voffB[2];
#pragma unroll
    for (int i = 0; i < 2; ++i) { int R, C; stage_rc(tid * 16 + i * 8192, R, C); const int Rb = Epi::PERM ? ((R & ~31) + perm32(R & 31)) : R;
        voffA[i] = (unsigned)(R * g.lda + C) * 2u; voffB[i] = (unsigned)(Rb * g.ldb + C) * 2u; }
    const size_t kstep = (size_t)(BK * 2);
    const size_t hstepA = (size_t)HALF * g.lda * 2, hstepB = (size_t)HALF * g.ldb * 2;
    const unsigned ldsw = (unsigned)wid * 1024u;
    const int aoff = lds_byte(wr * 64 + fr, fq * 8), boff = lds_byte(wc * 32 + fr, fq * 8);
#define PG8_SA(b, h) (((b) * 2 + (h)) * HTB)
#define PG8_SB(b, h) ((4 + (b) * 2 + (h)) * HTB)
#define PG8_STAGE(bufoff, gbase, voff) do { _Pragma("unroll") for (int _i = 0; _i < 2; ++_i) \
        __builtin_amdgcn_global_load_lds((const unsigned*)((const char*)(gbase) + (voff)[_i]), (LAS unsigned*)(lds + (bufoff) + ldsw + _i * 8192), 16, 0, 0); } while (0)
#define PG8_LDA(dst, b, h) do { _Pragma("unroll") for (int m = 0; m < 4; ++m) _Pragma("unroll") for (int k = 0; k < 2; ++k) dst[m][k] = *(const LAS bf16x8*)(lds + PG8_SA(b, h) + aoff + m * 2048 + k * 1024); } while (0)
#define PG8_LDB(dst, b, h) do { _Pragma("unroll") for (int n = 0; n < 2; ++n) _Pragma("unroll") for (int k = 0; k < 2; ++k) dst[n][k] = *(const LAS bf16x8*)(lds + PG8_SB(b, h) + boff + n * 2048 + k * 1024); } while (0)
#define PG8_MMA(ai, bj, At, Bt) do { __builtin_amdgcn_s_setprio(1); _Pragma("unroll") for (int m = 0; m < 4; ++m) _Pragma("unroll") for (int n = 0; n < 2; ++n) _Pragma("unroll") for (int k = 0; k < 2; ++k) \
        acc[ai][bj][m][n] = __builtin_amdgcn_mfma_f32_16x16x32_bf16(Bt[n][k], At[m][k], acc[ai][bj][m][n], 0, 0, 0); __builtin_amdgcn_s_setprio(0); } while (0)
#define PG8_WAIT_V(n) asm volatile("s_waitcnt vmcnt(" #n ")" ::: "memory")
#define PG8_WAIT_L(n) asm volatile("s_waitcnt lgkmcnt(" #n ")" ::: "memory")
#define PG8_BAR __builtin_amdgcn_s_barrier()
#define PG8_SCHED __builtin_amdgcn_sched_barrier(0)
    Unit cur, nxt; int ui = 0;
    if (!S.next(0, cur)) return;
    Acc acc;
#pragma unroll
    for (int a = 0; a < 2; ++a)
#pragma unroll
        for (int b = 0; b < 2; ++b)
#pragma unroll
            for (int m = 0; m < 4; ++m)
#pragma unroll
                for (int n = 0; n < 2; ++n) acc[a][b][m][n] = (f32x4){0.f, 0.f, 0.f, 0.f};
    bf16x8 At[4][2], B0[2][2], B1[2][2];
    const char* cA = (const char*)g.A + cur.aoff; const char* cB = (const char*)g.Bt + cur.boff;
    S.a_ready(cur);
    PG8_STAGE(PG8_SB(0, 0), cB, voffB); PG8_STAGE(PG8_SB(0, 1), cB + hstepB, voffB); PG8_STAGE(PG8_SA(0, 0), cA, voffA); PG8_STAGE(PG8_SA(0, 1), cA + hstepA, voffA);
    if (wr == 1) PG8_BAR;
    PG8_WAIT_V(2); PG8_BAR;
    PG8_STAGE(PG8_SB(1, 0), cB + kstep, voffB); PG8_STAGE(PG8_SA(1, 0), cA + kstep, voffA); PG8_STAGE(PG8_SB(1, 1), cB + hstepB + kstep, voffB);
    PG8_WAIT_V(6); PG8_BAR;
    for (;;) {
        const bool has_next = S.next(ui + 1, nxt);
        const char* nA = has_next ? (const char*)g.A + nxt.aoff : cA; const char* nB = has_next ? (const char*)g.Bt + nxt.boff : cB;
#pragma nounroll
        for (int t = 0; t < nt; t += 2) {
            const bool last = (t == nt - 2);
            const char* a1 = cA + (size_t)(t + 1) * kstep;
            const char* a2 = last ? nA : cA + (size_t)(t + 2) * kstep; const char* b2 = last ? nB : cB + (size_t)(t + 2) * kstep;
            const char* a3 = a2 + kstep; const char* b3 = b2 + kstep;
            if (last && has_next) S.a_ready(nxt);
            PG8_LDB(B0, 0, 0); PG8_LDB(B1, 0, 1); PG8_SCHED; PG8_LDA(At, 0, 0); PG8_STAGE(PG8_SA(1, 1), a1 + hstepA, voffA);
            PG8_WAIT_V(8); PG8_WAIT_L(0); PG8_BAR; PG8_MMA(0, 0, At, B0); PG8_MMA(0, 1, At, B1); PG8_BAR; PG8_SCHED;
            PG8_LDA(At, 0, 1); PG8_STAGE(PG8_SB(0, 0), b2, voffB); PG8_STAGE(PG8_SB(0, 1), b2 + hstepB, voffB); PG8_STAGE(PG8_SA(0, 0), a2, voffA);
            PG8_WAIT_V(8); PG8_WAIT_L(0); PG8_BAR; PG8_MMA(1, 0, At, B0); PG8_MMA(1, 1, At, B1); PG8_BAR; PG8_SCHED;
            PG8_LDB(B0, 1, 0); PG8_LDB(B1, 1, 1); PG8_SCHED; PG8_LDA(At, 1, 0); PG8_STAGE(PG8_SA(0, 1), a2 + hstepA, voffA);
            PG8_WAIT_V(8); PG8_WAIT_L(0); PG8_BAR; PG8_MMA(0, 0, At, B0); PG8_MMA(0, 1, At, B1); PG8_BAR; PG8_SCHED;
            PG8_LDA(At, 1, 1); PG8_STAGE(PG8_SB(1, 0), b3, voffB); PG8_STAGE(PG8_SB(1, 1), b3 + hstepB, voffB); PG8_STAGE(PG8_SA(1, 0), a3, voffA);
            PG8_WAIT_V(8); PG8_WAIT_L(0); PG8_BAR; PG8_MMA(1, 0, At, B0); PG8_MMA(1, 1, At, B1); PG8_BAR; PG8_SCHED;
        }
        if (wr == 0) PG8_BAR;
        E(acc, cur, wr, wc, fr, fq); S.done(cur);
        if (!has_next) break;
#pragma unroll
        for (int a = 0; a < 2; ++a)
#pragma unroll
            for (int b = 0; b < 2; ++b)
#pragma unroll
                for (int m = 0; m < 4; ++m)
#pragma unroll
                    for (int n = 0; n < 2; ++n) acc[a][b][m][n] = (f32x4){0.f, 0.f, 0.f, 0.f};
        cur = nxt; cA = nA; cB = nB; ++ui;
        if (wr == 1) PG8_BAR;
    }
    PG8_WAIT_V(0);
    PG8_BAR;
#undef PG8_SA
#undef PG8_SB
#undef PG8_STAGE
#undef PG8_LDA
#undef PG8_LDB
#undef PG8_MMA
#undef PG8_WAIT_V
#undef PG8_WAIT_L
#undef PG8_BAR
#undef PG8_SCHED
}

__host__ __device__ __forceinline__ int g8(int rr) { const int q = rr >> 1; return ((2 * q) & 7) | (q >> 2); }
__host__ __device__ __forceinline__ void stage_rc8(int b, int& R, int& Cb) { const int s = b >> 11, rr = (b >> 7) & 15, p = (b >> 4) & 7; R = s * 16 + rr; Cb = (p ^ g8(rr)) << 4; }
__host__ __device__ __forceinline__ int lds_byte8(int r, int c) { const int rr = r & 15; return (r >> 4) * 2048 + rr * 128 + ((c ^ g8(rr)) << 4); }
template <bool FP6> struct Frag8 { typedef v8i T; };
template <> struct Frag8<true> { typedef v6i T; };
template <class Epi, class Sched, int MODE = 0>
__device__ __forceinline__ void gemm_phase8(LAS unsigned char* lds, const Gemm g, const Sched& S, const Epi& E) {
    constexpr bool FP6 = (MODE == 1);
    const int tid = opaque_tid(), wid = __builtin_amdgcn_readfirstlane(tid >> 6), lane = tid & 63, wr = wid >> 2, wc = wid & 3, fr = lane & 15, fq = lane >> 4;
    const int K = g.K, nt = K / 128;
    unsigned voffA[2], voffB[2];
#pragma unroll
    for (int i = 0; i < 2; ++i) { int R, C; stage_rc8(tid * 16 + i * 8192, R, C); const int Rb = Epi::PERM ? ((R & ~31) + perm32(R & 31)) : R;
        voffA[i] = (unsigned)(R * g.lda + C); voffB[i] = (unsigned)(Rb * g.ldb + C); }
    const size_t kstep = 128;
    const size_t hstepA = (size_t)HALF * g.lda, hstepB = (size_t)HALF * g.ldb;
    const unsigned ldsw = (unsigned)wid * 1024u;
    const int aoff0 = lds_byte8(wr * 64 + fr, 2 * fq), aoff1 = lds_byte8(wr * 64 + fr, 2 * fq + 1), boff0 = lds_byte8(wc * 32 + fr, 2 * fq), boff1 = lds_byte8(wc * 32 + fr, 2 * fq + 1);
#define PG8_SA(b, h) (((b) * 2 + (h)) * HTB)
#define PG8_SB(b, h) ((4 + (b) * 2 + (h)) * HTB)
#define PG8_STAGE(bufoff, gbase, voff) do { _Pragma("unroll") for (int _i = 0; _i < 2; ++_i) \
        __builtin_amdgcn_global_load_lds((const unsigned*)((const char*)(gbase) + (voff)[_i]), (LAS unsigned*)(lds + (bufoff) + ldsw + _i * 8192), 16, 0, 0); } while (0)
#define PG8_LD1(dst, off0, off1) do { const v4i lo_ = *(const LAS v4i*)(lds + (off0)); \
        if constexpr (FP6) { const v2i hi_ = *(const LAS v2i*)(lds + (off1)); dst = (v6i){lo_[0], lo_[1], lo_[2], lo_[3], hi_[0], hi_[1]}; } \
        else { const v4i hi_ = *(const LAS v4i*)(lds + (off1)); dst = __builtin_shufflevector(lo_, hi_, 0, 1, 2, 3, 4, 5, 6, 7); } } while (0)
#define PG8_LDA(dst, b, h) do { _Pragma("unroll") for (int m = 0; m < 4; ++m) PG8_LD1(dst[m], PG8_SA(b, h) + aoff0 + m * 2048, PG8_SA(b, h) + aoff1 + m * 2048); } while (0)
#define PG8_LDB(dst, b, h) do { _Pragma("unroll") for (int n = 0; n < 2; ++n) PG8_LD1(dst[n], PG8_SB(b, h) + boff0 + n * 2048, PG8_SB(b, h) + boff1 + n * 2048); } while (0)
#define PG8_MMA(ai, bj, At, Bt) do { __builtin_amdgcn_s_setprio(1); \
        if constexpr (MODE == 2) { \
            _Pragma("unroll") for (int m = 0; m < 4; ++m) _Pragma("unroll") for (int n = 0; n < 2; ++n) { const v4i bl_ = __builtin_shufflevector(Bt[n], Bt[n], 0, 1, 2, 3), al_ = __builtin_shufflevector(At[m], At[m], 0, 1, 2, 3); \
                asm volatile("v_mfma_i32_16x16x64_i8 %0, %1, %2, %0" : "+v"(acc[ai][bj][m][n]) : "v"(bl_), "v"(al_)); } \
            _Pragma("unroll") for (int m = 0; m < 4; ++m) _Pragma("unroll") for (int n = 0; n < 2; ++n) { const v4i bh_ = __builtin_shufflevector(Bt[n], Bt[n], 4, 5, 6, 7), ah_ = __builtin_shufflevector(At[m], At[m], 4, 5, 6, 7); \
                asm volatile("v_mfma_i32_16x16x64_i8 %0, %1, %2, %0" : "+v"(acc[ai][bj][m][n]) : "v"(bh_), "v"(ah_)); } \
        } else { _Pragma("unroll") for (int m = 0; m < 4; ++m) _Pragma("unroll") for (int n = 0; n < 2; ++n) \
        { if constexpr (MODE == 1) asm volatile("v_mfma_f32_16x16x128_f8f6f4 %0, %1, %2, %0 cbsz:2 blgp:2" : "+v"(acc[ai][bj][m][n]) : "v"(Bt[n]), "v"(At[m])); \
          else asm volatile("v_mfma_f32_16x16x128_f8f6f4 %0, %1, %2, %0" : "+v"(acc[ai][bj][m][n]) : "v"(Bt[n]), "v"(At[m])); } } __builtin_amdgcn_s_setprio(0); } while (0)
#define PG8_WAIT_V(n) asm volatile("s_waitcnt vmcnt(" #n ")" ::: "memory")
#define PG8_WAIT_L(n) asm volatile("s_waitcnt lgkmcnt(" #n ")" ::: "memory")
#define PG8_BAR __builtin_amdgcn_s_barrier()
#define PG8_SCHED __builtin_amdgcn_sched_barrier(0)
    Unit cur, nxt; int ui = 0;
    if (!S.next(0, cur)) return;
    Acc acc;
#pragma unroll
    for (int a = 0; a < 2; ++a)
#pragma unroll
        for (int b = 0; b < 2; ++b)
#pragma unroll
            for (int m = 0; m < 4; ++m)
#pragma unroll
                for (int n = 0; n < 2; ++n) acc[a][b][m][n] = (f32x4){0.f, 0.f, 0.f, 0.f};
    typename Frag8<FP6>::T At[4], B0[2], B1[2];
    const char* cA = (const char*)g.A + cur.aoff; const char* cB = (const char*)g.Bt + cur.boff;
    S.a_ready(cur);
    PG8_STAGE(PG8_SB(0, 0), cB, voffB); PG8_STAGE(PG8_SB(0, 1), cB + hstepB, voffB); PG8_STAGE(PG8_SA(0, 0), cA, voffA); PG8_STAGE(PG8_SA(0, 1), cA + hstepA, voffA);
    if (wr == 1) PG8_BAR;
    PG8_WAIT_V(2); PG8_BAR;
    PG8_STAGE(PG8_SB(1, 0), cB + kstep, voffB); PG8_STAGE(PG8_SA(1, 0), cA + kstep, voffA); PG8_STAGE(PG8_SB(1, 1), cB + hstepB + kstep, voffB);
    PG8_WAIT_V(6); PG8_BAR;
    for (;;) {
        const bool has_next = S.next(ui + 1, nxt);
        const char* nA = has_next ? (const char*)g.A + nxt.aoff : cA; const char* nB = has_next ? (const char*)g.Bt + nxt.boff : cB;
#pragma nounroll
        for (int t = 0; t < nt; t += 2) {
            const bool last = (t == nt - 2);
            const char* a1 = cA + (size_t)(t + 1) * kstep;
            const char* a2 = last ? nA : cA + (size_t)(t + 2) * kstep; const char* b2 = last ? nB : cB + (size_t)(t + 2) * kstep;
            const char* a3 = a2 + kstep; const char* b3 = b2 + kstep;
            if (last && has_next) S.a_ready(nxt);
            PG8_LDB(B0, 0, 0); PG8_LDB(B1, 0, 1); PG8_SCHED; PG8_LDA(At, 0, 0); PG8_STAGE(PG8_SA(1, 1), a1 + hstepA, voffA);
            PG8_WAIT_V(8); PG8_WAIT_L(0); PG8_BAR; PG8_MMA(0, 0, At, B0); PG8_MMA(0, 1, At, B1); PG8_BAR; PG8_SCHED;
            PG8_LDA(At, 0, 1); PG8_STAGE(PG8_SB(0, 0), b2, voffB); PG8_STAGE(PG8_SB(0, 1), b2 + hstepB, voffB); PG8_STAGE(PG8_SA(0, 0), a2, voffA);
            PG8_WAIT_V(8); PG8_WAIT_L(0); PG8_BAR; PG8_MMA(1, 0, At, B0); PG8_MMA(1, 1, At, B1); PG8_BAR; PG8_SCHED;
            PG8_LDB(B0, 1, 0); PG8_LDB(B1, 1, 1); PG8_SCHED; PG8_LDA(At, 1, 0); PG8_STAGE(PG8_SA(0, 1), a2 + hstepA, voffA);
            PG8_WAIT_V(8); PG8_WAIT_L(0); PG8_BAR; PG8_MMA(0, 0, At, B0); PG8_MMA(0, 1, At, B1); PG8_BAR; PG8_SCHED;
            PG8_LDA(At, 1, 1); PG8_STAGE(PG8_SB(1, 0), b3, voffB); PG8_STAGE(PG8_SB(1, 1), b3 + hstepB, voffB); PG8_STAGE(PG8_SA(1, 0), a3, voffA);
            PG8_WAIT_V(8); PG8_WAIT_L(0); PG8_BAR; PG8_MMA(1, 0, At, B0); PG8_MMA(1, 1, At, B1); PG8_BAR; PG8_SCHED;
        }
        asm volatile("s_nop 15\n\ts_nop 15" ::: "memory");
        if (wr == 0) PG8_BAR;
        if constexpr (MODE == 2) {
#pragma unroll
            for (int a = 0; a < 2; ++a)
#pragma unroll
                for (int b = 0; b < 2; ++b)
#pragma unroll
                    for (int m = 0; m < 4; ++m)
#pragma unroll
                        for (int n = 0; n < 2; ++n)
                        { const f32x4 t_ = acc[a][b][m][n]; f32x4 r_;
                          r_.x = (float)__float_as_int(t_.x); r_.y = (float)__float_as_int(t_.y); r_.z = (float)__float_as_int(t_.z); r_.w = (float)__float_as_int(t_.w); acc[a][b][m][n] = r_; }
        }
        E(acc, cur, wr, wc, fr, fq); S.done(cur);
        if (!has_next) break;
#pragma unroll
        for (int a = 0; a < 2; ++a)
#pragma unroll
            for (int b = 0; b < 2; ++b)
#pragma unroll
                for (int m = 0; m < 4; ++m)
#pragma unroll
                    for (int n = 0; n < 2; ++n) acc[a][b][m][n] = (f32x4){0.f, 0.f, 0.f, 0.f};
        cur = nxt; cA = nA; cB = nB; ++ui;
        if (wr == 1) PG8_BAR;
    }
    PG8_WAIT_V(0);
    PG8_BAR;
#undef PG8_SA
#undef PG8_SB
#undef PG8_STAGE
#undef PG8_LDA
#undef PG8_LD1
#undef PG8_LDB
#undef PG8_MMA
#undef PG8_WAIT_V
#undef PG8_WAIT_L
#undef PG8_BAR
#undef PG8_SCHED
}
}

namespace att {
constexpr int KROW = 208, KBUF = 64 * KROW,     VROW = 80, VBUF = 128 * VROW,     VOFF = 2 * KBUF, LDS_TOTAL = VOFF + 3 * VBUF;
static_assert(LDS_TOTAL <= RING_BYTES, "attention LDS");
constexpr float THR = 4.5f, PSH = 4.f, QS8 = 16.f, OSC8 = 16.f;
__device__ __forceinline__ int crow(int r, int hi) { return (r & 3) + 8 * (r >> 2) + 4 * hi; }

constexpr int CV_KB = FF / 128, CV_NB = D / 16, CV_ITEMS = NE * CV_NB * CV_KB, CV_IPW = CV_ITEMS / (GRID * NWAVES);
static_assert(CV_ITEMS % (GRID * NWAVES) == 0 && CV_KB % CV_IPW == 0, "MoE-down conversion items per wave");
constexpr float CV_WS = 64.f;
struct CvtState { const float* W; unsigned char* WT; int next, end; };
__device__ __forceinline__ void cvt_load(const CvtState& cs, int lane, f32x4 (&v)[8]) {
    const int kb = cs.next % CV_KB, tmp = cs.next / CV_KB, nb = tmp % CV_NB, e = tmp / CV_NB;
    const float* src = cs.W + ((size_t)e * FF + (size_t)(128 * kb + 8 * (lane >> 2))) * D + 16 * nb + 4 * (lane & 3);
#pragma unroll
    for (int i = 0; i < 8; ++i) v[i] = *(const f32x4*)(src + (size_t)i * D);
}
__device__ __forceinline__ void cvt_store(CvtState& cs, int lane, const f32x4 (&v)[8]) {
    const int kb = cs.next % CV_KB, tmp = cs.next / CV_KB, nb = tmp % CV_NB, e = tmp / CV_NB;
    unsigned char* dst = cs.WT + ((size_t)e * D + (size_t)(16 * nb + 4 * (lane & 3))) * FF + 128 * kb + 8 * (lane >> 2);
#pragma unroll
    for (int j = 0; j < 4; ++j) { u32x2 w; w.x = pk4_fp8(v[0][j] * CV_WS, v[1][j] * CV_WS, v[2][j] * CV_WS, v[3][j] * CV_WS); w.y = pk4_fp8(v[4][j] * CV_WS, v[5][j] * CV_WS, v[6][j] * CV_WS, v[7][j] * CV_WS);
        *(u32x2*)(dst + (size_t)j * FF) = w; }
    ++cs.next;
}

__device__ __forceinline__ void attn_unit(LAS unsigned char* lds, const unsigned char* Q, const unsigned char* KV, const bf16_t* KPE, const float* CST, bf16_t* O, int b, int h, int qb, CvtState& cs) {
    const int tid = opaque_tid(), wid = __builtin_amdgcn_readfirstlane(tid >> 6), lane = tid & 63, r32 = lane & 31, hi = lane >> 5;
    const bool lag = wid >= 4;
    if (lag) __builtin_amdgcn_s_setprio(1);
    const size_t rowb = (size_t)b * SEQ;
    const int qlo = qb * 256 + wid * 32;
    v8i qf[3];
    const unsigned qo = (unsigned)((rowb + qlo + r32) * (NH * QKD) + h * QKD + hi * 32);
    { const v4i a0 = *(const v4i*)((const char*)Q + qo), a1 = *(const v4i*)((const char*)Q + qo + 16), b0 = *(const v4i*)((const char*)Q + qo + 64), b1 = *(const v4i*)((const char*)Q + qo + 80);
      qf[0] = __builtin_shufflevector(a0, a1, 0, 1, 2, 3, 4, 5, 6, 7); qf[1] = __builtin_shufflevector(b0, b1, 0, 1, 2, 3, 4, 5, 6, 7); }
    { const float* cst = CST + (size_t)(rowb + qlo + r32) * 64;
      const v4i t0 = *(const v4i*)((const char*)Q + qo + 128), t1 = *(const v4i*)((const char*)Q + qo + 144);
#pragma unroll
      for (int d = 0; d < 8; ++d) {
          const int own = (d < 4) ? t0[d & 3] : t1[d & 3];
          const auto rr = __builtin_amdgcn_permlane32_swap((unsigned)own, (unsigned)own, false, false); const int par = (int)(rr[0] ^ rr[1]) ^ own;
          const f32x4 c = *(const f32x4*)(cst + 4 * d); f32x4 sn = *(const f32x4*)(cst + 32 + 4 * d);
          if (hi == 0) sn = -sn;
          const float o0 = __builtin_amdgcn_cvt_f32_fp8(own, 0) * c[0] + __builtin_amdgcn_cvt_f32_fp8(par, 0) * sn[0], o1 = __builtin_amdgcn_cvt_f32_fp8(own, 1) * c[1] + __builtin_amdgcn_cvt_f32_fp8(par, 1) * sn[1];
          const float o2 = __builtin_amdgcn_cvt_f32_fp8(own, 2) * c[2] + __builtin_amdgcn_cvt_f32_fp8(par, 2) * sn[2], o3 = __builtin_amdgcn_cvt_f32_fp8(own, 3) * c[3] + __builtin_amdgcn_cvt_f32_fp8(par, 3) * sn[3];
          qf[2][d] = (int)pk4_fp8(o0, o1, o2, o3); } }
    const int NT = 4 * (qb + 1);
    const int sr = tid >> 4, sc = (tid & 15) * 8, pr = tid >> 3, pc = (tid & 7) * 8;
    const unsigned kvo = (unsigned)((rowb + sr) * 4096 + h * 256 + sc);
    const unsigned kpo = (unsigned)(((rowb + pr) * 64 + pc) * 2);
    const int kw0 = sr * KROW + sc, kw1 = (sr + 32) * KROW + sc, kwp = pr * KROW + 128 + pc;
    const int vkg = (wid & 3) * 4 + (lane >> 4), vdg = (wid >> 2) * 16 + (lane & 15);
    const unsigned kvv = (unsigned)((rowb + 4 * vkg) * 4096 + h * 256 + 128 + 4 * vdg);
    const int vw = VOFF + 4 * vdg * VROW + (vkg & 1) * 32 + (((vkg >> 3) * 4 + ((vkg & 7) >> 1)) * 4);
    u32x2 sk0, sk1; bf16x8 skp; unsigned sv0, sv1, sv2, sv3;
#define ATT_LOAD(t) do { const unsigned k1_ = kvo + (unsigned)(t) * (64u * 4096u), k2_ = kpo + (unsigned)(t) * (64u * 128u); const char* kvb_ = (const char*)KV; \
        const unsigned k3_ = kvv + (unsigned)(t) * (64u * 4096u); \
        sk0 = *(const u32x2*)(kvb_ + k1_); sk1 = *(const u32x2*)(kvb_ + k1_ + 32u * 4096u); skp = *(const bf16x8*)((const char*)KPE + k2_); \
        sv0 = *(const unsigned*)(kvb_ + k3_); sv1 = *(const unsigned*)(kvb_ + k3_ + 4096u); sv2 = *(const unsigned*)(kvb_ + k3_ + 2u * 4096u); sv3 = *(const unsigned*)(kvb_ + k3_ + 3u * 4096u); } while (0)
#define B8_(x_, y_) ({ const unsigned bx_ = (x_), by_ = (y_); __builtin_bit_cast(unsigned, __builtin_amdgcn_cvt_scalef32_pk_fp8_bf16(__builtin_amdgcn_cvt_scalef32_pk_fp8_bf16((v2s){0, 0}, __builtin_bit_cast(v2bf, bx_), 1.0f, false), __builtin_bit_cast(v2bf, by_), 1.0f, true)); })
#define K8_(S) ({ const u32x4 t_ = __builtin_bit_cast(u32x4, S); u32x2 w_; w_.x = B8_(t_.x, t_.y); w_.y = B8_(t_.z, t_.w); w_; })
#define VL_(a_, b_) __builtin_amdgcn_perm(b_, a_, 0x05040100u)
#define VH_(a_, b_) __builtin_amdgcn_perm(b_, a_, 0x07060302u)
#define V8_(a_, b_, c_, d_) ((unsigned)__builtin_amdgcn_cvt_pk_fp8_f32(c_, d_, __builtin_amdgcn_cvt_pk_fp8_f32(a_, b_, 0, false), true))
#define ATT_WRITE(kb, vb) do { LAS unsigned char* kb_ = lds + (kb) * KBUF; LAS unsigned char* vb_ = lds + (vb) * VBUF; *(LAS u32x2*)(kb_ + kw0) = sk0; *(LAS u32x2*)(kb_ + kw1) = sk1; *(LAS u32x2*)(kb_ + kwp) = K8_(skp); \
        const unsigned a_ = __builtin_amdgcn_perm(sv1, sv0, 0x05010400u), b_ = __builtin_amdgcn_perm(sv3, sv2, 0x05010400u), c_ = __builtin_amdgcn_perm(sv1, sv0, 0x07030602u), d_ = __builtin_amdgcn_perm(sv3, sv2, 0x07030602u); \
        *(LAS unsigned*)(vb_ + vw) = VL_(a_, b_); *(LAS unsigned*)(vb_ + vw + VROW) = VH_(a_, b_); *(LAS unsigned*)(vb_ + vw + 2 * VROW) = VL_(c_, d_); *(LAS unsigned*)(vb_ + vw + 3 * VROW) = VH_(c_, d_); } while (0)
    ATT_LOAD(0); ATT_WRITE(0, 0);
    __syncthreads();
    float m_reg = -1e30f, l_reg = 0.f;
    f32x16 o[4];
#pragma unroll
    for (int d = 0; d < 4; ++d)
#pragma unroll
        for (int r = 0; r < 16; ++r) o[d][r] = 0.f;
    const unsigned vrd = (unsigned)(uintptr_t)lds + (unsigned)(VOFF + r32 * VROW + hi * 32);
#define DSR(dst, addr, off) asm volatile("ds_read_b128 %0, %1 offset:%2" : "=v"(dst) : "v"(addr), "i"(off))
#define DSW4(n, a, b, c, d) asm volatile("s_waitcnt lgkmcnt(" #n ")" : "+v"(a), "+v"(b), "+v"(c), "+v"(d))
#define CAT8(a, b) __builtin_shufflevector(a, b, 0, 1, 2, 3, 4, 5, 6, 7)
#define MMA8(A, B, C) __builtin_amdgcn_mfma_scale_f32_32x32x64_f8f6f4(A, B, C, 0, 0, 0, 0, 0, 0)
    v8i pf = {0, 0, 0, 0, 0, 0, 0, 0};
    bool pend = false; int vs = 0;
    v4i va0, va1, va2, va3, va4, va5, va6, va7;
#define PV_READ(slot) do { const unsigned vb0 = vrd + (unsigned)((slot) * VBUF); DSR(va0, vb0, 0); DSR(va1, vb0, 16); DSR(va2, vb0, 32 * VROW); DSR(va3, vb0, 32 * VROW + 16); \
        DSR(va4, vb0, 64 * VROW); DSR(va5, vb0, 64 * VROW + 16); DSR(va6, vb0, 96 * VROW); DSR(va7, vb0, 96 * VROW + 16); } while (0)
#define PV_MMA() do { DSW4(4, va0, va1, va2, va3); o[0] = MMA8(CAT8(va0, va1), pf, o[0]); o[1] = MMA8(CAT8(va2, va3), pf, o[1]); \
        DSW4(0, va4, va5, va6, va7); o[2] = MMA8(CAT8(va4, va5), pf, o[2]); o[3] = MMA8(CAT8(va6, va7), pf, o[3]); } while (0)
    f32x4 cv[8]; bool cvt_pend = false;
    for (int t = 0; t < NT; ++t) {
        if (t + 1 < NT) ATT_LOAD(t + 1);
        if (cvt_pend) { cvt_store(cs, lane, cv); cvt_pend = false; }
        if (lag && pend) { PV_MMA(); pend = false; }
        const int kb0 = t * 64;
        const bool cvt_now = ((t & 3) == 0) && cs.next < cs.end;
        if (cvt_now && !(kb0 <= qlo + 31)) cvt_load(cs, lane, cv);
        if (kb0 <= qlo + 31) {
            const unsigned ka = (unsigned)(uintptr_t)lds + (unsigned)((t & 1) * KBUF + r32 * KROW + hi * 32);
            f32x16 p0, p1;
#pragma unroll
            for (int r = 0; r < 16; ++r) { p0[r] = 0.f; p1[r] = 0.f; }
            { v4i k0, k1, k2, k3, k4, k5, k6, k7, k8, k9, k10, k11;
              DSR(k0, ka, 0); DSR(k1, ka, 16); DSR(k2, ka, 32 * KROW); DSR(k3, ka, 32 * KROW + 16);
              DSR(k4, ka, 64); DSR(k5, ka, 80); DSR(k6, ka, 32 * KROW + 64); DSR(k7, ka, 32 * KROW + 80);
              DSR(k8, ka, 128); DSR(k9, ka, 144); DSR(k10, ka, 32 * KROW + 128); DSR(k11, ka, 32 * KROW + 144);
              DSW4(8, k0, k1, k2, k3);
              p0 = MMA8(CAT8(k0, k1), qf[0], p0); p1 = MMA8(CAT8(k2, k3), qf[0], p1);
              PV_READ(vs);
              DSW4(12, k4, k5, k6, k7);
              p0 = MMA8(CAT8(k4, k5), qf[1], p0); p1 = MMA8(CAT8(k6, k7), qf[1], p1);
              DSW4(8, k8, k9, k10, k11);
              p0 = MMA8(CAT8(k8, k9), qf[2], p0); p1 = MMA8(CAT8(k10, k11), qf[2], p1); }
            if (cvt_now) cvt_load(cs, lane, cv);
            if (kb0 + 63 > qlo) {
                const int dq = qlo + r32 - 4 * hi - kb0; const float NEG = -__builtin_inff();
#pragma unroll
                for (int r = 0; r < 16; ++r) { const int c = (r & 3) + 8 * (r >> 2); if (dq - c < 0) p0[r] = NEG; if (dq - c - 32 < 0) p1[r] = NEG; }
            }
            float pmax = p0[0];
#pragma unroll
            for (int r = 1; r < 16; ++r) pmax = fmaxf(pmax, p0[r]);
#pragma unroll
            for (int r = 0; r < 16; ++r) pmax = fmaxf(pmax, p1[r]);
            { auto rr = __builtin_amdgcn_permlane32_swap(__float_as_uint(pmax), __float_as_uint(pmax), false, false); pmax = fmaxf(__uint_as_float(rr[0]), __uint_as_float(rr[1])); }
            float mn, alpha;
            constexpr float QI8 = 1.0f / QS8;
            if (__all((pmax - m_reg) <= THR * QS8)) { mn = m_reg; alpha = 1.f; }
            else { mn = fmaxf(m_reg, pmax); alpha = __builtin_amdgcn_exp2f((m_reg - mn) * QI8); m_reg = mn; }
            const float mnq = PSH - mn * QI8;
            float ps = 0.f;
#pragma unroll
            for (int r = 0; r < 16; ++r) { p0[r] = __builtin_amdgcn_exp2f(fmaf(p0[r], QI8, mnq)); ps += p0[r]; }
#pragma unroll
            for (int r = 0; r < 16; ++r) { p1[r] = __builtin_amdgcn_exp2f(fmaf(p1[r], QI8, mnq)); ps += p1[r]; }
            { auto rr = __builtin_amdgcn_permlane32_swap(__float_as_uint(ps), __float_as_uint(ps), false, false); ps = __uint_as_float(rr[0]) + __uint_as_float(rr[1]); }
            l_reg = l_reg * alpha + ps;
            if (__any(alpha < 1.f)) {
#pragma unroll
                for (int d = 0; d < 4; ++d)
#pragma unroll
                    for (int r = 0; r < 16; ++r) o[d][r] *= alpha;
            }
#pragma unroll
            for (int i = 0; i < 4; ++i) { pf[i] = (int)V8_(p0[4 * i], p0[4 * i + 1], p0[4 * i + 2], p0[4 * i + 3]); pf[4 + i] = (int)V8_(p1[4 * i], p1[4 * i + 1], p1[4 * i + 2], p1[4 * i + 3]); }
            if (!lag) PV_MMA(); else pend = true;
        }
        if (cvt_now) cvt_pend = true;
        const int vn = (vs == 2) ? 0 : vs + 1;
        if (t + 1 < NT) ATT_WRITE((t + 1) & 1, vn);
        asm volatile("s_waitcnt lgkmcnt(0)" ::: "memory");
        __syncthreads();
        vs = vn;
    }
    if (lag && pend) PV_MMA();
    if (cvt_pend) cvt_store(cs, lane, cv);
    __builtin_amdgcn_s_setprio(0);
    __syncthreads();
#undef PV_READ
#undef PV_MMA
#undef DSR
#undef DSW4
#undef CAT8
#undef MMA8
#undef ATT_LOAD
#undef ATT_WRITE
#undef K8_
#undef V8_
#undef B8_
#undef VL_
#undef VH_
    { const float rl = __builtin_amdgcn_rcpf(l_reg) * OSC8;
      const unsigned oo = (unsigned)((rowb + qlo + r32) * D + h * VDIM + 4 * hi);
#pragma unroll
      for (int d0 = 0; d0 < 4; ++d0)
#pragma unroll
          for (int j = 0; j < 4; ++j)
              *(unsigned*)((char*)O + oo + (unsigned)(d0 * 32 + j * 8)) = pk4_fp8(o[d0][4 * j] * rl, o[d0][4 * j + 1] * rl, o[d0][4 * j + 2] * rl, o[d0][4 * j + 3] * rl); }
}
}

#define XB_TMO      128
#define XB_XCNT(j)  (256  + 64 * (j))
#define XB_XSUB(j)  (1280 + 64 * (j))
#define XB_XGEN(j)  (2304 + 64 * (j))
#define XB_TOP      3328
#define XB_TOPGEN   3392
#define XCD_BAR_WORDS 3456
#define XB_SPIN_CAP (1u << 18)
__device__ __forceinline__ unsigned xb_ld(unsigned* p)              { return __hip_atomic_load(p, __ATOMIC_RELAXED, __HIP_MEMORY_SCOPE_AGENT); }
__device__ __forceinline__ unsigned xb_add(unsigned* p, unsigned v) { return __hip_atomic_fetch_add(p, v, __ATOMIC_RELAXED, __HIP_MEMORY_SCOPE_AGENT); }
__device__ __forceinline__ unsigned xb_xcc_id() { return (unsigned)__builtin_amdgcn_s_getreg((3 << 11) | 20) & 0xFu; }
#define XB_SPIN(cond, bar) do { unsigned _sp = 0; while (cond) { __builtin_amdgcn_s_sleep(1); \
    if ((++_sp & 255u) == 0u) { if (xb_ld(&(bar)[XB_TMO])) break; if (_sp > XB_SPIN_CAP) { atomicAdd(&(bar)[XB_TMO], 1u); break; } } } } while (0)
struct XcdBarrier { unsigned* bar; unsigned x; volatile LAS unsigned* st; };
__device__ __forceinline__ XcdBarrier xcd_barrier_post(unsigned* bar, volatile LAS unsigned* st) {
    XcdBarrier b; b.bar = bar; b.x = xb_xcc_id(); b.st = st;
    if (threadIdx.x == 0) (void)xb_add(&bar[XB_XCNT(b.x)], 1u);
    return b;
}
__device__ __forceinline__ void xcd_barrier_complete(unsigned* bar, unsigned x, unsigned& nloc, unsigned& nx) {
    const unsigned G = gridDim.x * gridDim.y * gridDim.z;
    unsigned sum, cnt, mine, sp = 0u;
    for (;;) {
        sum = 0u; cnt = 0u; mine = 0u;
#pragma unroll
        for (unsigned j = 0; j < 16; ++j) { const unsigned c = xb_ld(&bar[XB_XCNT(j)]); sum += c; cnt += (c > 0u) ? 1u : 0u; mine = (j == x) ? c : mine; }
        if (sum == G) break;
        __builtin_amdgcn_s_sleep(1);
        if ((++sp & 255u) == 0u) { if (xb_ld(&bar[XB_TMO])) break; if (sp > XB_SPIN_CAP) { atomicAdd(&bar[XB_TMO], 1u); break; } }
    }
    nloc = mine > 0u ? mine : 1u; nx = cnt > 0u ? cnt : 1u;
}
__device__ __forceinline__ void xcd_barrier(const XcdBarrier& b) {
    asm volatile("s_waitcnt vmcnt(0)" ::: "memory");
    __syncthreads();
    if (threadIdx.x == 0) {
        unsigned* bar = b.bar;
        __builtin_amdgcn_s_waitcnt(0);
        unsigned nloc = b.st[0], nx = b.st[1];
        if (nloc == 0u) { xcd_barrier_complete(bar, b.x, nloc, nx); b.st[0] = nloc; b.st[1] = nx; }
        const unsigned old = xb_add(&bar[XB_XSUB(b.x)], 1u);
        const unsigned gen = old / nloc;
        if (old + 1u == (gen + 1u) * nloc) {
            __builtin_amdgcn_fence(__ATOMIC_RELEASE, "agent");
            asm volatile("s_waitcnt vmcnt(0)" ::: "memory");
            const unsigned og = xb_add(&bar[XB_TOP], 1u);
            const unsigned tg = og / nx;
            if (og + 1u == (tg + 1u) * nx) xb_add(&bar[XB_TOPGEN], 1u);
            else XB_SPIN(xb_ld(&bar[XB_TOPGEN]) == tg, bar);
            __builtin_amdgcn_fence(__ATOMIC_ACQUIRE, "agent");
            xb_add(&bar[XB_XGEN(b.x)], 1u);
            asm volatile("s_waitcnt vmcnt(0)" ::: "memory");
        } else {
            XB_SPIN(xb_ld(&bar[XB_XGEN(b.x)]) == gen, bar);
            __builtin_amdgcn_fence(__ATOMIC_ACQUIRE, "agent");
            asm volatile("s_waitcnt vmcnt(0)" ::: "memory");
        }
    }
    __syncthreads();
}

struct Args { const float* in[29]; const int* positions; float* out; unsigned char* ws; };
enum { I_X = 0, I_POS = 1, I_ANM = 2, I_RGWIN = 3, I_CONVW = 4, I_CONVB = 5, I_RGWA = 6, I_RGBA = 7, I_RGWX = 8, I_RGBX = 9, I_LAM = 10, I_RGWOUT = 11, I_ANF = 12, I_FFG = 13, I_FFU = 14, I_FFD = 15,
       I_BNM = 16, I_MLAWIN = 17, I_QNORM = 18, I_WQUP = 19, I_KVNORM = 20, I_WKVUP = 21, I_MLAWO = 22, I_BNF = 23, I_ROUTER = 24, I_MOEG = 25, I_MOEU = 26, I_MOED = 27, I_FNORM = 28 };

constexpr float WSC8 = 64.f, ASC8 = 8.f, HSC8 = 4.f; static_assert(WSC8 == att::CV_WS, "e4m3 weight scale");
__device__ __forceinline__ void tr_load(const float* W, int N, int k0, int n0, int lane, f32x4 (&v)[16]) {
    const float* src = W + (size_t)(k0 + 16 * (lane >> 4)) * N + n0 + 4 * (lane & 15);
#pragma unroll
    for (int i = 0; i < 16; ++i) v[i] = *(const f32x4*)(src + (size_t)i * N);
}
constexpr float WSI8 = 1400.f, ASI8 = 31.f, WSU8 = 700.f, WSD8 = 2600.f, HSI8 = 16.f;
template <int FP8>
__device__ __forceinline__ void tr_store(const f32x4 (&v)[16], void* WT, int K, int k0, int drow0, int lane, float wsc) {
    const int c = lane & 15, q = lane >> 4;
#pragma unroll
    for (int j = 0; j < 4; ++j) {
        const size_t eoff = (size_t)(drow0 + 4 * c + j) * K + k0 + 16 * q;
        if constexpr (FP8 == 2) { u32x4 o;
            o.x = pk4_i8(v[0][j] * wsc, v[1][j] * wsc, v[2][j] * wsc, v[3][j] * wsc); o.y = pk4_i8(v[4][j] * wsc, v[5][j] * wsc, v[6][j] * wsc, v[7][j] * wsc);
            o.z = pk4_i8(v[8][j] * wsc, v[9][j] * wsc, v[10][j] * wsc, v[11][j] * wsc); o.w = pk4_i8(v[12][j] * wsc, v[13][j] * wsc, v[14][j] * wsc, v[15][j] * wsc);
            *(u32x4*)((unsigned char*)WT + eoff) = o; }
        else if constexpr (FP8 == 1) { u32x4 o;
            o.x = pk4_fp8(v[0][j] * WSC8, v[1][j] * WSC8, v[2][j] * WSC8, v[3][j] * WSC8); o.y = pk4_fp8(v[4][j] * WSC8, v[5][j] * WSC8, v[6][j] * WSC8, v[7][j] * WSC8);
            o.z = pk4_fp8(v[8][j] * WSC8, v[9][j] * WSC8, v[10][j] * WSC8, v[11][j] * WSC8); o.w = pk4_fp8(v[12][j] * WSC8, v[13][j] * WSC8, v[14][j] * WSC8, v[15][j] * WSC8);
            *(u32x4*)((unsigned char*)WT + eoff) = o; }
        else { u32x4 o0, o1;
            o0.x = cvtpk(v[0][j], v[1][j]); o0.y = cvtpk(v[2][j], v[3][j]); o0.z = cvtpk(v[4][j], v[5][j]); o0.w = cvtpk(v[6][j], v[7][j]);
            o1.x = cvtpk(v[8][j], v[9][j]); o1.y = cvtpk(v[10][j], v[11][j]); o1.z = cvtpk(v[12][j], v[13][j]); o1.w = cvtpk(v[14][j], v[15][j]);
            *(u32x4*)((bf16_t*)WT + eoff) = o0; *(u32x4*)((bf16_t*)WT + eoff + 8) = o1; }
    }
}
template <int MODE, int FP8 = 0>
__device__ __forceinline__ void tr_matrix(const float* W, int nb, int K, int N, void* WT, int drows, int rot, int gw, int NGW, LAS float* scr, int lane, float wsc = 1.0f) {
    const int nbn = N / 64, per = (K / 128) * nbn, total = nb * per;
    int it = gw - rot; if (it < 0) it += NGW;
    if (it >= total) return;
    f32x4 va[16], vb[16];
    int e = it / per, r = it - e * per, kb = r / nbn, nbk = r - kb * nbn, n0 = nbk * 64, k0 = kb * 128;
    const float* Wp = W + (size_t)e * K * N; unsigned char* WTp = (unsigned char*)WT + (size_t)e * drows * K * (FP8 ? 1 : 2);
    tr_load(Wp, N, k0, n0, lane, va);
    for (;;) {
        tr_load(Wp, N, k0 + 64, n0, lane, vb);
        const int drow0 = (MODE == 0) ? n0 : ((n0 >> 7) * 256 + (n0 & 127) + (MODE == 2 ? 128 : 0));
        tr_store<FP8>(va, WTp, K, k0, drow0, lane, wsc);
        const int nit = it + NGW; const bool more = nit < total;
        int n0n = n0, k0n = k0; const float* Wpn = Wp; unsigned char* WTpn = WTp;
        if (more) { e = nit / per; r = nit - e * per; kb = r / nbn; nbk = r - kb * nbn; n0n = nbk * 64; k0n = kb * 128;
            Wpn = W + (size_t)e * K * N; WTpn = (unsigned char*)WT + (size_t)e * drows * K * (FP8 ? 1 : 2);
            tr_load(Wpn, N, k0n, n0n, lane, va); }
        tr_store<FP8>(vb, WTp, K, k0 + 64, drow0, lane, wsc);
        if (!more) break;
        it = nit; n0 = n0n; k0 = k0n; Wp = Wpn; WTp = WTpn;
    }
}
constexpr float WSC6 = 90.f, ASC6 = 2.f;
template <int MODE>
__device__ __forceinline__ void tr_matrix6(const float* W, int nb, int K, int N, unsigned char* WT, int drows, int rot, int gw, int NGW, int lane, float wscale) {
    const int nbn = N / 32, per = (K / 256) * nbn, total = nb * per;
    int it = gw - rot; if (it < 0) it += NGW;
    const int c = lane & 7, q = lane >> 3;
    for (; it < total; it += NGW) {
        const int e = it / per, r = it - e * per, kb = r / nbn, nbk = r - kb * nbn, n0 = nbk * 32, k0 = kb * 256;
        const float* src = W + (size_t)e * K * N + (size_t)(k0 + 32 * q) * N + n0 + 4 * c;
        f32x4 v[32];
#pragma unroll
        for (int i = 0; i < 32; ++i) v[i] = *(const f32x4*)(src + (size_t)i * N);
        const int drow0 = (MODE == 0) ? n0 : ((n0 >> 7) * 256 + (n0 & 127) + (MODE == 2 ? 128 : 0));
        unsigned char* dst = WT + (size_t)e * drows * K + (size_t)(drow0 + 4 * c) * K + k0 + 32 * q;
#pragma unroll
        for (int j = 0; j < 4; ++j) { float x[32];
#pragma unroll
            for (int i = 0; i < 32; ++i) x[i] = v[i][j] * wscale;
            const v6u w = pk32_fp6(x);
            *(u32x4*)(dst + (size_t)j * K) = (u32x4){w[0], w[1], w[2], w[3]}; *(u32x4*)(dst + (size_t)j * K + 16) = (u32x4){w[4], w[5], 0u, 0u}; }
    }
}
template <bool I8OUT = false>
__device__ __forceinline__ void norm_rows(const float* __restrict__ X, const float* __restrict__ gain, bf16_t* __restrict__ O, int gw, int NGW, int lane) {
    f32x4 g[8];
#pragma unroll
    for (int j = 0; j < 8; ++j) g[j] = *(const f32x4*)(gain + 4 * lane + 256 * j);
    for (int m = gw; m < M; m += 2 * NGW) {
        const f32x4* xa = (const f32x4*)(X + (size_t)m * D) + lane; const f32x4* xb = (const f32x4*)(X + (size_t)(m + NGW) * D) + lane;
        f32x4 va[8], vb[8]; float sa = 0.f, sb = 0.f;
#pragma unroll
        for (int j = 0; j < 8; ++j) { va[j] = xa[64 * j]; vb[j] = xb[64 * j]; }
#pragma unroll
        for (int j = 0; j < 8; ++j) { sa += dot4(va[j]); sb += dot4(vb[j]); }
        const float ra = 1.0f / sqrtf(wave_sum(sa) * (1.0f / D) + EPS), rb = 1.0f / sqrtf(wave_sum(sb) * (1.0f / D) + EPS);
        if constexpr (I8OUT) { unsigned* oa = (unsigned*)((unsigned char*)O + (size_t)m * D) + lane; unsigned* ob = (unsigned*)((unsigned char*)O + (size_t)(m + NGW) * D) + lane;
#pragma unroll
            for (int j = 0; j < 8; ++j) { const f32x4 ya = va[j] * (ra * ASI8) * g[j], yb = vb[j] * (rb * ASI8) * g[j]; oa[64 * j] = pk4_i8(ya.x, ya.y, ya.z, ya.w); ob[64 * j] = pk4_i8(yb.x, yb.y, yb.z, yb.w); } }
        else {
        u32x2* oa = (u32x2*)(O + (size_t)m * D) + lane; u32x2* ob = (u32x2*)(O + (size_t)(m + NGW) * D) + lane;
#pragma unroll
        for (int j = 0; j < 8; ++j) { const f32x4 ya = va[j] * ra * g[j], yb = vb[j] * rb * g[j]; u32x2 wa, wb; wa.x = cvtpk(ya.x, ya.y); wa.y = cvtpk(ya.z, ya.w); wb.x = cvtpk(yb.x, yb.y); wb.y = cvtpk(yb.z, yb.w);
            oa[64 * j] = wa; ob[64 * j] = wb; } }
    }
}
__device__ __forceinline__ void rope_cs(int pos, double invf, float& c, float& s) {
    const double rev = (double)pos * invf * 0.15915494309189535; const float fr = (float)(rev - __builtin_floor(rev));
    s = __builtin_amdgcn_sinf(fr); c = __builtin_amdgcn_cosf(fr);
}

#ifndef PHASES
#define PHASES 0xffffffffu
#endif
#define PH(n) (((PHASES) >> (n)) & 1u)
#ifndef REPEAT
#define REPEAT 0u
#endif
#define RP(n) _Pragma("nounroll") for (int rep_ = 0; rep_ < (int)(((REPEAT) >> (n)) & 1u) + 1; ++rep_)
__global__ void __launch_bounds__(NTHREADS, 2) fwd_kernel(Args args) {
    extern __shared__ __attribute__((aligned(16))) unsigned char lds_raw[];
    LAS unsigned char* lds = (LAS unsigned char*)lds_raw;
    volatile LAS unsigned* MISC = (volatile LAS unsigned*)(lds + LDSCTL_OFF);
    const int wave = __builtin_amdgcn_readfirstlane(opaque_tid() >> 6);
    const int G = gridDim.x, bx = blockIdx.x;
    const int gw = bx * NWAVES + wave, NGW = G * NWAVES, NGT = G * NTHREADS;
#define IDS() const int tid = opaque_tid(), lane = tid & 63, gtid = bx * NTHREADS + tid; (void)lane; (void)gtid
    unsigned char* ws = args.ws;
    float* out = args.out;
    { IDS(); for (int u = tid; u < (LDS_BYTES - LDSCTL_OFF) / 4; u += NTHREADS) ((LAS unsigned*)(lds + LDSCTL_OFF))[u] = 0u; }
    __syncthreads();
    XcdBarrier bar = xcd_barrier_post((unsigned*)(ws + WS_CTL) + 1024, MISC + 8);
#define GRID_BAR() xcd_barrier(bar)

    bf16_t* XB = (bf16_t*)(ws + WS_XB);
    float* csp = (float*)(ws + TAB_CSP);

    if (PH(0)) RP(0)
    {
        IDS();
        LAS float* scr = (LAS float*)(lds + wave * 16640);
        constexpr int T0 = (D / 128) * (2 * D / 64), T1 = (D / 128) * (D / 64), T2 = (D / 128) * (FF / 64), T5 = (D / 128) * (MLA_IN / 64), T6 = (QLORA / 128) * (NH * QKD / 64), T7 = (KVLORA / 128) * (NH * 256 / 64);
        constexpr int NGWC = GRID * NWAVES;
        constexpr int R1 = T0 % NGWC, R2 = (R1 + T1) % NGWC, R3 = (R2 + T2) % NGWC, R4 = (R3 + T2) % NGWC, R5 = (R4 + T2) % NGWC, R6 = (R5 + T5) % NGWC, R7 = (R6 + T6) % NGWC, R8 = (R7 + T7) % NGWC, R9 = (R8 + T1) % NGWC;
        static_assert((NE * (D / 256) * (FF / 32)) % NGWC == 0, "fp6 item count per matrix is a multiple of the wave count");
        tr_matrix<0, 2>(args.in[I_RGWIN], 1, D,      2 * D,    (bf16_t*)(ws + W_IN1),   2 * D,      0,   gw, NGW, scr, lane, WSI8);
        tr_matrix<0>(args.in[I_RGWOUT], 1,  D,      D,        (bf16_t*)(ws + W_OUT1),  D,          R1,  gw, NGW, scr, lane);
        tr_matrix<1, 2>(args.in[I_FFG], 1,  D,      FF,       (bf16_t*)(ws + W_FFGU),  2 * FF,     R2,  gw, NGW, scr, lane, WSI8);
        tr_matrix<2, 2>(args.in[I_FFU], 1,  D,      FF,       (bf16_t*)(ws + W_FFGU),  2 * FF,     R3,  gw, NGW, scr, lane, WSI8);
        tr_matrix<0, 2>(args.in[I_FFD],  1,  FF,     D,        (bf16_t*)(ws + W_FFD),   D,          R4,  gw, NGW, scr, lane, WSD8);
        tr_matrix<0, 2>(args.in[I_MLAWIN], 1, D,     MLA_IN,   (bf16_t*)(ws + W_MLAIN), MLA_IN_PAD, R5,  gw, NGW, scr, lane, WSI8);
        tr_matrix<0, 2>(args.in[I_WQUP],  1,  QLORA,  NH * QKD, (bf16_t*)(ws + W_QUP),   NH * QKD,   R6,  gw, NGW, scr, lane, WSU8);
        tr_matrix<0, 2>(args.in[I_WKVUP], 1,  KVLORA, NH * 256, (bf16_t*)(ws + W_KVUP),  NH * 256,   R7,  gw, NGW, scr, lane, WSU8);
        tr_matrix<0, 1>(args.in[I_MLAWO], 1,  D,      D,        (bf16_t*)(ws + W_MLAO),  D,          R8,  gw, NGW, scr, lane);
        tr_matrix6<1>(args.in[I_MOEG], NE, D, FF, ws + W_MOEGU, 2 * FF, R9, gw, NGW, lane, WSC6);
        tr_matrix6<2>(args.in[I_MOEU], NE, D, FF, ws + W_MOEGU, 2 * FF, R9, gw, NGW, lane, WSC6);
        { u32x4* z = (u32x4*)(ws + W_MLAIN + (size_t)MLA_IN * D); const int nz = (MLA_IN_PAD - MLA_IN) * D / 16;
          for (int i = gtid; i < nz; i += NGT) z[i] = (u32x4){0u, 0u, 0u, 0u}; }
        { bf16_t* Wg = (bf16_t*)(ws + W_GATE); const float* wa = args.in[I_RGWA]; const float* wx = args.in[I_RGWX];
          for (int idx = gtid; idx < 16 * 256 * 256; idx += NGT) { const int h = idx >> 16, n = (idx >> 8) & 255, k = idx & 255, kl = k - 128 * (h & 1);
              float v = 0.f; if (kl >= 0 && kl < 128) v = (n < 128) ? wa[((size_t)h * 128 + kl) * 128 + n] : wx[((size_t)h * 128 + kl) * 128 + (n - 128)];
              Wg[idx] = (bf16_t)(cvtpk(v, 0.f) & 0xffffu); } }
        for (int c = gtid; c < D; c += NGT) { const float lam = args.in[I_LAM][c]; csp[c] = 8.0f * 1.4426950408889634f * log1pf(expf(-lam)); }
        norm_rows<true>(args.in[I_X], args.in[I_ANM], XB, gw, NGW, lane);
    }
    GRID_BAR();

    if (PH(1)) RP(1)
    {
        pg8::Gemm g{XB, (const bf16_t*)(ws + W_IN1), D, D, D};
        pg8::SchedPlain S; S.T.init(M / 256, 2 * D / 256, G, bx); S.atile = (size_t)256 * D; S.btile = (size_t)256 * D;
        pg8::EpiBf16 E{(bf16_t*)(ws + A_U), 2 * D, 1.0f / (WSI8 * ASI8)};
        pg8::gemm_phase8<pg8::EpiBf16, pg8::SchedPlain, 2>(lds, g, S, E);
    }
    GRID_BAR();

    if (PH(2)) RP(2)
    {
        IDS();
        const bf16_t* __restrict__ U = (const bf16_t*)(ws + A_U); bf16_t* __restrict__ XC = (bf16_t*)(ws + A_XC);
        const float* __restrict__ cw = args.in[I_CONVW]; const float* __restrict__ cb = args.in[I_CONVB];
        const int cg = tid & 255, r0 = bx * RPB + (tid >> 8) * (RPB / 2);
        float wk[4][8], bias[8];
#pragma unroll
        for (int k = 0; k < 4; ++k) { const f32x4 w0 = *(const f32x4*)(cw + k * D + cg * 8), w1 = *(const f32x4*)(cw + k * D + cg * 8 + 4);
            wk[k][0] = w0.x; wk[k][1] = w0.y; wk[k][2] = w0.z; wk[k][3] = w0.w; wk[k][4] = w1.x; wk[k][5] = w1.y; wk[k][6] = w1.z; wk[k][7] = w1.w; }
        { const f32x4 b0 = *(const f32x4*)(cb + cg * 8), b1 = *(const f32x4*)(cb + cg * 8 + 4); bias[0] = b0.x; bias[1] = b0.y; bias[2] = b0.z; bias[3] = b0.w; bias[4] = b1.x; bias[5] = b1.y; bias[6] = b1.z; bias[7] = b1.w; }
        const bf16_t* rec = U + (size_t)r0 * (2 * D) + D + cg * 8;
        bf16_t* dst = XC + (size_t)r0 * D + cg * 8;
        u32x4 x3 = {0u, 0u, 0u, 0u}, x2 = x3, x1 = x3;
        if ((r0 & (SEQ - 1)) != 0) { x3 = *(const u32x4*)(rec - 3 * (2 * D)); x2 = *(const u32x4*)(rec - 2 * (2 * D)); x1 = *(const u32x4*)(rec - 1 * (2 * D)); }
#pragma unroll 1
        for (int tb = 0; tb < RPB / 2; tb += 8) {
            u32x4 xn[8];
#pragma unroll
            for (int u = 0; u < 8; ++u) xn[u] = *(const u32x4*)(rec + (size_t)(tb + u) * (2 * D));
#pragma unroll
            for (int u = 0; u < 8; ++u) {
                const u32x4 x0 = xn[u]; float acc[8];
#define CONV_TAP(K_, X_) do { acc[0] += wk[K_][0] * bflo(X_.x); acc[1] += wk[K_][1] * bfhi(X_.x); acc[2] += wk[K_][2] * bflo(X_.y); acc[3] += wk[K_][3] * bfhi(X_.y); \
                              acc[4] += wk[K_][4] * bflo(X_.z); acc[5] += wk[K_][5] * bfhi(X_.z); acc[6] += wk[K_][6] * bflo(X_.w); acc[7] += wk[K_][7] * bfhi(X_.w); } while (0)
#pragma unroll
                for (int e = 0; e < 8; ++e) acc[e] = bias[e];
                CONV_TAP(0, x3); CONV_TAP(1, x2); CONV_TAP(2, x1); CONV_TAP(3, x0);
#undef CONV_TAP
                u32x4 o; o.x = cvtpk(acc[0], acc[1]); o.y = cvtpk(acc[2], acc[3]); o.z = cvtpk(acc[4], acc[5]); o.w = cvtpk(acc[6], acc[7]);
                *(u32x4*)(dst + (size_t)(tb + u) * D) = o;
                x3 = x2; x2 = x1; x1 = x0;
            }
        }
    }
    GRID_BAR();

    if (PH(3)) RP(3)
    {
        pg8::Gemm g{(const bf16_t*)(ws + A_XC), (const bf16_t*)(ws + W_GATE), D, 256, 256};
        pg8::SchedGate S; S.T.init(M / 256, 16, G, bx);
        pg8::EpiGate E{(const bf16_t*)(ws + A_XC), args.in[I_RGBA], args.in[I_RGBX], csp, (unsigned*)(ws + A_AV)};
        pg8::gemm_phase(lds, g, S, E);
    }
    GRID_BAR();

    if (PH(4)) RP(4)
    {
        IDS();
        const unsigned* __restrict__ AB = (const unsigned*)(ws + A_AV);
        float* __restrict__ AGA = (float*)(ws + WS_AGGA); float* __restrict__ AGB = (float*)(ws + WS_AGGB);
        for (int item = bx; item < NBATCH * NCH; item += G) {
            const size_t r0 = (size_t)item * SCH;
            f32x4 A = {1.f, 1.f, 1.f, 1.f}, B = {0.f, 0.f, 0.f, 0.f};
#pragma unroll 8
            for (int t = 0; t < SCH; ++t) { const u32x4 w = *(const u32x4*)(AB + (r0 + t) * D + 4 * tid);
                const f32x4 a = {__builtin_amdgcn_exp2f(bflo(w.x)), __builtin_amdgcn_exp2f(bflo(w.y)), __builtin_amdgcn_exp2f(bflo(w.z)), __builtin_amdgcn_exp2f(bflo(w.w))};
                const f32x4 b = {bfhi(w.x), bfhi(w.y), bfhi(w.z), bfhi(w.w)}; A = A * a; B = a * B + b; }
            *(f32x4*)(AGA + (size_t)item * D + 4 * tid) = A; *(f32x4*)(AGB + (size_t)item * D + 4 * tid) = B;
        }
    }
    GRID_BAR();

    if (PH(5)) RP(5)
    {
        IDS();
        const unsigned* __restrict__ AB = (const unsigned*)(ws + A_AV);
        const float* __restrict__ AGA = (const float*)(ws + WS_AGGA); const float* __restrict__ AGB = (const float*)(ws + WS_AGGB);
        const bf16_t* __restrict__ U = (const bf16_t*)(ws + A_U); bf16_t* __restrict__ Y = (bf16_t*)(ws + A_Y);
        for (int item = bx; item < NBATCH * NCH; item += G) {
            const int b = item / NCH, ch = item - b * NCH; const size_t r0 = (size_t)item * SCH;
            f32x4 h = {0.f, 0.f, 0.f, 0.f};
#pragma unroll 8
            for (int c = 0; c < ch; ++c) { const f32x4 a = *(const f32x4*)(AGA + (size_t)(b * NCH + c) * D + 4 * tid), bb = *(const f32x4*)(AGB + (size_t)(b * NCH + c) * D + 4 * tid); h = a * h + bb; }
#pragma unroll 8
            for (int t = 0; t < SCH; ++t) {
                const u32x4 pw = *(const u32x4*)(AB + (r0 + t) * D + 4 * tid);
                const f32x4 a = {__builtin_amdgcn_exp2f(bflo(pw.x)), __builtin_amdgcn_exp2f(bflo(pw.y)), __builtin_amdgcn_exp2f(bflo(pw.z)), __builtin_amdgcn_exp2f(bflo(pw.w))};
                const f32x4 bb = {bfhi(pw.x), bfhi(pw.y), bfhi(pw.z), bfhi(pw.w)};
                const u32x2 gw2 = *(const u32x2*)(U + (r0 + t) * (2 * D) + 4 * tid);
                h = a * h + bb;
                const float y0 = h.x * gelu_tanh(bflo(gw2.x)), y1 = h.y * gelu_tanh(bfhi(gw2.x)), y2 = h.z * gelu_tanh(bflo(gw2.y)), y3 = h.w * gelu_tanh(bfhi(gw2.y));
                u32x2 w; w.x = cvtpk(y0, y1); w.y = cvtpk(y2, y3);
                *(u32x2*)(Y + (r0 + t) * D + 4 * tid) = w;
            }
        }
    }
    GRID_BAR();

    if (PH(6)) RP(6)
    {
        pg8::Gemm g{(const bf16_t*)(ws + A_Y), (const bf16_t*)(ws + W_OUT1), D, D, D};
        pg8::SchedPlain S; S.T.init(M / 256, D / 256, G, bx); S.atile = (size_t)256 * D * 2; S.btile = (size_t)256 * D * 2;
        pg8::EpiResidual E{args.in[I_X], out, D, 1.0f};
        pg8::gemm_phase(lds, g, S, E);
    }
    GRID_BAR();
    if (PH(7)) RP(7)
    { IDS(); norm_rows<true>(out, args.in[I_ANF], XB, gw, NGW, lane); }
    GRID_BAR();
    if (PH(8)) RP(8)
    {
        pg8::Gemm g{XB, (const bf16_t*)(ws + W_FFGU), D, D, D};
        pg8::SchedPlain S; S.T.init(M / 256, 2 * FF / 256, G, bx); S.atile = (size_t)256 * D; S.btile = (size_t)256 * D;
        pg8::EpiSwiglu<2> E{(void*)(ws + A_H), FF, 1.0f / (WSI8 * ASI8), HSI8};
        pg8::gemm_phase8<pg8::EpiSwiglu<2>, pg8::SchedPlain, 2>(lds, g, S, E);
    }
    GRID_BAR();
    if (PH(9)) RP(9)
    {
        pg8::Gemm g{(const bf16_t*)(ws + A_H), (const bf16_t*)(ws + W_FFD), FF, FF, FF};
        pg8::SchedPlain S; S.T.init(M / 256, D / 256, G, bx); S.atile = (size_t)256 * FF; S.btile = (size_t)256 * FF;
        pg8::EpiResidual E{out, out, D, 1.0f / (WSD8 * HSI8)};
        pg8::gemm_phase8<pg8::EpiResidual, pg8::SchedPlain, 2>(lds, g, S, E);
    }
    GRID_BAR();
    if (PH(10)) RP(10)
    { IDS(); norm_rows<true>(out, args.in[I_BNM], XB, gw, NGW, lane); }
    GRID_BAR();
    if (PH(11)) RP(11)
    {
        pg8::Gemm g{XB, (const bf16_t*)(ws + W_MLAIN), D, D, D};
        pg8::SchedPlain S; S.T.init(M / 256, 4, G, bx); S.atile = (size_t)256 * D; S.btile = (size_t)256 * D;
        pg8::EpiBf16 E{(bf16_t*)(ws + A_CU), MLA_IN_PAD, 1.0f / (WSI8 * ASI8)};
        pg8::gemm_phase8<pg8::EpiBf16, pg8::SchedPlain, 2>(lds, g, S, E);
    }
    if (PH(11)) RP(11)
    {
        pg8::Gemm g{XB, (const bf16_t*)(ws + W_MLAIN), D, D, D / 4};
        pg8::SchedKSplit S{G, bx, M / 256, 4, 4, (size_t)256 * D, (size_t)256 * D, (size_t)(D / 4)};
        pg8::EpiKpe E{(float*)(ws + A_KPP), 4, 1.0f / (WSI8 * ASI8)};
        pg8::gemm_phase8<pg8::EpiKpe, pg8::SchedKSplit, 2>(lds, g, S, E);
    }
    GRID_BAR();
    if (PH(12)) RP(12)
    {
        IDS();
        const bf16_t* __restrict__ CU = (const bf16_t*)(ws + A_CU); bf16_t* __restrict__ CQ = (bf16_t*)(ws + A_CQ); bf16_t* __restrict__ CKV = (bf16_t*)(ws + A_CKV); bf16_t* __restrict__ KPE = (bf16_t*)(ws + A_KPE);
        const int* __restrict__ posv = args.positions; float* __restrict__ CST = (float*)(ws + A_CST); const float* __restrict__ KPP = (const float*)(ws + A_KPP);
        const f32x4 gq0 = *(const f32x4*)(args.in[I_QNORM] + 4 * lane), gq1 = *(const f32x4*)(args.in[I_QNORM] + 256 + 4 * lane);
        const f32x4 gk0 = *(const f32x4*)(args.in[I_KVNORM] + 4 * lane), gk1 = *(const f32x4*)(args.in[I_KVNORM] + 256 + 4 * lane);
        const double invf = INV_FREQ[lane & 31];
#pragma unroll 2
        for (int m = gw; m < M; m += NGW) {
            const bf16_t* r = CU + (size_t)m * MLA_IN_PAD;
            const u32x2 wq0 = *(const u32x2*)(r + 4 * lane), wq1 = *(const u32x2*)(r + 256 + 4 * lane), wk0 = *(const u32x2*)(r + 512 + 4 * lane), wk1 = *(const u32x2*)(r + 768 + 4 * lane);
            const f32x4 q0 = {bflo(wq0.x), bfhi(wq0.x), bflo(wq0.y), bfhi(wq0.y)}, q1 = {bflo(wq1.x), bfhi(wq1.x), bflo(wq1.y), bfhi(wq1.y)};
            const f32x4 k0 = {bflo(wk0.x), bfhi(wk0.x), bflo(wk0.y), bfhi(wk0.y)}, k1 = {bflo(wk1.x), bfhi(wk1.x), bflo(wk1.y), bfhi(wk1.y)};
            const float* kp = KPP + (size_t)m * 64 + (lane & 31);
            const float x1 = (kp[0] + kp[(size_t)M * 64]) + (kp[(size_t)2 * M * 64] + kp[(size_t)3 * M * 64]), x2 = (kp[32] + kp[(size_t)M * 64 + 32]) + (kp[(size_t)2 * M * 64 + 32] + kp[(size_t)3 * M * 64 + 32]);
            const float rq = 1.0f / sqrtf(wave_sum(dot4(q0) + dot4(q1)) * (1.0f / QLORA) + EPS), rk = 1.0f / sqrtf(wave_sum(dot4(k0) + dot4(k1)) * (1.0f / KVLORA) + EPS);
            { const f32x4 y0 = q0 * (rq * ASI8) * gq0, y1 = q1 * (rq * ASI8) * gq1;
              *(unsigned*)((unsigned char*)CQ + (size_t)m * QLORA + 4 * lane) = pk4_i8(y0.x, y0.y, y0.z, y0.w); *(unsigned*)((unsigned char*)CQ + (size_t)m * QLORA + 256 + 4 * lane) = pk4_i8(y1.x, y1.y, y1.z, y1.w); }
            { const f32x4 y0 = k0 * (rk * ASI8) * gk0, y1 = k1 * (rk * ASI8) * gk1;
              *(unsigned*)((unsigned char*)CKV + (size_t)m * KVLORA + 4 * lane) = pk4_i8(y0.x, y0.y, y0.z, y0.w); *(unsigned*)((unsigned char*)CKV + (size_t)m * KVLORA + 256 + 4 * lane) = pk4_i8(y1.x, y1.y, y1.z, y1.w); }
            float cs, sn; rope_cs(posv[m], invf, cs, sn);
            const float o1 = x1 * cs - x2 * sn, o2 = x2 * cs + x1 * sn;
            CST[(size_t)m * 64 + lane] = (lane < 32) ? cs : sn;
            if (lane < 32) { KPE[(size_t)m * ROPE + lane] = (bf16_t)(cvtpk(o1, 0.f) & 0xffffu); KPE[(size_t)m * ROPE + 32 + lane] = (bf16_t)(cvtpk(o2, 0.f) & 0xffffu); }
        }
    }
    GRID_BAR();
    if (PH(13)) RP(13)
    {
        pg8::Gemm g{(const bf16_t*)(ws + A_CQ), (const bf16_t*)(ws + W_QUP), QLORA, QLORA, QLORA};
        pg8::SchedPlain S; S.T.init(M / 256, NH * QKD / 256, G, bx); S.atile = (size_t)256 * QLORA; S.btile = (size_t)256 * QLORA;
        pg8::EpiFp8 E{ws + A_Q, NH * QKD, QSCALE * att::QS8 / (WSU8 * ASI8)};
        pg8::gemm_phase8<pg8::EpiFp8, pg8::SchedPlain, 2>(lds, g, S, E);
    }
    if (PH(22)) RP(22)
    {
        pg8::Gemm g{(const bf16_t*)(ws + A_CKV), (const bf16_t*)(ws + W_KVUP), KVLORA, KVLORA, KVLORA};
        pg8::SchedPlain S; S.T.init(M / 256, NH * 256 / 256, G, bx); S.atile = (size_t)256 * KVLORA; S.btile = (size_t)256 * KVLORA;
        pg8::EpiFp8 E{ws + A_KV, NH * 256, 1.0f / (WSU8 * ASI8)};
        pg8::gemm_phase8<pg8::EpiFp8, pg8::SchedPlain, 2>(lds, g, S, E);
    }
    GRID_BAR();
    if (PH(15)) RP(15)
    {
        const int vcu = (G % 8 == 0) ? (bx % 8) * (G / 8) + bx / 8 : bx;
        att::CvtState cs{args.in[I_MOED], ws + W_MOED, gw * att::CV_IPW, (gw + 1) * att::CV_IPW};
        for (int L = vcu; L < NBATCH * NH * 8; L += G) {
            const int bh = L >> 3, x = L & 7, b = bh / NH, h = bh - b * NH;
#pragma nounroll
            for (int pass = 0; pass < 2; ++pass)
                att::attn_unit(lds, ws + A_Q, ws + A_KV, (const bf16_t*)(ws + A_KPE), (const float*)(ws + A_CST), (bf16_t*)(ws + A_O), b, h, pass ? x : 15 - x, cs);
        }
        { const int lane_ = opaque_tid() & 63;
#pragma nounroll
          while (cs.next < cs.end) { f32x4 cv[8]; att::cvt_load(cs, lane_, cv); att::cvt_store(cs, lane_, cv); } }
    }
    GRID_BAR();
    if (PH(16)) RP(16)
    {
        pg8::Gemm g{(const bf16_t*)(ws + A_O), (const bf16_t*)(ws + W_MLAO), D, D, D};
        pg8::SchedPlain S; S.T.init(M / 256, D / 256, G, bx); S.atile = (size_t)256 * D; S.btile = (size_t)256 * D;
        pg8::EpiResidual E{out, out, D, 1.0f / (WSC8 * att::OSC8)};
        pg8::gemm_phase8<pg8::EpiResidual, pg8::SchedPlain, 0>(lds, g, S, E);
    }
    GRID_BAR();
    int* CNT = (int*)(ws + TAB_CNT); int* TILE = (int*)(ws + TAB_TILE); int* SLOT = (int*)(ws + TAB_SLOT); float* GATE = (float*)(ws + TAB_GATE); int* TOPE = (int*)(ws + TAB_TOPE);
    if (PH(17)) RP(17)
    {
        IDS();
        LAS float* wr = (LAS float*)lds;
        LAS int* tl = (LAS int*)(lds + 65536);
        const float* gain = args.in[I_BNF]; const float* wrt = args.in[I_ROUTER];
        for (int d = tid; d < D; d += NTHREADS) { const float gd = gain[d]; const f32x4 a = *(const f32x4*)(wrt + (size_t)d * 8), c = *(const f32x4*)(wrt + (size_t)d * 8 + 4);
            wr[0 * D + d] = a.x * gd; wr[1 * D + d] = a.y * gd; wr[2 * D + d] = a.z * gd; wr[3 * D + d] = a.w * gd; wr[4 * D + d] = c.x * gd; wr[5 * D + d] = c.y * gd; wr[6 * D + d] = c.z * gd; wr[7 * D + d] = c.w * gd; }
        f32x4 g[8];
#pragma unroll
        for (int j = 0; j < 8; ++j) g[j] = *(const f32x4*)(gain + 4 * lane + 256 * j);
        __syncthreads();
        for (int i = 0; i < RPB / NWAVES; i += 2) {
            const int rl = wave * (RPB / NWAVES) + i, m = bx * RPB + rl;
            const f32x4* xr = (const f32x4*)(out + (size_t)m * D) + lane;
            f32x4 va[8], vb[8]; float sa = 0.f, sb = 0.f;
#pragma unroll
            for (int j = 0; j < 8; ++j) { va[j] = xr[64 * j]; vb[j] = xr[64 * j + D / 4]; }
#pragma unroll
            for (int j = 0; j < 8; ++j) { sa += dot4(va[j]); sb += dot4(vb[j]); }
            float la[8], lb[8];
#pragma unroll
            for (int e = 0; e < 8; ++e) { float a = 0.f, b = 0.f;
#pragma unroll
                for (int j = 0; j < 8; ++j) { const f32x4 w = *(const LAS f32x4*)(wr + e * D + 4 * lane + 256 * j);
                    a += (va[j].x * w.x + va[j].y * w.y) + (va[j].z * w.z + va[j].w * w.w); b += (vb[j].x * w.x + vb[j].y * w.y) + (vb[j].z * w.z + vb[j].w * w.w); }
                la[e] = a; lb[e] = b; }
            const float ra = 1.0f / sqrtf(wave_sum(sa) * (1.0f / D) + EPS), rb = 1.0f / sqrtf(wave_sum(sb) * (1.0f / D) + EPS);
#pragma unroll
            for (int e = 0; e < 8; ++e) { la[e] = wave_sum(la[e]) * ra; lb[e] = wave_sum(lb[e]) * rb; }
#pragma unroll
            for (int rr = 0; rr < 2; ++rr) {
                float lg[8];
#pragma unroll
                for (int e = 0; e < 8; ++e) lg[e] = rr ? lb[e] : la[e];
                int e1 = 0; float v1 = lg[0];
#pragma unroll
                for (int e = 1; e < 8; ++e) if (lg[e] > v1) { v1 = lg[e]; e1 = e; }
                int e2 = -1; float v2 = -__builtin_inff();
#pragma unroll
                for (int e = 0; e < 8; ++e) if (e != e1 && lg[e] > v2) { v2 = lg[e]; e2 = e; }
                const float g2 = 1.0f / (1.0f + expf(v1 - v2)), g1 = 1.0f - g2;
                if (lane == 0) { tl[2 * (rl + rr)] = e1; tl[2 * (rl + rr) + 1] = e2; TOPE[2 * (m + rr)] = e1; TOPE[2 * (m + rr) + 1] = e2; GATE[2 * (m + rr)] = g1; GATE[2 * (m + rr) + 1] = g2; }
            }
            u32x2* o = (u32x2*)(XB + (size_t)m * D) + lane;
#pragma unroll
            for (int j = 0; j < 8; ++j) { const f32x4 ya = va[j] * ra * g[j], yb = vb[j] * rb * g[j]; u32x2 wa, wb; wa.x = cvtpk(ya.x, ya.y); wa.y = cvtpk(ya.z, ya.w); wb.x = cvtpk(yb.x, yb.y); wb.y = cvtpk(yb.z, yb.w);
                o[64 * j] = wa; o[64 * j + D / 4] = wb; }
        }
        __syncthreads();
        if (tid < NE) { int c = 0; for (int i = 0; i < 2 * RPB; ++i) c += (tl[i] == tid) ? 1 : 0; CNT[bx * NE + tid] = c; }
        __syncthreads();
    }
    GRID_BAR();
    if (PH(18)) RP(18)
    {
        IDS();
        LAS int* sh = (LAS int*)lds;
        if (tid < NE) { int before = 0, total = 0; for (int bb = 0; bb < G; ++bb) { const int c = CNT[bb * NE + tid]; total += c; before += (bb < bx) ? c : 0; } sh[tid] = before; sh[16 + tid] = total; }
        if (tid >= 64 && tid < 64 + 2 * RPB) sh[32 + (tid - 64)] = TOPE[2 * bx * RPB + (tid - 64)];
        __syncthreads();
        if (tid == 0) { int ps = 0; for (int e = 0; e < NE; ++e) { sh[8 + e] = ps; ps += ((sh[16 + e] + 255) >> 8) << 8; }
            if (bx == 0) { int ti = 0; for (int e = 0; e < NE; ++e) { const int ntl = (sh[16 + e] + 255) >> 8; for (int q = 0; q < ntl; ++q) TILE[ti++] = e; } TILE[255] = ti; } }
        __syncthreads();
        if (tid < 2 * RPB) { const int e = sh[32 + tid]; int rank = 0; for (int j = 0; j < tid; ++j) rank += (sh[32 + j] == e) ? 1 : 0;
            const int slot = sh[8 + e] + sh[e] + rank; sh[160 + tid] = slot; SLOT[2 * bx * RPB + tid] = slot; }
        __syncthreads();
        unsigned char* BUF = ws + A_BUF;
        for (int r = wave; r < RPB; r += 2 * NWAVES) {
            u32x4 s[2][4];
#pragma unroll
            for (int qq = 0; qq < 2; ++qq) { const int m = bx * RPB + r + qq * NWAVES;
                const u32x4* src = (const u32x4*)(XB + (size_t)m * D + 32 * lane);
#pragma unroll
                for (int j = 0; j < 4; ++j) s[qq][j] = src[j]; }
#pragma unroll
            for (int qq = 0; qq < 2; ++qq) { float x[32]; const int rr = r + qq * NWAVES;
#pragma unroll
                for (int j = 0; j < 4; ++j) { const u32x4 t = s[qq][j]; x[8 * j + 0] = bflo(t.x) * ASC6; x[8 * j + 1] = bfhi(t.x) * ASC6; x[8 * j + 2] = bflo(t.y) * ASC6; x[8 * j + 3] = bfhi(t.y) * ASC6;
                    x[8 * j + 4] = bflo(t.z) * ASC6; x[8 * j + 5] = bfhi(t.z) * ASC6; x[8 * j + 6] = bflo(t.w) * ASC6; x[8 * j + 7] = bfhi(t.w) * ASC6; }
                const v6u w = pk32_fp6(x); const u32x4 lo = {w[0], w[1], w[2], w[3]}, hi = {w[4], w[5], 0u, 0u};
                unsigned char* d0 = BUF + (size_t)sh[160 + 2 * rr] * D + 32 * lane; unsigned char* d1 = BUF + (size_t)sh[160 + 2 * rr + 1] * D + 32 * lane;
                *(u32x4*)d0 = lo; *(u32x4*)(d0 + 16) = hi; *(u32x4*)d1 = lo; *(u32x4*)(d1 + 16) = hi; } }
        __syncthreads();
    }
    GRID_BAR();
    if (PH(19)) RP(19)
    {
        LAS int* tlds = (LAS int*)(lds + LDSCTL_OFF + 1024);
        { IDS(); if (tid < 256) tlds[tid] = TILE[tid]; __syncthreads(); }
        const int ntiles = tlds[255];
        pg8::Gemm g{(const bf16_t*)(ws + A_BUF), (const bf16_t*)(ws + W_MOEGU), D, D, D};
        pg8::SchedMoe S; S.T.init(ntiles, 2 * FF / 256, G, bx); S.tile_e = tlds; S.atile = (size_t)256 * D; S.btile = (size_t)256 * D; S.nN = 2 * FF / 256;
        pg8::EpiSwiglu<1> E{(void*)(ws + A_HM), FF, 1.0f / (WSC6 * ASC6), HSC8};
        pg8::gemm_phase8<pg8::EpiSwiglu<1>, pg8::SchedMoe, 1>(lds, g, S, E);
    }
    GRID_BAR();
    if (PH(20)) RP(20)
    {
        LAS int* tlds = (LAS int*)(lds + LDSCTL_OFF + 1024);
        { IDS(); if (tid < 256) tlds[tid] = TILE[tid]; __syncthreads(); }
        const int ntiles = tlds[255], nmain = ntiles < MAIN_TILES ? ntiles : MAIN_TILES;
        {
            pg8::Gemm g{(const bf16_t*)(ws + A_HM), (const bf16_t*)(ws + W_MOED), FF, FF, FF};
            pg8::SchedMoe S; S.T.init(nmain, D / 256, G, bx); S.tile_e = tlds; S.atile = (size_t)256 * FF; S.btile = (size_t)256 * FF; S.nN = D / 256;
            pg8::EpiBf16 E{(bf16_t*)(ws + A_YM), D, 1.0f / (WSC8 * HSC8)};
            pg8::gemm_phase8(lds, g, S, E);
        }
        if (ntiles > MAIN_TILES) {
            pg8::Gemm g{(const bf16_t*)(ws + A_HM), (const bf16_t*)(ws + W_MOED), FF, FF, FF / KSPLIT};
            pg8::SchedMoeSplit S; S.G = G; S.c = bx; S.pm0 = MAIN_TILES; S.nN = D / 256; S.ntl = (ntiles - MAIN_TILES) * (D / 256); S.KS = KSPLIT; S.tile_e = tlds;
            S.atile = (size_t)256 * FF; S.btile = (size_t)256 * FF; S.kbytes = FF / KSPLIT;
            pg8::EpiBf16Split E{(bf16_t*)(ws + A_YP) - (size_t)MAIN_TILES * 256 * D, D, 1.0f / (WSC8 * HSC8), (size_t)(MAXT - MAIN_TILES) * 256 * D};
            pg8::gemm_phase8(lds, g, S, E);
        }
    }
    GRID_BAR();
    if (PH(21)) RP(21)
    {
        IDS();
        const bf16_t* YM = (const bf16_t*)(ws + A_YM); const float* gain = args.in[I_FNORM];
        const bf16_t* YP = (const bf16_t*)(ws + A_YP); constexpr size_t YPS = (size_t)(MAXT - MAIN_TILES) * 256 * D;
        const bool poison = xb_ld((unsigned*)(ws + WS_CTL) + 1024 + XB_TMO) != 0u;
        f32x4 g[8];
#pragma unroll
        for (int j = 0; j < 8; ++j) g[j] = *(const f32x4*)(gain + 4 * lane + 256 * j);
        for (int m = gw; m < M; m += NGW) {
            const int s1 = SLOT[2 * m], s2 = SLOT[2 * m + 1]; const float g1 = GATE[2 * m], g2 = GATE[2 * m + 1];
            f32x4* xr = (f32x4*)(out + (size_t)m * D) + lane;
            const u32x2* y1 = (const u32x2*)(YM + (size_t)s1 * D) + lane; const u32x2* y2 = (const u32x2*)(YM + (size_t)s2 * D) + lane;
            f32x4 v[8]; float s = 0.f;
            if (s1 < MAIN_TILES * 256 && s2 < MAIN_TILES * 256) {
#pragma unroll
            for (int j = 0; j < 8; ++j) { const f32x4 x = xr[64 * j]; const u32x2 a = y1[64 * j], b = y2[64 * j];
                f32x4 t; t.x = x.x + g1 * bflo(a.x) + g2 * bflo(b.x); t.y = x.y + g1 * bfhi(a.x) + g2 * bfhi(b.x); t.z = x.z + g1 * bflo(a.y) + g2 * bflo(b.y); t.w = x.w + g1 * bfhi(a.y) + g2 * bfhi(b.y);
                v[j] = t; s += dot4(t); }
            } else {
#pragma unroll
                for (int j = 0; j < 8; ++j) v[j] = xr[64 * j];
#pragma unroll
                for (int k = 0; k < 2; ++k) { const int sl = k ? s2 : s1; const float gk = k ? g2 : g1;
                    const int np = (sl < MAIN_TILES * 256) ? 1 : KSPLIT;
                    const bf16_t* base = (sl < MAIN_TILES * 256) ? YM + (size_t)sl * D : YP + (size_t)(sl - MAIN_TILES * 256) * D;
                    for (int kc = 0; kc < np; ++kc) { const u32x2* y = (const u32x2*)(base + (size_t)kc * YPS) + lane;
#pragma unroll
                        for (int j = 0; j < 8; ++j) { const u32x2 a = y[64 * j]; v[j].x += gk * bflo(a.x); v[j].y += gk * bfhi(a.x); v[j].z += gk * bflo(a.y); v[j].w += gk * bfhi(a.y); } } }
#pragma unroll
                for (int j = 0; j < 8; ++j) s += dot4(v[j]);
            }
            float rstd = 1.0f / sqrtf(wave_sum(s) * (1.0f / D) + EPS);
            if (poison) rstd = __builtin_nanf("");
#pragma unroll
            for (int j = 0; j < 8; ++j) xr[64 * j] = v[j] * rstd * g[j];
        }
    }
}

extern "C" void kernel_launch(void* const* d_in, const int* in_sizes, int n_in, void* d_out, int out_size, void* d_ws, size_t ws_size, hipStream_t stream) {
    static int ready = 0;
    if (ready == 0) {
        if (n_in != 29 || in_sizes[0] != M * D || out_size != M * D || ws_size < WS_END) {
            fprintf(stderr, "kernel_launch: unexpected shapes (n_in %d, in0 %d, out %d, ws %zu, need %zu); nothing launched\n", n_in, n_in > 0 ? in_sizes[0] : -1, out_size, ws_size, (size_t)WS_END); ready = -1; return; }
        if (hipFuncSetAttribute((const void*)fwd_kernel, hipFuncAttributeMaxDynamicSharedMemorySize, LDS_BYTES) != hipSuccess) { fprintf(stderr, "kernel_launch: hipFuncSetAttribute failed\n"); ready = -1; return; }
        int per_cu = 0;
        if (hipOccupancyMaxActiveBlocksPerMultiprocessor(&per_cu, (const void*)fwd_kernel, NTHREADS, LDS_BYTES) != hipSuccess || per_cu < 1) fprintf(stderr, "kernel_launch: occupancy query reports %d workgroups per CU\n", per_cu);
        (void)hipGetLastError();
        ready = 1;
    }
    if (ready < 0) return;
    (void)hipMemsetAsync((char*)d_ws + WS_CTL, 0, CTL_ZERO_BYTES, stream);
    Args a{};
    for (int i = 0; i < 29; ++i) a.in[i] = (const float*)d_in[i];
    a.positions = (const int*)d_in[I_POS]; a.out = (float*)d_out; a.ws = (unsigned char*)d_ws;
    hipLaunchKernelGGL(fwd_kernel, dim3(GRID), dim3(NTHREADS), LDS_BYTES, stream, a);
}
```
